# Optimizing an MI355X kernel written in HIP

```python
import jax
import jax.numpy as jnp
from jax import lax
import numpy as np

D_MODEL = 1024
BATCH = 8
SEQ = 4096
DEPTH = 2

CTX_LEN = 256
GRID_W = 64
HEAD_DIM = 64
Q_BLOCK = 128
ROPE_BASE = 10000.0
A_HEADS = D_MODEL // (2 * HEAD_DIM)
A_KV_HEADS = 2
B_GROUPS = 4
B_GROUP_DIM = D_MODEL // (4 * B_GROUPS)
C_HEADS = D_MODEL // (4 * HEAD_DIM)
C_KV_HEADS = 2
WINDOW = 128
N_EXPERTS = 16
EC_CAPACITY_FACTOR = 2
EXPERT_FF = 2 * D_MODEL

A_Q = A_HEADS * HEAD_DIM
A_KV = A_KV_HEADS * HEAD_DIM
B_W = B_GROUPS * B_GROUP_DIM
C_Q = C_HEADS * HEAD_DIM
C_KV = C_KV_HEADS * HEAD_DIM
MIX_WIDTH = A_Q + B_W + C_Q
QU_WIDTH = A_Q + C_Q + B_W
IN_WIDTH = QU_WIDTH + 2 * A_KV + 2 * C_KV

LN_EPS = 1e-5
RMS_EPS = 1e-6
NEG_INF = -1e30
DEEPNORM_ALPHA = (2 * DEPTH) ** 0.25
DEEPNORM_BETA = (8 * DEPTH) ** -0.25

kernel_name = 'hybrid_gqa_fourier_swa_ecmoe_diffusion'


def _layer_norm(x):
    xf = x.astype(jnp.float32)
    mu = jnp.mean(xf, -1, keepdims=True)
    var = jnp.mean(jnp.square(xf - mu), -1, keepdims=True)
    return ((xf - mu) * lax.rsqrt(var + LN_EPS)).astype(x.dtype)


def _post_norm(res, g, b):
    return _layer_norm(res) * g + b


def _modulate(x, shift, scale):
    return _layer_norm(x) * (1 + scale) + shift


def _rms_norm(x, g):
    xf = x.astype(jnp.float32)
    y = xf * lax.rsqrt(jnp.mean(jnp.square(xf), -1, keepdims=True) + RMS_EPS)
    return y.astype(x.dtype) * g


def _rope_2d_tables(n_tokens, dtype):
    rows = n_tokens // GRID_W
    row = jnp.repeat(jnp.arange(rows, dtype=jnp.int32), GRID_W)
    col = jnp.tile(jnp.arange(GRID_W, dtype=jnp.int32), rows)
    axis_dim = HEAD_DIM // 2
    inv_freq = ROPE_BASE ** (-jnp.arange(0, axis_dim, 2, dtype=jnp.float32) / axis_dim)
    ang = jnp.stack([row[:, None] * inv_freq, col[:, None] * inv_freq], axis=1)
    return jnp.cos(ang).astype(dtype), jnp.sin(ang).astype(dtype)


def _apply_rope_2d(x, cos, sin):
    b, s, h, dh = x.shape
    xr = x.reshape(b, s, h, 2, 2, dh // 4)
    x1, x2 = xr[..., 0, :], xr[..., 1, :]
    cs, sn = cos[None, :, None], sin[None, :, None]
    out = jnp.stack([x1 * cs - x2 * sn, x2 * cs + x1 * sn], axis=-2)
    return out.reshape(b, s, h, dh)


def _heads(p, n):
    b, t, _ = p.shape
    return p.reshape(b, t, n, HEAD_DIM)


def _group_q(q, n_kv):
    b, t, h, dh = q.shape
    return q.reshape(b, t, n_kv, h // n_kv, dh)


def _split_qu(p):
    return p[..., :A_Q], p[..., A_Q:A_Q + C_Q], p[..., A_Q + C_Q:QU_WIDTH]


def _split_kv(p):
    ka = _heads(p[..., :A_KV], A_KV_HEADS)
    va = _heads(p[..., A_KV:2 * A_KV], A_KV_HEADS)
    kc = _heads(p[..., 2 * A_KV:2 * A_KV + C_KV], C_KV_HEADS)
    vc = _heads(p[..., 2 * A_KV + C_KV:], C_KV_HEADS)
    return ka, va, kc, vc


def _dense_block_attention(q, k, v):
    b, s, hkv, g, dh = q.shape
    nb = s // Q_BLOCK
    qb = jnp.moveaxis(q.reshape(b, nb, Q_BLOCK, hkv, g, dh), 1, 0)
    scale = dh ** -0.5

    def one(qblk):
        sc = jnp.einsum('bqhgd,bkhd->bhgqk', qblk, k).astype(jnp.float32) * scale
        p = jax.nn.softmax(sc, axis=-1).astype(v.dtype)
        return jnp.einsum('bhgqk,bkhd->bqhgd', p, v)

    out = lax.map(one, qb)
    return jnp.moveaxis(out, 0, 1).reshape(b, s, hkv * g * dh)


def _sink_softmax(sc, sink):
    b, hkv, g, qn, _ = sc.shape
    sk = jnp.broadcast_to(sink.astype(jnp.float32)[None, :, :, None, None], (b, hkv, g, qn, 1))
    return jax.nn.softmax(jnp.concatenate([sc, sk], axis=-1), axis=-1)[..., :-1]


def _ctx_sink_attention(q, k, v, sink):
    scale = q.shape[-1] ** -0.5
    sc = jnp.einsum('bqhgd,bkhd->bhgqk', q, k).astype(jnp.float32) * scale
    p = _sink_softmax(sc, sink).astype(v.dtype)
    out = jnp.einsum('bhgqk,bkhd->bqhgd', p, v)
    b, t = q.shape[:2]
    return out.reshape(b, t, -1)


def _window_sink_attention(q, k, v, k_ctx, v_ctx, sink):
    b, s, hkv, g, dh = q.shape
    nb = s // Q_BLOCK
    band = Q_BLOCK + 2 * WINDOW
    pad = ((0, 0), (WINDOW, WINDOW), (0, 0), (0, 0))
    kp, vp = jnp.pad(k, pad), jnp.pad(v, pad)
    qb = jnp.moveaxis(q.reshape(b, nb, Q_BLOCK, hkv, g, dh), 1, 0)
    scale = dh ** -0.5
    q_off = jnp.arange(Q_BLOCK)
    k_off = jnp.arange(band) - WINDOW
    in_window = jnp.abs(k_off[None, :] - q_off[:, None]) <= WINDOW
    ctx_valid = jnp.ones((Q_BLOCK, k_ctx.shape[1]), dtype=bool)

    def one(args):
        qblk, i = args
        start = i * Q_BLOCK
        kb = lax.dynamic_slice_in_dim(kp, start, band, axis=1)
        vb = lax.dynamic_slice_in_dim(vp, start, band, axis=1)
        k_pos = start + k_off
        valid = in_window & ((k_pos >= 0) & (k_pos < s))[None, :]
        mask = jnp.concatenate([ctx_valid, valid], axis=-1)
        kk = jnp.concatenate([k_ctx, kb], axis=1)
        vv = jnp.concatenate([v_ctx, vb], axis=1)
        sc = jnp.einsum('bqhgd,bkhd->bhgqk', qblk, kk).astype(jnp.float32) * scale
        sc = jnp.where(mask, sc, NEG_INF)
        p = _sink_softmax(sc, sink).astype(vv.dtype)
        return jnp.einsum('bhgqk,bkhd->bqhgd', p, vv)

    out = lax.map(one, (qb, jnp.arange(nb)))
    return jnp.moveaxis(out, 0, 1).reshape(b, s, hkv * g * dh)


def _fourier_mix(u, w, bias):
    b, t, _ = u.shape
    ug = u.reshape(b, t, B_GROUPS, B_GROUP_DIM).astype(jnp.float32)
    f = jnp.fft.fft2(ug, axes=(1, 3), norm='ortho').real.astype(u.dtype)
    y = jnp.einsum('btgc,gcd->btgd', f, w) + bias
    return y.reshape(b, t, B_W)


def _mixing(h_lat, h_ctx, w_in, q_norm, k_norm, w_four, b_four, sink, w_out, cos, sin, update_ctx):
    sink = sink.reshape(C_KV_HEADS, C_HEADS // C_KV_HEADS)
    ka_c, va_c, kc_c, vc_c = _split_kv(h_ctx @ w_in[:, QU_WIDTH:])
    ka_c = _rms_norm(ka_c, k_norm)
    p = h_lat @ w_in
    qa, qc, u = _split_qu(p)
    ka, va, kc, vc = _split_kv(p[..., QU_WIDTH:])
    qa = _apply_rope_2d(_rms_norm(_heads(qa, A_HEADS), q_norm), cos, sin)
    ka = _apply_rope_2d(_rms_norm(ka, k_norm), cos, sin)
    qc = _apply_rope_2d(_heads(qc, C_HEADS), cos, sin)
    kc = _apply_rope_2d(kc, cos, sin)
    out_a = _dense_block_attention(_group_q(qa, A_KV_HEADS),
                                   jnp.concatenate([ka_c, ka], axis=1),
                                   jnp.concatenate([va_c, va], axis=1))
    out_b = _fourier_mix(u, w_four, b_four)
    out_c = _window_sink_attention(_group_q(qc, C_KV_HEADS), kc, vc, kc_c, vc_c, sink)
    o_lat = jnp.concatenate([out_a, out_b, out_c], axis=-1) @ w_out
    if not update_ctx:
        return o_lat, None
    qa_c, qc_c, u_c = _split_qu(h_ctx @ w_in[:, :QU_WIDTH])
    qa_c = _rms_norm(_heads(qa_c, A_HEADS), q_norm)
    out_a_c = _dense_block_attention(_group_q(qa_c, A_KV_HEADS), ka_c, va_c)
    out_b_c = _fourier_mix(u_c, w_four, b_four)
    out_c_c = _ctx_sink_attention(_group_q(_heads(qc_c, C_HEADS), C_KV_HEADS), kc_c, vc_c, sink)
    o_ctx = jnp.concatenate([out_a_c, out_b_c, out_c_c], axis=-1) @ w_out
    return o_lat, o_ctx


def _expert_choice_moe(h, w_router, w_gate, w_up, w_down):
    b, t, d = h.shape
    capacity = EC_CAPACITY_FACTOR * t // N_EXPERTS
    logits = jnp.einsum('btd,de->bte', h, w_router).astype(jnp.float32)
    affinity = jax.nn.softmax(logits, axis=-1)
    gate, idx = lax.top_k(jnp.swapaxes(affinity, 1, 2), capacity)
    xg = jax.vmap(lambda hb, ib: hb[ib])(h, idx)
    a = jnp.einsum('becd,edf->becf', xg, w_gate)
    up = jnp.einsum('becd,edf->becf', xg, w_up)
    y = jnp.einsum('becf,efd->becd', jax.nn.silu(a) * up, w_down) * gate[..., None].astype(h.dtype)
    return jax.vmap(lambda ib, yb: jnp.zeros((t, d), yb.dtype).at[ib.reshape(-1)].add(yb.reshape(-1, d)))(idx, y)


def setup_inputs(seed: int = 0) -> dict:
    key = jax.random.key(seed)
    ks = jax.random.split(key, 24)
    D = D_MODEL

    def nrm(k, shape, scale):
        return jax.random.normal(k, shape, jnp.float32) * scale

    return {
        'x': nrm(ks[0], (BATCH, SEQ, D), 1.0),
        'c': nrm(ks[1], (BATCH, D), 1.0),
        'ctx': nrm(ks[2], (BATCH, CTX_LEN, D), 1.0),
        'c_ctx': nrm(ks[3], (D,), 1.0),
        'w_mod': nrm(ks[4], (DEPTH, D, 6 * D), 0.5 * D ** -0.5),
        'b_mod': nrm(ks[5], (DEPTH, 6 * D), 0.02),
        'w_in': nrm(ks[6], (DEPTH, D, IN_WIDTH), D ** -0.5),
        'q_norm_a': 1.0 + nrm(ks[7], (DEPTH, HEAD_DIM), 0.02),
        'k_norm_a': 1.0 + nrm(ks[8], (DEPTH, HEAD_DIM), 0.02),
        'w_fourier': nrm(ks[9], (DEPTH, B_GROUPS, B_GROUP_DIM, B_GROUP_DIM), B_GROUP_DIM ** -0.5),
        'b_fourier': nrm(ks[10], (DEPTH, B_GROUPS, B_GROUP_DIM), 0.02),
        'sink_c': nrm(ks[11], (DEPTH, C_HEADS), 0.5),
        'w_out': nrm(ks[12], (DEPTH, MIX_WIDTH, D), DEEPNORM_BETA * MIX_WIDTH ** -0.5),
        'ln1_g': 1.0 + nrm(ks[13], (DEPTH, D), 0.02),
        'ln1_b': nrm(ks[14], (DEPTH, D), 0.02),
        'w_router': nrm(ks[15], (DEPTH, D, N_EXPERTS), D ** -0.5),
        'w_gate': nrm(ks[16], (DEPTH, N_EXPERTS, D, EXPERT_FF), D ** -0.5),
        'w_up': nrm(ks[17], (DEPTH, N_EXPERTS, D, EXPERT_FF), D ** -0.5),
        'w_down': nrm(ks[18], (DEPTH, N_EXPERTS, EXPERT_FF, D), DEEPNORM_BETA * EXPERT_FF ** -0.5),
        'ln2_g': 1.0 + nrm(ks[19], (DEPTH, D), 0.02),
        'ln2_b': nrm(ks[20], (DEPTH, D), 0.02),
    }


def reference(x, c, ctx, c_ctx, w_mod, b_mod, w_in, q_norm_a, k_norm_a, w_fourier, b_fourier, sink_c,
              w_out, ln1_g, ln1_b, w_router, w_gate, w_up, w_down, ln2_g, ln2_b):
    cos, sin = _rope_2d_tables(x.shape[1], x.dtype)
    silu_c = jax.nn.silu(c)
    silu_cc = jax.nn.silu(c_ctx)
    x_lat, x_ctx = x, ctx
    for layer in range(DEPTH):
        update_ctx = layer < DEPTH - 1
        mod_lat = silu_c @ w_mod[layer] + b_mod[layer]
        mod_ctx = silu_cc @ w_mod[layer] + b_mod[layer]
        sh1, sc1, g1, sh2, sc2, g2 = jnp.split(mod_lat[:, None, :], 6, axis=-1)
        csh1, csc1, cg1, csh2, csc2, cg2 = jnp.split(mod_ctx, 6, axis=-1)
        h_lat = _modulate(x_lat, sh1, sc1)
        h_ctx = _modulate(x_ctx, csh1, csc1)
        o_lat, o_ctx = _mixing(h_lat, h_ctx, w_in[layer], q_norm_a[layer], k_norm_a[layer],
                               w_fourier[layer], b_fourier[layer], sink_c[layer], w_out[layer],
                               cos, sin, update_ctx)
        x_lat = _post_norm(DEEPNORM_ALPHA * x_lat + g1 * o_lat, ln1_g[layer], ln1_b[layer])
        y_lat = _expert_choice_moe(_modulate(x_lat, sh2, sc2), w_router[layer], w_gate[layer],
                                   w_up[layer], w_down[layer])
        x_lat = _post_norm(DEEPNORM_ALPHA * x_lat + g2 * y_lat, ln2_g[layer], ln2_b[layer])
        if update_ctx:
            x_ctx = _post_norm(DEEPNORM_ALPHA * x_ctx + cg1 * o_ctx, ln1_g[layer], ln1_b[layer])
            y_ctx = _expert_choice_moe(_modulate(x_ctx, csh2, csc2), w_router[layer], w_gate[layer],
                                       w_up[layer], w_down[layer])
            x_ctx = _post_norm(DEEPNORM_ALPHA * x_ctx + cg2 * y_ctx, ln2_g[layer], ln2_b[layer])
    return x_lat
```

```cpp
#include <hip/hip_runtime.h>
#include <hip/hip_cooperative_groups.h>
#include <cstdio>
namespace cg = cooperative_groups;

#ifndef ONE_LAUNCH
#define ONE_LAUNCH 1
#endif

#define DI __device__ __forceinline__
typedef unsigned short bfraw;
using bf16x8 = __attribute__((ext_vector_type(8))) short;
using f32x4 = __attribute__((ext_vector_type(4))) float;

constexpr int NB = 8, SEQ = 4096, DM = 1024, CTX = 256;
constexpr int NT = NB * SEQ, NCT = NB * CTX;
constexpr int NPROJ = 1792;
constexpr int KS = CTX + SEQ;
constexpr int NE = 16, FF = 2048;
constexpr int CAP = 512, CAPC = 32;
constexpr float ALPHA = 1.41421356237f;
constexpr float LOG2E = 1.44269504089f;
constexpr int NPHASE = 18;

constexpr size_t al(size_t x) { return (x + 255) & ~size_t(255); }
constexpr size_t O_MOD = 0;
constexpr size_t O_ROPE = al(O_MOD + 2 * 9 * 6144 * 4);
constexpr size_t O_WINT = al(O_ROPE + 2 * 1024 * 4);
constexpr size_t O_WOUTT = al(O_WINT + 2ull * NPROJ * 1024 * 2);
constexpr size_t O_DFT = al(O_WOUTT + 2ull * 1024 * 1024 * 2);
constexpr size_t O_DFTC = al(O_DFT + 4096ull * 8192 * 2);
constexpr size_t O_WGU = al(O_DFTC + 256ull * 512 * 2);
constexpr size_t O_WD = al(O_WGU + 16ull * 4096 * 1024 * 2);
constexpr size_t O_X1 = al(O_WD + 16ull * 1024 * 2048 * 2);
constexpr size_t O_X1C = al(O_X1 + (size_t)NT * 1024 * 4);
constexpr size_t O_H = al(O_X1C + (size_t)NCT * 1024 * 4);
constexpr size_t O_HC = al(O_H + (size_t)NT * 1024 * 2);
constexpr size_t O_AFF = al(O_HC + (size_t)NCT * 1024 * 2);
constexpr size_t O_AFFC = al(O_AFF + 8ull * 16 * 4096 * 4);
constexpr size_t O_IDX = al(O_AFFC + 8ull * 16 * 256 * 4);
constexpr size_t O_GATE = al(O_IDX + 16ull * 8 * 512 * 4);
constexpr size_t O_SLOT = al(O_GATE + 16ull * 8 * 512 * 4);
constexpr size_t O_IDXC = al(O_SLOT + 8ull * 4096 * 16 * 2);
constexpr size_t O_GATEC = al(O_IDXC + 16ull * 8 * 32 * 4);
constexpr size_t O_SLOTC = al(O_GATEC + 16ull * 8 * 32 * 4);
constexpr size_t O_Y = al(O_SLOTC + 8ull * 256 * 16 * 2);
constexpr size_t O_YC = al(O_Y + 65536ull * 1024 * 2);
constexpr size_t O_ACTC = al(O_YC + 4096ull * 1024 * 2);
constexpr size_t O_R = al(O_ACTC + 4096ull * 2048 * 2);
constexpr size_t O_ACT = O_R;
constexpr size_t O_QA = O_R;
constexpr size_t O_QC = al(O_QA + (size_t)NT * 512 * 2);
constexpr size_t O_KA = al(O_QC + (size_t)NT * 256 * 2);
constexpr size_t O_VAT = al(O_KA + 8ull * 2 * KS * 64 * 2);
constexpr size_t O_KC = al(O_VAT + 8ull * 2 * KS * 64 * 2);
constexpr size_t O_VCT = al(O_KC + 8ull * 2 * KS * 64 * 2);
constexpr size_t O_VTF = al(O_VCT + 8ull * 2 * KS * 64 * 2);
constexpr size_t O_MIX = al(O_VTF + 8ull * 256 * 8192 * 2);
constexpr size_t O_QAC = al(O_MIX + (size_t)NT * 1024 * 2);
constexpr size_t O_QCC = al(O_QAC + (size_t)NCT * 512 * 2);
constexpr size_t O_VTFC = al(O_QCC + (size_t)NCT * 256 * 2);
constexpr size_t O_MIXC = al(O_VTFC + 8ull * 256 * 512 * 2);
constexpr size_t O_REND = al(O_MIXC + (size_t)NCT * 1024 * 2);
constexpr size_t O_END = O_R + 65536ull * 2048 * 2;
static_assert(O_REND <= O_END, "mixer buffers must fit in the ACT region");
static_assert(O_END <= 1073741824ull, "workspace too large");

struct Params {
  const float *x, *c, *ctx, *c_ctx, *w_mod, *b_mod, *w_in, *q_norm, *k_norm, *w_four, *b_four, *sink, *w_out,
      *ln1_g, *ln1_b, *w_router, *w_gate, *w_up, *w_down, *ln2_g, *ln2_b;
  float* out;
  char* ws;
  int ph_lo, ph_hi;
};

DI bfraw f2bf(float x) {
  unsigned u = __float_as_uint(x);
  u += 0x7fffu + ((u >> 16) & 1u);
  return (bfraw)(u >> 16);
}
DI unsigned pack2(float a, float b) { return (unsigned)f2bf(a) | ((unsigned)f2bf(b) << 16); }
DI float bflo(unsigned u) { return __uint_as_float(u << 16); }
DI float bfhi(unsigned u) { return __uint_as_float(u & 0xffff0000u); }
DI float wsum(float v) {
#pragma unroll
  for (int o = 32; o; o >>= 1) v += __shfl_xor(v, o);
  return v;
}
DI void glds16(const void* g, char* l) {
  __builtin_amdgcn_global_load_lds((const unsigned*)g, (unsigned*)l, 16, 0, 0);
}
DI void wait_vm0() { asm volatile("s_waitcnt vmcnt(0)" ::: "memory"); }
DI f32x4 mfma16(bf16x8 a, bf16x8 b, f32x4 c) { return __builtin_amdgcn_mfma_f32_16x16x32_bf16(a, b, c, 0, 0, 0); }

DI void gemm_stage(const bfraw* a0, const bfraw* a1, const bfraw* b0, const bfraw* b1, int k0, char* st, int tid) {
#pragma unroll
  for (int i = 0; i < 4; ++i) {
    const bfraw* ga = ((i & 1) ? a1 : a0) + k0 + (i >> 1) * 32;
    glds16(ga, st + (i * 256 + tid) * 16);
  }
#pragma unroll
  for (int i = 0; i < 4; ++i) {
    const bfraw* gb = ((i & 1) ? b1 : b0) + k0 + (i >> 1) * 32;
    glds16(gb, st + 16384 + (i * 256 + tid) * 16);
  }
}

template <class Epi>
DI void gemm_tile(const bfraw* a0, const bfraw* a1, const bfraw* b0, const bfraw* b1, int K, char* lds, int tid, Epi epi) {
  const int w = tid >> 6, lane = tid & 63, wr = w >> 1, wc = w & 1, fr = lane & 15, fq = lane >> 4;
  f32x4 acc[4][4];
#pragma unroll
  for (int m = 0; m < 4; ++m)
#pragma unroll
    for (int n = 0; n < 4; ++n) acc[m][n] = f32x4{0.f, 0.f, 0.f, 0.f};
  const int nk = K >> 6;
  __syncthreads();
  gemm_stage(a0, a1, b0, b1, 0, lds, tid);
  for (int kt = 0; kt < nk; ++kt) {
    wait_vm0();
    __syncthreads();
    if (kt + 1 < nk) gemm_stage(a0, a1, b0, b1, (kt + 1) * 64, lds + ((kt + 1) & 1) * 32768, tid);
    const char* sA = lds + (kt & 1) * 32768;
    const char* sB = sA + 16384;
#pragma unroll
    for (int h = 0; h < 2; ++h) {
      bf16x8 af[4], bfr[4];
#pragma unroll
      for (int m = 0; m < 4; ++m) af[m] = *(const bf16x8*)(sA + h * 8192 + (wr * 64 + m * 16 + fr) * 64 + fq * 16);
#pragma unroll
      for (int n = 0; n < 4; ++n) bfr[n] = *(const bf16x8*)(sB + h * 8192 + (wc * 64 + n * 16 + fr) * 64 + fq * 16);
#pragma unroll
      for (int m = 0; m < 4; ++m)
#pragma unroll
        for (int n = 0; n < 4; ++n) acc[m][n] = mfma16(af[m], bfr[n], acc[m][n]);
    }
  }
  epi(acc, wr, wc, fr, fq);
}

DI void attn_stage(const bfraw* Kp, const bfraw* VTp, int ldv, int tile, char* st, int tid) {
  const int slot0 = tile * 64;
#pragma unroll
  for (int i = 0; i < 2; ++i) {
    glds16(Kp + (long)(slot0 + (tid >> 2)) * 64 + i * 32 + (tid & 3) * 8, st + (i * 256 + tid) * 16);
  }
#pragma unroll
  for (int i = 0; i < 2; ++i) {
    glds16(VTp + (long)(tid >> 2) * ldv + slot0 + i * 32 + (tid & 3) * 8, st + 8192 + (i * 256 + tid) * 16);
  }
}

template <bool WINDOW>
DI void attn_item(const bfraw* Qp, int qstride, const bfraw* Kp, const bfraw* VTp, int ldv, int n1, int tlo, int n2,
                  int qpos0, bool has_sink, float sink_l2, bfraw* Op, int ostride, char* lds, int tid) {
  const int w = tid >> 6, lane = tid & 63, fr = lane & 15, fq = lane >> 4;
  const float scale_l2 = 0.125f * LOG2E;
  bf16x8 qf[2][2];
#pragma unroll
  for (int n = 0; n < 2; ++n)
#pragma unroll
    for (int sd = 0; sd < 2; ++sd)
      qf[n][sd] = *(const bf16x8*)(Qp + (long)(w * 32 + n * 16 + fr) * qstride + sd * 32 + fq * 8);
  float m_run[2], l_run[2];
  f32x4 o[4][2];
#pragma unroll
  for (int n = 0; n < 2; ++n) {
    m_run[n] = has_sink ? sink_l2 : -1e30f;
    l_run[n] = (has_sink && fq == 0) ? 1.f : 0.f;
#pragma unroll
    for (int md = 0; md < 4; ++md) o[md][n] = f32x4{0.f, 0.f, 0.f, 0.f};
  }
  const int nt = n1 + n2;
  __syncthreads();
  attn_stage(Kp, VTp, ldv, (0 < n1) ? 0 : tlo, lds, tid);
  for (int it = 0; it < nt; ++it) {
    wait_vm0();
    __syncthreads();
    if (it + 1 < nt) {
      const int nx = it + 1;
      attn_stage(Kp, VTp, ldv, (nx < n1) ? nx : tlo + (nx - n1), lds + (nx & 1) * 16384, tid);
    }
    const char* sK = lds + (it & 1) * 16384;
    const char* sV = sK + 8192;
    f32x4 s[4][2];
#pragma unroll
    for (int m = 0; m < 4; ++m)
#pragma unroll
      for (int n = 0; n < 2; ++n) s[m][n] = f32x4{0.f, 0.f, 0.f, 0.f};
#pragma unroll
    for (int sd = 0; sd < 2; ++sd) {
#pragma unroll
      for (int m = 0; m < 4; ++m) {
        const int krow = (m >> 1) * 32 + (fr >> 2) * 8 + (m & 1) * 4 + (fr & 3);
        bf16x8 kf = *(const bf16x8*)(sK + sd * 4096 + krow * 64 + fq * 16);
#pragma unroll
        for (int n = 0; n < 2; ++n) s[m][n] = mfma16(kf, qf[n][sd], s[m][n]);
      }
    }
    const int tile = (it < n1) ? it : tlo + (it - n1);
    const bool domask = WINDOW && (it >= n1);
#pragma unroll
    for (int n = 0; n < 2; ++n) {
      const int qpos = qpos0 + w * 32 + n * 16 + fr;
      float mx = -1e30f;
#pragma unroll
      for (int m = 0; m < 4; ++m)
#pragma unroll
        for (int j = 0; j < 4; ++j) {
          float v = s[m][n][j] * scale_l2;
          if (domask) {
            const int kpos = tile * 64 - CTX + (m >> 1) * 32 + fq * 8 + (m & 1) * 4 + j;
            const int d = qpos - kpos;
            if (d > 128 || d < -128) v = -1e30f;
          }
          s[m][n][j] = v;
          mx = fmaxf(mx, v);
        }
      mx = fmaxf(mx, __shfl_xor(mx, 16));
      mx = fmaxf(mx, __shfl_xor(mx, 32));
      const float m_new = fmaxf(m_run[n], mx);
      const float alpha = __builtin_amdgcn_exp2f(m_run[n] - m_new);
      m_run[n] = m_new;
      float ls = 0.f;
#pragma unroll
      for (int m = 0; m < 4; ++m)
#pragma unroll
        for (int j = 0; j < 4; ++j) {
          const float p = __builtin_amdgcn_exp2f(s[m][n][j] - m_new);
          s[m][n][j] = p;
          ls += p;
        }
      l_run[n] = l_run[n] * alpha + ls;
#pragma unroll
      for (int md = 0; md < 4; ++md) {
        o[md][n][0] *= alpha; o[md][n][1] *= alpha; o[md][n][2] *= alpha; o[md][n][3] *= alpha;
      }
    }
#pragma unroll
    for (int ks = 0; ks < 2; ++ks) {
      bf16x8 pf[2];
#pragma unroll
      for (int n = 0; n < 2; ++n) {
        union { unsigned u[4]; bf16x8 v; } pk;
        pk.u[0] = pack2(s[2 * ks][n][0], s[2 * ks][n][1]);
        pk.u[1] = pack2(s[2 * ks][n][2], s[2 * ks][n][3]);
        pk.u[2] = pack2(s[2 * ks + 1][n][0], s[2 * ks + 1][n][1]);
        pk.u[3] = pack2(s[2 * ks + 1][n][2], s[2 * ks + 1][n][3]);
        pf[n] = pk.v;
      }
#pragma unroll
      for (int md = 0; md < 4; ++md) {
        bf16x8 vf = *(const bf16x8*)(sV + ks * 4096 + (md * 16 + fr) * 64 + fq * 16);
#pragma unroll
        for (int n = 0; n < 2; ++n) o[md][n] = mfma16(vf, pf[n], o[md][n]);
      }
    }
  }
#pragma unroll
  for (int n = 0; n < 2; ++n) {
    float l = l_run[n];
    l += __shfl_xor(l, 16);
    l += __shfl_xor(l, 32);
    const float inv = 1.f / l;
    bfraw* orow = Op + (long)(w * 32 + n * 16 + fr) * ostride;
#pragma unroll
    for (int md = 0; md < 4; ++md) {
      uint2 st;
      st.x = pack2(o[md][n][0] * inv, o[md][n][1] * inv);
      st.y = pack2(o[md][n][2] * inv, o[md][n][3] * inv);
      *(uint2*)(orow + md * 16 + fq * 4) = st;
    }
  }
}

DI void xpose_tile(const float* src, long ld_src, bfraw* dst, long ld_dst, int mode, char* lds, int tid) {
  float(*t)[65] = (float(*)[65])lds;
  __syncthreads();
  {
    const int c = tid & 63, r0 = tid >> 6;
#pragma unroll 4
    for (int rr = r0; rr < 64; rr += 4) t[rr][c] = src[(long)rr * ld_src + c];
  }
  __syncthreads();
  {
    const int k8 = (tid & 7) * 8, n0 = tid >> 3;
#pragma unroll
    for (int nn = n0; nn < 64; nn += 32) {
      uint4 v;
      v.x = pack2(t[k8 + 0][nn], t[k8 + 1][nn]);
      v.y = pack2(t[k8 + 2][nn], t[k8 + 3][nn]);
      v.z = pack2(t[k8 + 4][nn], t[k8 + 5][nn]);
      v.w = pack2(t[k8 + 6][nn], t[k8 + 7][nn]);
      const int row = (mode == 0) ? nn : ((nn >> 4) * 32 + (mode == 2 ? 16 : 0) + (nn & 15));
      *(uint4*)(dst + (long)row * ld_dst + k8) = v;
    }
  }
}

constexpr int N_EXPCONV = 16384 + 8192;
DI void expconv_item(const Params& p, int layer, int item, char* lds, int tid) {
  bfraw* WGU = (bfraw*)(p.ws + O_WGU);
  bfraw* WD = (bfraw*)(p.ws + O_WD);
  if (item < 16384) {
    const int type = item & 1;
    int r = item >> 1;
    const int nt = r & 31; r >>= 5;
    const int kt = r & 15; const int e = r >> 4;
    const float* src = (type ? p.w_up : p.w_gate) + ((long)(layer * NE + e) * DM + kt * 64) * FF + nt * 64;
    bfraw* dst = WGU + ((long)e * 4096 + nt * 128) * DM + kt * 64;
    xpose_tile(src, FF, dst, DM, 1 + type, lds, tid);
  } else {
    int r = item - 16384;
    const int nt = r & 15; r >>= 4;
    const int kt = r & 31; const int e = r >> 5;
    const float* src = p.w_down + ((long)(layer * NE + e) * FF + kt * 64) * DM + nt * 64;
    bfraw* dst = WD + ((long)e * DM + nt * 64) * FF + kt * 64;
    xpose_tile(src, DM, dst, FF, 0, lds, tid);
  }
}

DI void prep_mod_item(const Params& p, int item, char* lds, int tid) {
  const int layer = item / 96, chunk = item % 96;
  float* sc = (float*)lds;
  float* red = (float*)(lds + 36864);
  __syncthreads();
  for (int idx = tid; idx < 9 * 1024; idx += 256) {
    const int r = idx >> 10, k = idx & 1023;
    const float v = (r < 8) ? p.c[r * 1024 + k] : p.c_ctx[k];
    sc[idx] = v / (1.f + __expf(-v));
  }
  __syncthreads();
  const int w = tid >> 6, lane = tid & 63;
  const int col = chunk * 64 + lane;
  float acc[9];
#pragma unroll
  for (int r = 0; r < 9; ++r) acc[r] = 0.f;
  const float* wp = p.w_mod + ((long)layer * 1024 + w * 256) * 6144 + col;
#pragma unroll 4
  for (int k = 0; k < 256; ++k) {
    const float wv = wp[(long)k * 6144];
#pragma unroll
    for (int r = 0; r < 9; ++r) acc[r] += sc[r * 1024 + w * 256 + k] * wv;
  }
#pragma unroll
  for (int r = 0; r < 9; ++r) red[(w * 9 + r) * 64 + lane] = acc[r];
  __syncthreads();
  float* MOD = (float*)(p.ws + O_MOD);
  for (int idx = tid; idx < 9 * 64; idx += 256) {
    const int r = idx >> 6, l = idx & 63;
    float s = red[(0 * 9 + r) * 64 + l] + red[(1 * 9 + r) * 64 + l] + red[(2 * 9 + r) * 64 + l] + red[(3 * 9 + r) * 64 + l];
    s += p.b_mod[layer * 6144 + chunk * 64 + l];
    MOD[(layer * 9 + r) * 6144 + chunk * 64 + l] = s;
  }
}

DI void prep_four_item(const Params& p, int item, char* lds, int tid) {
  const int layer = item >> 6, g = (item >> 4) & 3, kt = item & 15;
  float* G = (float*)lds;
  float(*Wt)[65] = (float(*)[65])(lds + 32768);
  float* ctab = (float*)(lds + 32768 + 64 * 65 * 4);
  __syncthreads();
  const float* wg = p.w_four + (long)(layer * 4 + g) * 4096;
  for (int idx = tid; idx < 4096; idx += 256) Wt[idx >> 6][idx & 63] = wg[idx];
  if (tid < 64) {
    float sn, cs;
    sincospif((float)tid / 32.f, &sn, &cs);
    ctab[tid] = cs;
    ctab[64 + tid] = sn;
  }
  __syncthreads();
  for (int o = tid; o < 4096; o += 256) {
    const int c = o >> 6, d = o & 63;
    float s1 = 0.f, s2 = 0.f;
#pragma unroll 4
    for (int c2 = 0; c2 < 64; ++c2) {
      const int a = (c * c2) & 63;
      const float wv = Wt[c2][d];
      s1 += ctab[a] * wv;
      s2 += ctab[64 + a] * wv;
    }
    G[o] = s1;
    G[4096 + o] = s2;
  }
  __syncthreads();
  const float* wi = p.w_in + ((long)layer * 1024 + kt * 64) * 1536 + 768 + g * 64;
  for (int idx = tid; idx < 4096; idx += 256) Wt[idx >> 6][idx & 63] = wi[(long)(idx >> 6) * 1536 + (idx & 63)];
  __syncthreads();
  bfraw* WINT = (bfraw*)(p.ws + O_WINT) + (long)layer * NPROJ * 1024;
  for (int o = tid; o < 64 * 128; o += 256) {
    const int kk = o & 63, dcol = o >> 6;
    const float* Gs = G + (dcol >> 6) * 4096 + (dcol & 63);
    float s = 0.f;
#pragma unroll 4
    for (int c = 0; c < 64; ++c) s += Wt[kk][c] * Gs[c * 64];
    const int row = (dcol < 64) ? (768 + g * 64 + dcol) : (1024 + g * 64 + (dcol - 64));
    WINT[(long)row * 1024 + kt * 64 + kk] = f2bf(s);
  }
}

constexpr int P0_MOD = 192, P0_FOUR = 128, P0_ROPE = 1, P0_DFTC = 256, P0_DFT = 4096, P0_WIN = 2 * 16 * 24, P0_WOUT = 2 * 16 * 16;
constexpr int P0_TOTAL = P0_MOD + P0_FOUR + P0_ROPE + P0_DFTC + P0_DFT + P0_WIN + P0_WOUT + N_EXPCONV;

DI void phase_prep(const Params& p, char* lds, int tid) {
  for (int item = blockIdx.x; item < P0_TOTAL; item += gridDim.x) {
    int it = item;
    if (it < P0_MOD) { prep_mod_item(p, it, lds, tid); continue; }
    it -= P0_MOD;
    if (it < P0_FOUR) { prep_four_item(p, it, lds, tid); continue; }
    it -= P0_FOUR;
    if (it < P0_ROPE) {
      float* rope = (float*)(p.ws + O_ROPE);
      for (int idx = tid; idx < 1024; idx += 256) {
        const int pos = idx >> 4, f = idx & 15;
        const float inv_freq = powf(10000.f, -(float)f / 16.f);
        const float ang = (float)pos * inv_freq;
        rope[idx] = cosf(ang);
        rope[1024 + idx] = sinf(ang);
      }
      continue;
    }
    it -= P0_ROPE;
    if (it < P0_DFTC) {
      bfraw* D = (bfraw*)(p.ws + O_DFTC) + (long)it * 512;
      for (int k = tid; k < 512; k += 256) {
        const int kk = k & 255;
        float sn, cs;
        sincospif((float)((it * kk) & 255) / 128.f, &sn, &cs);
        D[k] = f2bf(k < 256 ? cs : -sn);
      }
      continue;
    }
    it -= P0_DFTC;
    if (it < P0_DFT) {
      bfraw* D = (bfraw*)(p.ws + O_DFT) + (long)it * 8192;
      for (int ch = tid; ch < 4096; ch += 256) {
        const int k = ch * 2, kk = k & 4095;
        float sn0, cs0, sn1, cs1;
        sincospif((float)((it * kk) & 4095) / 2048.f, &sn0, &cs0);
        sincospif((float)((it * (kk + 1)) & 4095) / 2048.f, &sn1, &cs1);
        *(unsigned*)(D + k) = (k < 4096) ? pack2(cs0, cs1) : pack2(-sn0, -sn1);
      }
      continue;
    }
    it -= P0_DFT;
    if (it < P0_WIN) {
      const int layer = it / 384, r = it % 384, kt = r / 24, nt = r % 24;
      if (nt >= 12 && nt < 16) continue;
      const int col = nt * 64;
      const int drow = (col < 768) ? col : col + 256;
      const float* src = p.w_in + ((long)layer * 1024 + kt * 64) * 1536 + col;
      bfraw* dst = (bfraw*)(p.ws + O_WINT) + ((long)layer * NPROJ + drow) * 1024 + kt * 64;
      xpose_tile(src, 1536, dst, 1024, 0, lds, tid);
      continue;
    }
    it -= P0_WIN;
    if (it < P0_WOUT) {
      const int layer = it >> 8, r = it & 255, kt = r >> 4, nt = r & 15;
      const float* src = p.w_out + ((long)layer * 1024 + kt * 64) * 1024 + nt * 64;
      bfraw* dst = (bfraw*)(p.ws + O_WOUTT) + ((long)layer * 1024 + nt * 64) * 1024 + kt * 64;
      xpose_tile(src, 1024, dst, 1024, 0, lds, tid);
      continue;
    }
    it -= P0_WOUT;
    expconv_item(p, 0, it, lds, tid);
  }
}

DI void ln_stats(const float v[16], float& mean, float& rstd) {
  float s = 0.f;
#pragma unroll
  for (int i = 0; i < 16; ++i) s += v[i];
  mean = wsum(s) * (1.f / 1024.f);
  float q = 0.f;
#pragma unroll
  for (int i = 0; i < 16; ++i) { const float d = v[i] - mean; q += d * d; }
  rstd = rsqrtf(wsum(q) * (1.f / 1024.f) + 1e-5f);
}
DI void load_row16(const float* src, int lane, float v[16]) {
#pragma unroll
  for (int i = 0; i < 4; ++i) {
    const float4 t = *(const float4*)(src + i * 256 + lane * 4);
    v[i * 4 + 0] = t.x; v[i * 4 + 1] = t.y; v[i * 4 + 2] = t.z; v[i * 4 + 3] = t.w;
  }
}
DI void store_row16(float* dst, int lane, const float v[16]) {
#pragma unroll
  for (int i = 0; i < 4; ++i) *(float4*)(dst + i * 256 + lane * 4) = make_float4(v[i * 4], v[i * 4 + 1], v[i * 4 + 2], v[i * 4 + 3]);
}
DI void store_row16_bf(bfraw* dst, int lane, const float v[16]) {
#pragma unroll
  for (int i = 0; i < 4; ++i) {
    uint2 st;
    st.x = pack2(v[i * 4], v[i * 4 + 1]);
    st.y = pack2(v[i * 4 + 2], v[i * 4 + 3]);
    *(uint2*)(dst + i * 256 + lane * 4) = st;
  }
}
DI void modulate16(float v[16], const float* sh, const float* sc, int lane) {
  float mean, rstd;
  ln_stats(v, mean, rstd);
  float a[16], b[16];
  load_row16(sh, lane, a);
  load_row16(sc, lane, b);
#pragma unroll
  for (int i = 0; i < 16; ++i) v[i] = (v[i] - mean) * rstd * (1.f + b[i]) + a[i];
}
DI void postnorm16(float v[16], const float* g, const float* bb, int lane) {
  float mean, rstd;
  ln_stats(v, mean, rstd);
  float a[16], b[16];
  load_row16(g, lane, a);
  load_row16(bb, lane, b);
#pragma unroll
  for (int i = 0; i < 16; ++i) v[i] = (v[i] - mean) * rstd * a[i] + b[i];
}

DI void phase_lnmod0(const Params& p, int tid) {
  const int w = tid >> 6, lane = tid & 63;
  const float* MOD = (const float*)(p.ws + O_MOD);
  for (int row = blockIdx.x * 4 + w; row < NT + NCT; row += gridDim.x * 4) {
    float v[16];
    if (row < NT) {
      load_row16(p.x + (long)row * 1024, lane, v);
      const float* mr = MOD + (0 * 9 + row / SEQ) * 6144;
      modulate16(v, mr, mr + 1024, lane);
      store_row16_bf((bfraw*)(p.ws + O_H) + (long)row * 1024, lane, v);
    } else {
      const int rc = row - NT;
      load_row16(p.ctx + (long)rc * 1024, lane, v);
      const float* mr = MOD + (0 * 9 + 8) * 6144;
      modulate16(v, mr, mr + 1024, lane);
      store_row16_bf((bfraw*)(p.ws + O_HC) + (long)rc * 1024, lane, v);
    }
  }
}

DI void proj_item(const Params& p, int layer, bool is_ctx, int rt, int ct, char* lds, int tid) {
  const int T = is_ctx ? CTX : SEQ;
  const bfraw* Hs = (const bfraw*)(p.ws + (is_ctx ? O_HC : O_H));
  const bfraw* W = (const bfraw*)(p.ws + O_WINT) + (long)layer * NPROJ * 1024;
  const int r0 = tid >> 2, c8 = (tid & 3) * 8;
  const bfraw* a0 = Hs + (long)(rt * 128 + r0) * 1024 + c8;
  const bfraw* a1 = a0 + 64 * 1024;
  const bfraw* b0 = W + (long)(ct * 128 + r0) * 1024 + c8;
  const bfraw* b1 = b0 + 64 * 1024;
  char* ws = p.ws;
  const float* rope = (const float*)(ws + O_ROPE);
  const float* qn = p.q_norm + layer * 64;
  const float* kn = p.k_norm + layer * 64;
  gemm_tile(a0, a1, b0, b1, 1024, lds, tid, [&](f32x4 (&acc)[4][4], int wr, int wc, int fr, int fq) {
    const int rowbase = rt * 128 + wr * 64;
    const int b = rowbase / T;
    const int tbase = rowbase - b * T;
    int kind;
    if (ct < 6 || ct == 10 || ct == 12) kind = 0;
    else if (ct == 11 || ct == 13) kind = 1;
    else kind = 2;
    if (kind == 0) {
      const bool donorm = (ct < 4) || (ct == 10);
      const float* gn = (ct < 4) ? qn : kn;
      bfraw* dst;
      long rstride;
      if (ct < 4) { dst = (bfraw*)(ws + (is_ctx ? O_QAC : O_QA)) + ((long)rowbase * 8 + (ct * 2 + wc)) * 64; rstride = 512; }
      else if (ct < 6) { dst = (bfraw*)(ws + (is_ctx ? O_QCC : O_QC)) + ((long)rowbase * 4 + ((ct - 4) * 2 + wc)) * 64; rstride = 256; }
      else {
        const int slot0 = is_ctx ? tbase : CTX + tbase;
        dst = (bfraw*)(ws + (ct == 10 ? O_KA : O_KC)) + ((long)(b * 2 + wc) * KS + slot0) * 64; rstride = 64;
      }
      float g4[4];
#pragma unroll
      for (int n = 0; n < 4; ++n) g4[n] = donorm ? gn[n * 16 + fr] : 1.f;
#pragma unroll
      for (int m = 0; m < 4; ++m)
#pragma unroll
        for (int j = 0; j < 4; ++j) {
          const int rl = m * 16 + fq * 4 + j;
          float xv[4];
#pragma unroll
          for (int n = 0; n < 4; ++n) xv[n] = acc[m][n][j];
          if (donorm) {
            float ss = xv[0] * xv[0] + xv[1] * xv[1] + xv[2] * xv[2] + xv[3] * xv[3];
            ss += __shfl_xor(ss, 1); ss += __shfl_xor(ss, 2); ss += __shfl_xor(ss, 4); ss += __shfl_xor(ss, 8);
            const float rs = rsqrtf(ss * (1.f / 64.f) + 1e-6f);
#pragma unroll
            for (int n = 0; n < 4; ++n) xv[n] = xv[n] * rs * g4[n];
          }
          if (!is_ctx) {
            const int t = tbase + rl;
            const int pr = t >> 6, pc = t & 63;
            const float c0 = rope[pr * 16 + fr], s0 = rope[1024 + pr * 16 + fr];
            const float c1 = rope[pc * 16 + fr], s1 = rope[1024 + pc * 16 + fr];
            const float y0 = xv[0] * c0 - xv[1] * s0, y1 = xv[1] * c0 + xv[0] * s0;
            const float y2 = xv[2] * c1 - xv[3] * s1, y3 = xv[3] * c1 + xv[2] * s1;
            xv[0] = y0; xv[1] = y1; xv[2] = y2; xv[3] = y3;
          }
          bfraw* d = dst + (long)rl * rstride + fr;
#pragma unroll
          for (int n = 0; n < 4; ++n) d[n * 16] = f2bf(xv[n]);
        }
    } else {
      bfraw* dst;
      long cstride;
      if (kind == 1) {
        const int slot0 = is_ctx ? tbase : CTX + tbase;
        dst = (bfraw*)(ws + (ct == 11 ? O_VAT : O_VCT)) + (long)(b * 2 + wc) * 64 * KS + slot0;
        cstride = KS;
      } else {
        const int ncol0 = ((ct - 6) & 1) * 128 + wc * 64;
        const int koff = (ct >= 8) ? T : 0;
        if (is_ctx) { dst = (bfraw*)(ws + O_VTFC) + ((long)b * 256 + ncol0) * 512 + koff + tbase; cstride = 512; }
        else { dst = (bfraw*)(ws + O_VTF) + ((long)b * 256 + ncol0) * 8192 + koff + tbase; cstride = 8192; }
      }
#pragma unroll
      for (int m = 0; m < 4; ++m)
#pragma unroll
        for (int n = 0; n < 4; ++n) {
          uint2 st;
          st.x = pack2(acc[m][n][0], acc[m][n][1]);
          st.y = pack2(acc[m][n][2], acc[m][n][3]);
          *(uint2*)(dst + (long)(n * 16 + fr) * cstride + m * 16 + fq * 4) = st;
        }
    }
  });
}

DI void phase_proj(const Params& p, int layer, char* lds, int tid) {
  const int n_lat = 256 * 14;
  const int nct_ctx = (layer == 0) ? 14 : 4;
  const int n_ctx = 16 * nct_ctx;
  for (int item = blockIdx.x; item < n_lat + n_ctx; item += gridDim.x) {
    if (item < n_lat) proj_item(p, layer, false, item / 14, item % 14, lds, tid);
    else {
      const int r = item - n_lat;
      const int rt = r / nct_ctx, ct = (layer == 0) ? (r % nct_ctx) : (10 + r % nct_ctx);
      proj_item(p, layer, true, rt, ct, lds, tid);
    }
  }
}

DI void four_item(const Params& p, int layer, bool is_ctx, int b, int rt, int ct, char* lds, int tid) {
  const int T = is_ctx ? CTX : SEQ;
  const int K = 2 * T;
  const bfraw* A = (const bfraw*)(p.ws + (is_ctx ? O_DFTC : O_DFT));
  const bfraw* Bt = (const bfraw*)(p.ws + (is_ctx ? O_VTFC : O_VTF)) + (long)b * 256 * K;
  const int r0 = tid >> 2, c8 = (tid & 3) * 8;
  const bfraw* a0 = A + (long)(rt * 128 + r0) * K + c8;
  const bfraw* a1 = a0 + 64l * K;
  const bfraw* b0 = Bt + (long)(ct * 128 + r0) * K + c8;
  const bfraw* b1 = b0 + 64l * K;
  bfraw* MIX = (bfraw*)(p.ws + (is_ctx ? O_MIXC : O_MIX)) + (long)b * T * 1024;
  const float scale = is_ctx ? (1.f / 128.f) : (1.f / 512.f);
  const float* bias = p.b_four + layer * 256;
  gemm_tile(a0, a1, b0, b1, K, lds, tid, [&](f32x4 (&acc)[4][4], int wr, int wc, int fr, int fq) {
#pragma unroll
    for (int m = 0; m < 4; ++m)
#pragma unroll
      for (int n = 0; n < 4; ++n) {
        const int ncol = ct * 128 + wc * 64 + n * 16 + fr;
        const float bv = bias[ncol];
#pragma unroll
        for (int j = 0; j < 4; ++j) {
          const int t = rt * 128 + wr * 64 + m * 16 + fq * 4 + j;
          MIX[(long)t * 1024 + 512 + ncol] = f2bf(acc[m][n][j] * scale + bv);
        }
      }
  });
}

DI void phase_mix(const Params& p, int layer, char* lds, int tid) {
  char* ws = p.ws;
  const int nF = 512, nA = 2048, nC = 1024;
  const int nFc = (layer == 0) ? 32 : 0, nAc = (layer == 0) ? 128 : 0, nCc = (layer == 0) ? 64 : 0;
  const int total = nF + nA + nC + nFc + nAc + nCc;
  for (int item = blockIdx.x; item < total; item += gridDim.x) {
    int it = item;
    if (it < nF) { four_item(p, layer, false, it >> 6, (it >> 1) & 31, it & 1, lds, tid); continue; }
    it -= nF;
    if (it < nA) {
      const int b = it >> 8, h = (it >> 5) & 7, qb = it & 31;
      const bfraw* Qp = (const bfraw*)(ws + O_QA) + ((long)(b * SEQ + qb * 128) * 8 + h) * 64;
      const bfraw* Kp = (const bfraw*)(ws + O_KA) + (long)(b * 2 + (h >> 2)) * KS * 64;
      const bfraw* Vp = (const bfraw*)(ws + O_VAT) + (long)(b * 2 + (h >> 2)) * 64 * KS;
      bfraw* Op = (bfraw*)(ws + O_MIX) + (long)(b * SEQ + qb * 128) * 1024 + h * 64;
      attn_item<false>(Qp, 512, Kp, Vp, KS, KS / 64, 0, 0, 0, false, 0.f, Op, 1024, lds, tid);
      continue;
    }
    it -= nA;
    if (it < nC) {
      const int b = it >> 7, h = (it >> 5) & 3, qb = it & 31;
      const bfraw* Qp = (const bfraw*)(ws + O_QC) + ((long)(b * SEQ + qb * 128) * 4 + h) * 64;
      const bfraw* Kp = (const bfraw*)(ws + O_KC) + (long)(b * 2 + (h >> 1)) * KS * 64;
      const bfraw* Vp = (const bfraw*)(ws + O_VCT) + (long)(b * 2 + (h >> 1)) * 64 * KS;
      bfraw* Op = (bfraw*)(ws + O_MIX) + (long)(b * SEQ + qb * 128) * 1024 + 768 + h * 64;
      const int q0 = qb * 128;
      const int lo = (q0 - 128 < 0) ? 0 : q0 - 128;
      const int hi = (q0 + 256 > SEQ) ? SEQ : q0 + 256;
      attn_item<true>(Qp, 256, Kp, Vp, KS, CTX / 64, (CTX + lo) / 64, (hi - lo) / 64, q0, true,
                      p.sink[layer * 4 + h] * LOG2E, Op, 1024, lds, tid);
      continue;
    }
    it -= nC;
    if (it < nFc) { four_item(p, layer, true, it >> 2, (it >> 1) & 1, it & 1, lds, tid); continue; }
    it -= nFc;
    if (it < nAc) {
      const int b = it >> 4, h = (it >> 1) & 7, qb = it & 1;
      const bfraw* Qp = (const bfraw*)(ws + O_QAC) + ((long)(b * CTX + qb * 128) * 8 + h) * 64;
      const bfraw* Kp = (const bfraw*)(ws + O_KA) + (long)(b * 2 + (h >> 2)) * KS * 64;
      const bfraw* Vp = (const bfraw*)(ws + O_VAT) + (long)(b * 2 + (h >> 2)) * 64 * KS;
      bfraw* Op = (bfraw*)(ws + O_MIXC) + (long)(b * CTX + qb * 128) * 1024 + h * 64;
      attn_item<false>(Qp, 512, Kp, Vp, KS, CTX / 64, 0, 0, 0, false, 0.f, Op, 1024, lds, tid);
      continue;
    }
    it -= nAc;
    {
      const int b = it >> 3, h = (it >> 1) & 3, qb = it & 1;
      const bfraw* Qp = (const bfraw*)(ws + O_QCC) + ((long)(b * CTX + qb * 128) * 4 + h) * 64;
      const bfraw* Kp = (const bfraw*)(ws + O_KC) + (long)(b * 2 + (h >> 1)) * KS * 64;
      const bfraw* Vp = (const bfraw*)(ws + O_VCT) + (long)(b * 2 + (h >> 1)) * 64 * KS;
      bfraw* Op = (bfraw*)(ws + O_MIXC) + (long)(b * CTX + qb * 128) * 1024 + 768 + h * 64;
      attn_item<false>(Qp, 256, Kp, Vp, KS, CTX / 64, 0, 0, 0, true, p.sink[layer * 4 + h] * LOG2E, Op, 1024, lds, tid);
    }
  }
}

DI void phase_outproj(const Params& p, int layer, char* lds, int tid) {
  const int n_lat = 256 * 8, n_ctx = (layer == 0) ? 16 * 8 : 0;
  const bfraw* W = (const bfraw*)(p.ws + O_WOUTT) + (long)layer * 1024 * 1024;
  const float* MOD = (const float*)(p.ws + O_MOD);
  for (int item = blockIdx.x; item < n_lat + n_ctx; item += gridDim.x) {
    const bool is_ctx = item >= n_lat;
    const int r = is_ctx ? item - n_lat : item;
    const int rt = r >> 3, ct = r & 7;
    const int T = is_ctx ? CTX : SEQ;
    const bfraw* A = (const bfraw*)(p.ws + (is_ctx ? O_MIXC : O_MIX));
    const float* xin = is_ctx ? p.ctx : (layer == 0 ? p.x : p.out);
    float* X1 = (float*)(p.ws + (is_ctx ? O_X1C : O_X1));
    const int r0 = tid >> 2, c8 = (tid & 3) * 8;
    const bfraw* a0 = A + (long)(rt * 128 + r0) * 1024 + c8;
    const bfraw* a1 = a0 + 64 * 1024;
    const bfraw* b0 = W + (long)(ct * 128 + r0) * 1024 + c8;
    const bfraw* b1 = b0 + 64 * 1024;
    gemm_tile(a0, a1, b0, b1, 1024, lds, tid, [&](f32x4 (&acc)[4][4], int wr, int wc, int fr, int fq) {
      const int rowbase = rt * 128 + wr * 64;
      const int b = is_ctx ? 8 : rowbase / T;
      const float* g1 = MOD + (layer * 9 + b) * 6144 + 2048;
#pragma unroll
      for (int n = 0; n < 4; ++n) {
        const int col = ct * 128 + wc * 64 + n * 16 + fr;
        const float gv = g1[col];
#pragma unroll
        for (int m = 0; m < 4; ++m)
#pragma unroll
          for (int j = 0; j < 4; ++j) {
            const long idx = (long)(rowbase + m * 16 + fq * 4 + j) * 1024 + col;
            X1[idx] = ALPHA * xin[idx] + gv * acc[m][n][j];
          }
      }
    });
  }
}

DI void phase_row(const Params& p, int layer, char* lds, int tid) {
  const int w = tid >> 6, lane = tid & 63;
  float* wrl = (float*)lds;
  __syncthreads();
  {
    const float* wr = p.w_router + (long)layer * 1024 * 16;
    for (int idx = tid; idx < 16384; idx += 256) wrl[(idx & 15) * 1024 + (idx >> 4)] = wr[idx];
  }
  __syncthreads();
  const float* MOD = (const float*)(p.ws + O_MOD);
  const int nrows = NT + ((layer == 0) ? NCT : 0);
  for (int row = blockIdx.x * 4 + w; row < nrows; row += gridDim.x * 4) {
    const bool is_ctx = row >= NT;
    const int rr = is_ctx ? row - NT : row;
    float* X1 = (float*)(p.ws + (is_ctx ? O_X1C : O_X1)) + (long)rr * 1024;
    bfraw* Hd = (bfraw*)(p.ws + (is_ctx ? O_HC : O_H)) + (long)rr * 1024;
    const int T = is_ctx ? CTX : SEQ;
    const int b = rr / T, t = rr - b * T;
    const float* mr = MOD + (layer * 9 + (is_ctx ? 8 : b)) * 6144;
    float v[16];
    load_row16(X1, lane, v);
    postnorm16(v, p.ln1_g + layer * 1024, p.ln1_b + layer * 1024, lane);
    store_row16(X1, lane, v);
    modulate16(v, mr + 3072, mr + 4096, lane);
    store_row16_bf(Hd, lane, v);
    float mylg = -1e30f;
#pragma unroll 2
    for (int e = 0; e < 16; ++e) {
      float s = 0.f;
#pragma unroll
      for (int i = 0; i < 4; ++i) {
        const float4 wv = *(const float4*)(wrl + e * 1024 + i * 256 + lane * 4);
        s += v[i * 4] * wv.x + v[i * 4 + 1] * wv.y + v[i * 4 + 2] * wv.z + v[i * 4 + 3] * wv.w;
      }
      s = wsum(s);
      if (lane == e) mylg = s;
    }
    float mx = mylg;
    mx = fmaxf(mx, __shfl_xor(mx, 1)); mx = fmaxf(mx, __shfl_xor(mx, 2));
    mx = fmaxf(mx, __shfl_xor(mx, 4)); mx = fmaxf(mx, __shfl_xor(mx, 8));
    const float ex = __expf(mylg - mx);
    float den = ex;
    den += __shfl_xor(den, 1); den += __shfl_xor(den, 2); den += __shfl_xor(den, 4); den += __shfl_xor(den, 8);
    const float mine = ex / den;
    if (lane < 16) {
      float* AFF = (float*)(p.ws + (is_ctx ? O_AFFC : O_AFF));
      AFF[((long)b * 16 + lane) * T + t] = mine;
    }
  }
}

DI void topk_item(const Params& p, bool is_ctx, int b, int e, int chunk, char* lds, int tid) {
  const int T = is_ctx ? CTX : SEQ, cap = is_ctx ? CAPC : CAP;
  unsigned* a = (unsigned*)lds;
  const unsigned* AFF = (const unsigned*)(p.ws + (is_ctx ? O_AFFC : O_AFF)) + ((long)b * 16 + e) * T;
  __syncthreads();
  for (int i = tid; i < T; i += 256) a[i] = AFF[i];
  __syncthreads();
  const int i = chunk * 256 + tid;
  const unsigned ai = a[i];
  const int i0 = i & ~63;
  int rank = 0;
  const uint4* a4 = (const uint4*)a;
  for (int j4 = 0; j4 < (i0 >> 2); ++j4) {
    const uint4 v = a4[j4];
    rank += (v.x >= ai) + (v.y >= ai) + (v.z >= ai) + (v.w >= ai);
  }
  for (int j = i0; j < i0 + 64; ++j) {
    const unsigned v = a[j];
    rank += (v > ai) || (v == ai && j < i);
  }
  for (int j4 = (i0 + 64) >> 2; j4 < (T >> 2); ++j4) {
    const uint4 v = a4[j4];
    rank += (v.x > ai) + (v.y > ai) + (v.z > ai) + (v.w > ai);
  }
  short* SLOT = (short*)(p.ws + (is_ctx ? O_SLOTC : O_SLOT));
  if (rank < cap) {
    int* IDX = (int*)(p.ws + (is_ctx ? O_IDXC : O_IDX));
    float* GATE = (float*)(p.ws + (is_ctx ? O_GATEC : O_GATE));
    const int prow = (e * 8 + b) * cap + rank;
    IDX[prow] = i;
    GATE[prow] = __uint_as_float(ai);
    SLOT[((long)b * T + i) * 16 + e] = (short)rank;
  } else {
    SLOT[((long)b * T + i) * 16 + e] = (short)-1;
  }
}

DI void phase_topk(const Params& p, int layer, char* lds, int tid) {
  const int n_lat = 2048, n_ctx = (layer == 0) ? 128 : 0, n_conv = (layer == 1) ? N_EXPCONV : 0;
  for (int item = blockIdx.x; item < n_lat + n_ctx + n_conv; item += gridDim.x) {
    int it = item;
    if (it < n_lat) { topk_item(p, false, it >> 8, (it >> 4) & 15, it & 15, lds, tid); continue; }
    it -= n_lat;
    if (it < n_ctx) { topk_item(p, true, it >> 4, it & 15, 0, lds, tid); continue; }
    it -= n_ctx;
    expconv_item(p, 1, it, lds, tid);
  }
}

DI void phase_moe1(const Params& p, int layer, char* lds, int tid) {
  const bfraw* WGU = (const bfraw*)(p.ws + O_WGU);
  const int n_lat = 16 * 32 * 32, n_ctx = (layer == 0) ? 16 * 32 * 2 : 0;
  for (int item = blockIdx.x; item < n_lat + n_ctx; item += gridDim.x) {
    const bool is_ctx = item >= n_lat;
    const int r = is_ctx ? item - n_lat : item;
    const int RT = is_ctx ? 2 : 32;
    const int cap = is_ctx ? CAPC : CAP, T = is_ctx ? CTX : SEQ;
    const int e = r / (32 * RT), rem = r % (32 * RT), ct = rem / RT, rt = rem % RT;
    const int* IDX = (const int*)(p.ws + (is_ctx ? O_IDXC : O_IDX));
    const bfraw* Hs = (const bfraw*)(p.ws + (is_ctx ? O_HC : O_H));
    bfraw* ACT = (bfraw*)(p.ws + (is_ctx ? O_ACTC : O_ACT));
    const int r0 = tid >> 2, c8 = (tid & 3) * 8;
    const int l0 = rt * 128 + r0, l1 = l0 + 64;
    const int tok0 = IDX[e * 8 * cap + l0], tok1 = IDX[e * 8 * cap + l1];
    const bfraw* a0 = Hs + ((long)(l0 / cap) * T + tok0) * 1024 + c8;
    const bfraw* a1 = Hs + ((long)(l1 / cap) * T + tok1) * 1024 + c8;
    const bfraw* b0 = WGU + ((long)e * 4096 + ct * 128 + r0) * 1024 + c8;
    const bfraw* b1 = b0 + 64 * 1024;
    const long prow0 = (long)e * 8 * cap + rt * 128;
    gemm_tile(a0, a1, b0, b1, 1024, lds, tid, [&](f32x4 (&acc)[4][4], int wr, int wc, int fr, int fq) {
#pragma unroll
      for (int m = 0; m < 4; ++m)
#pragma unroll
        for (int q = 0; q < 2; ++q) {
          const int f = ct * 64 + wc * 32 + q * 16 + fr;
#pragma unroll
          for (int j = 0; j < 4; ++j) {
            const float g = acc[m][2 * q][j], u = acc[m][2 * q + 1][j];
            const float sv = g / (1.f + __expf(-g)) * u;
            ACT[(prow0 + wr * 64 + m * 16 + fq * 4 + j) * FF + f] = f2bf(sv);
          }
        }
    });
  }
}

DI void phase_moe2(const Params& p, int layer, char* lds, int tid) {
  const bfraw* WD = (const bfraw*)(p.ws + O_WD);
  const int n_lat = 16 * 8 * 32, n_ctx = (layer == 0) ? 16 * 8 * 2 : 0;
  for (int item = blockIdx.x; item < n_lat + n_ctx; item += gridDim.x) {
    const bool is_ctx = item >= n_lat;
    const int r = is_ctx ? item - n_lat : item;
    const int RT = is_ctx ? 2 : 32;
    const int cap = is_ctx ? CAPC : CAP;
    const int e = r / (8 * RT), rem = r % (8 * RT), ct = rem / RT, rt = rem % RT;
    const bfraw* ACT = (const bfraw*)(p.ws + (is_ctx ? O_ACTC : O_ACT));
    bfraw* Y = (bfraw*)(p.ws + (is_ctx ? O_YC : O_Y));
    const int r0 = tid >> 2, c8 = (tid & 3) * 8;
    const long prow0 = (long)e * 8 * cap + rt * 128;
    const bfraw* a0 = ACT + (prow0 + r0) * FF + c8;
    const bfraw* a1 = a0 + 64 * FF;
    const bfraw* b0 = WD + ((long)e * 1024 + ct * 128 + r0) * FF + c8;
    const bfraw* b1 = b0 + 64 * FF;
    gemm_tile(a0, a1, b0, b1, FF, lds, tid, [&](f32x4 (&acc)[4][4], int wr, int wc, int fr, int fq) {
#pragma unroll
      for (int m = 0; m < 4; ++m)
#pragma unroll
        for (int n = 0; n < 4; ++n) {
          const int col = ct * 128 + wc * 64 + n * 16 + fr;
#pragma unroll
          for (int j = 0; j < 4; ++j) Y[(prow0 + wr * 64 + m * 16 + fq * 4 + j) * 1024 + col] = f2bf(acc[m][n][j]);
        }
    });
  }
}

DI void phase_combine(const Params& p, int layer, int tid) {
  const int w = tid >> 6, lane = tid & 63;
  const float* MOD = (const float*)(p.ws + O_MOD);
  const int nrows = NT + ((layer == 0) ? NCT : 0);
  for (int row = blockIdx.x * 4 + w; row < nrows; row += gridDim.x * 4) {
    const bool is_ctx = row >= NT;
    const int rr = is_ctx ? row - NT : row;
    const int T = is_ctx ? CTX : SEQ, cap = is_ctx ? CAPC : CAP;
    const int b = rr / T;
    const float* X1 = (const float*)(p.ws + (is_ctx ? O_X1C : O_X1)) + (long)rr * 1024;
    const short* SLOT = (const short*)(p.ws + (is_ctx ? O_SLOTC : O_SLOT)) + (long)rr * 16;
    const float* GATE = (const float*)(p.ws + (is_ctx ? O_GATEC : O_GATE));
    const bfraw* Y = (const bfraw*)(p.ws + (is_ctx ? O_YC : O_Y));
    const float* mr = MOD + (layer * 9 + (is_ctx ? 8 : b)) * 6144;
    float y[16];
#pragma unroll
    for (int i = 0; i < 16; ++i) y[i] = 0.f;
    for (int e = 0; e < 16; ++e) {
      const int s = SLOT[e];
      if (s >= 0) {
        const long prow = (long)(e * 8 + b) * cap + s;
        const float g = GATE[prow];
        const bfraw* yr = Y + prow * 1024;
#pragma unroll
        for (int i = 0; i < 4; ++i) {
          const uint2 u = *(const uint2*)(yr + i * 256 + lane * 4);
          y[i * 4 + 0] += g * bflo(u.x); y[i * 4 + 1] += g * bfhi(u.x);
          y[i * 4 + 2] += g * bflo(u.y); y[i * 4 + 3] += g * bfhi(u.y);
        }
      }
    }
    float v[16], g2[16];
    load_row16(X1, lane, v);
    load_row16(mr + 5120, lane, g2);
#pragma unroll
    for (int i = 0; i < 16; ++i) v[i] = ALPHA * v[i] + g2[i] * y[i];
    postnorm16(v, p.ln2_g + layer * 1024, p.ln2_b + layer * 1024, lane);
    if (!is_ctx) store_row16(p.out + (long)rr * 1024, lane, v);
    if (layer == 0) {
      const float* mn = MOD + (1 * 9 + (is_ctx ? 8 : b)) * 6144;
      modulate16(v, mn, mn + 1024, lane);
      store_row16_bf((bfraw*)(p.ws + (is_ctx ? O_HC : O_H)) + (long)rr * 1024, lane, v);
    }
  }
}

__global__ void __launch_bounds__(256, 2) fwd_kernel(Params p) {
  __shared__ __attribute__((aligned(16))) char smem[65536];
  for (int ph = p.ph_lo; ph < p.ph_hi; ++ph) {
    if (ph > p.ph_lo) cg::this_grid().sync();
    int tid = threadIdx.x;
    asm volatile("" : "+v"(tid));
    if (ph == 0) phase_prep(p, smem, tid);
    else if (ph == 1) phase_lnmod0(p, tid);
    else {
      const int layer = (ph - 2) >> 3, sub = (ph - 2) & 7;
      switch (sub) {
        case 0: phase_proj(p, layer, smem, tid); break;
        case 1: phase_mix(p, layer, smem, tid); break;
        case 2: phase_outproj(p, layer, smem, tid); break;
        case 3: phase_row(p, layer, smem, tid); break;
        case 4: phase_topk(p, layer, smem, tid); break;
        case 5: phase_moe1(p, layer, smem, tid); break;
        case 6: phase_moe2(p, layer, smem, tid); break;
        default: phase_combine(p, layer, tid); break;
      }
    }
  }
}

extern "C" void kernel_launch(void* const* d_in, const int* in_sizes, int n_in, void* d_out, int out_size, void* d_ws,
                              size_t ws_size, hipStream_t stream) {
  (void)in_sizes; (void)n_in; (void)out_size;
  if (ws_size < O_END) { fprintf(stderr, "kernel_launch: workspace too small (%zu < %zu)\n", ws_size, (size_t)O_END); return; }
  Params p{};
  const float** pp = (const float**)&p;
  for (int i = 0; i < 21; ++i) pp[i] = (const float*)d_in[i];
  p.out = (float*)d_out;
  p.ws = (char*)d_ws;
#if ONE_LAUNCH
  static int grid_blocks = 0;
  if (!grid_blocks) {
    int dev = 0, cus = 0, per_cu = 0;
    hipGetDevice(&dev);
    hipDeviceGetAttribute(&cus, hipDeviceAttributeMultiprocessorCount, dev);
    hipOccupancyMaxActiveBlocksPerMultiprocessor(&per_cu, fwd_kernel, 256, 0);
    if (per_cu > 2) per_cu = 2;
    if (per_cu < 1) per_cu = 1;
    grid_blocks = cus * per_cu;
  }
  p.ph_lo = 0; p.ph_hi = NPHASE;
  void* args[] = {&p};
  hipError_t e = hipLaunchCooperativeKernel((void*)fwd_kernel, dim3(grid_blocks), dim3(256), args, 0, stream);
  if (e != hipSuccess) fprintf(stderr, "cooperative launch failed: %s (grid %d)\n", hipGetErrorString(e), grid_blocks);
#else
  for (int ph = 0; ph < NPHASE; ++ph) {
    p.ph_lo = ph; p.ph_hi = ph + 1;
    hipLaunchKernelGGL(fwd_kernel, dim3(512), dim3(256), 0, stream, p);
  }
#endif
}
```

```cpp
#include <hip/hip_runtime.h>
#include <hip/hip_cooperative_groups.h>
#include <cstdio>
namespace cg = cooperative_groups;

#ifndef ONE_LAUNCH
#define ONE_LAUNCH 1
#endif

#define DI __device__ __forceinline__
typedef unsigned short bfraw;
using bf16x8 = __attribute__((ext_vector_type(8))) short;
using f32x4 = __attribute__((ext_vector_type(4))) float;

constexpr int NB = 8, SEQ = 4096, DM = 1024, CTX = 256;
constexpr int NT = NB * SEQ, NCT = NB * CTX;
constexpr int NPROJ = 1792;
constexpr int KS = CTX + SEQ;
constexpr int NE = 16, FF = 2048;
constexpr int CAP = 512, CAPC = 32;
constexpr float ALPHA = 1.41421356237f;
constexpr float LOG2E = 1.44269504089f;
constexpr int NPHASE = 18;
constexpr int NTHR = 512;
constexpr int NWAVE = NTHR / 64;
constexpr int LDS_BYTES = 131072;

constexpr size_t al(size_t x) { return (x + 255) & ~size_t(255); }
constexpr size_t O_MOD = 0;
constexpr size_t O_ROPE = al(O_MOD + 2 * 9 * 6144 * 4);
constexpr size_t O_CTR = al(O_ROPE + 2 * 1024 * 4);
constexpr size_t O_WINT = al(O_CTR + 64 * 4);
constexpr size_t O_WOUTT = al(O_WINT + 2ull * NPROJ * 1024 * 2);
constexpr size_t O_DFT = al(O_WOUTT + 2ull * 1024 * 1024 * 2);
constexpr size_t O_DFTC = al(O_DFT + 4096ull * 8192 * 2);
constexpr size_t O_WGU = al(O_DFTC + 256ull * 512 * 2);
constexpr size_t O_WD = al(O_WGU + 16ull * 4096 * 1024 * 2);
constexpr size_t O_X1 = al(O_WD + 16ull * 1024 * 2048 * 2);
constexpr size_t O_X1C = al(O_X1 + (size_t)NT * 1024 * 4);
constexpr size_t O_H = al(O_X1C + (size_t)NCT * 1024 * 4);
constexpr size_t O_HC = al(O_H + (size_t)NT * 1024 * 2);
constexpr size_t O_AFF = al(O_HC + (size_t)NCT * 1024 * 2);
constexpr size_t O_AFFC = al(O_AFF + 8ull * 16 * 4096 * 4);
constexpr size_t O_IDX = al(O_AFFC + 8ull * 16 * 256 * 4);
constexpr size_t O_GATE = al(O_IDX + 16ull * 8 * 512 * 4);
constexpr size_t O_SLOT = al(O_GATE + 16ull * 8 * 512 * 4);
constexpr size_t O_IDXC = al(O_SLOT + 8ull * 4096 * 16 * 2);
constexpr size_t O_GATEC = al(O_IDXC + 16ull * 8 * 32 * 4);
constexpr size_t O_SLOTC = al(O_GATEC + 16ull * 8 * 32 * 4);
constexpr size_t O_Y = al(O_SLOTC + 8ull * 256 * 16 * 2);
constexpr size_t O_YC = al(O_Y + 65536ull * 1024 * 2);
constexpr size_t O_ACTC = al(O_YC + 4096ull * 1024 * 2);
constexpr size_t O_R = al(O_ACTC + 4096ull * 2048 * 2);
constexpr size_t O_ACT = O_R;
constexpr size_t O_QA = O_R;
constexpr size_t O_QC = al(O_QA + (size_t)NT * 512 * 2);
constexpr size_t O_KA = al(O_QC + (size_t)NT * 256 * 2);
constexpr size_t O_VAT = al(O_KA + 8ull * 2 * KS * 64 * 2);
constexpr size_t O_KC = al(O_VAT + 8ull * 2 * KS * 64 * 2);
constexpr size_t O_VCT = al(O_KC + 8ull * 2 * KS * 64 * 2);
constexpr size_t O_VTF = al(O_VCT + 8ull * 2 * KS * 64 * 2);
constexpr size_t O_MIX = al(O_VTF + 8ull * 256 * 8192 * 2);
constexpr size_t O_QAC = al(O_MIX + (size_t)NT * 1024 * 2);
constexpr size_t O_QCC = al(O_QAC + (size_t)NCT * 512 * 2);
constexpr size_t O_VTFC = al(O_QCC + (size_t)NCT * 256 * 2);
constexpr size_t O_MIXC = al(O_VTFC + 8ull * 256 * 512 * 2);
constexpr size_t O_REND = al(O_MIXC + (size_t)NCT * 1024 * 2);
constexpr size_t O_END = O_R + 65536ull * 2048 * 2;
static_assert(O_REND <= O_END, "mixer buffers must fit in the ACT region");
static_assert(O_END <= 1073741824ull, "workspace too large");

struct Params {
  const float *x, *c, *ctx, *c_ctx, *w_mod, *b_mod, *w_in, *q_norm, *k_norm, *w_four, *b_four, *sink, *w_out,
      *ln1_g, *ln1_b, *w_router, *w_gate, *w_up, *w_down, *ln2_g, *ln2_b;
  float* out;
  char* ws;
  int ph_lo, ph_hi;
};

typedef __bf16 hwbf2 __attribute__((ext_vector_type(2)));
typedef float hwf2 __attribute__((ext_vector_type(2)));
DI unsigned pack2(float a, float b) {
  hwf2 f = {a, b};
  return __builtin_bit_cast(unsigned, __builtin_convertvector(f, hwbf2));
}
DI bfraw f2bf(float x) { return (bfraw)(pack2(x, 0.f) & 0xffffu); }
DI float bflo(unsigned u) { return __uint_as_float(u << 16); }
DI float bfhi(unsigned u) { return __uint_as_float(u & 0xffff0000u); }
DI float wsum(float v) {
#pragma unroll
  for (int o = 32; o; o >>= 1) v += __shfl_xor(v, o);
  return v;
}
DI void glds16(const void* g, char* l) {
  __builtin_amdgcn_global_load_lds((const unsigned*)g, (unsigned*)l, 16, 0, 0);
}
DI void wait_vm0() { asm volatile("s_waitcnt vmcnt(0)" ::: "memory"); }
DI f32x4 mfma16(bf16x8 a, bf16x8 b, f32x4 c) { return __builtin_amdgcn_mfma_f32_16x16x32_bf16(a, b, c, 0, 0, 0); }

DI int next_item(unsigned* ctr, int* s_item, int tid) {
  __syncthreads();
  if (tid == 0) *s_item = (int)atomicAdd(ctr, 1u);
  __syncthreads();
  return *s_item;
}

DI void gemm_stage(const bfraw* a0, const bfraw* a1, const bfraw* b0, const bfraw* b1, int k0, char* st, int tid) {
#pragma unroll
  for (int i = 0; i < 4; ++i) {
    const bfraw* ga = ((i & 1) ? a1 : a0) + k0 + (i >> 1) * 32;
    glds16(ga, st + (i * NTHR + tid) * 16);
  }
#pragma unroll
  for (int i = 0; i < 4; ++i) {
    const bfraw* gb = ((i & 1) ? b1 : b0) + k0 + (i >> 1) * 32;
    glds16(gb, st + 32768 + (i * NTHR + tid) * 16);
  }
}

template <bool SWAP, class Epi>
DI void gemm_tile(const bfraw* a0, const bfraw* a1, const bfraw* b0, const bfraw* b1, int K, char* lds, int tid, Epi epi) {
  asm volatile("" : "+v"(tid));
  const int w = tid >> 6, lane = tid & 63, wr = w >> 2, wc = w & 3, fr = lane & 15, fq = lane >> 4;
  f32x4 acc[8][4];
#pragma unroll
  for (int m = 0; m < 8; ++m)
#pragma unroll
    for (int n = 0; n < 4; ++n) acc[m][n] = f32x4{0.f, 0.f, 0.f, 0.f};
  const int nk = K >> 6;
  __syncthreads();
  gemm_stage(a0, a1, b0, b1, 0, lds, tid);
#pragma unroll 1
  for (int kt = 0; kt < nk; ++kt) {
    wait_vm0();
    __syncthreads();
    if (kt + 1 < nk) gemm_stage(a0, a1, b0, b1, (kt + 1) * 64, lds + ((kt + 1) & 1) * 65536, tid);
    const char* sA = lds + (kt & 1) * 65536;
    const char* sB = sA + 32768;
#pragma unroll
    for (int h = 0; h < 2; ++h) {
      bf16x8 bfr[4];
#pragma unroll
      for (int n = 0; n < 4; ++n) bfr[n] = *(const bf16x8*)(sB + h * 16384 + (wc * 64 + n * 16 + fr) * 64 + fq * 16);
#pragma unroll
      for (int m = 0; m < 8; ++m) {
        const bf16x8 af = *(const bf16x8*)(sA + h * 16384 + (wr * 128 + m * 16 + fr) * 64 + fq * 16);
#pragma unroll
        for (int n = 0; n < 4; ++n) acc[m][n] = SWAP ? mfma16(bfr[n], af, acc[m][n]) : mfma16(af, bfr[n], acc[m][n]);
      }
    }
  }
  epi(acc, wr, wc, fr, fq);
}

DI void attn_stage(const bfraw* Kp, const bfraw* VTp, int ldv, int tile, char* st, int tid) {
  const int slot0 = tile * 64;
  const int h = tid >> 8, r = (tid & 255) >> 2, c8 = (tid & 3) * 8;
  glds16(Kp + (long)(slot0 + r) * 64 + h * 32 + c8, st + tid * 16);
  glds16(VTp + (long)r * ldv + slot0 + h * 32 + c8, st + 8192 + tid * 16);
}

template <bool WINDOW>
DI void attn_item(const bfraw* Qp, int qstride, const bfraw* Kp, const bfraw* VTp, int ldv, int n1, int tlo, int n2,
                  int qpos0, bool has_sink, float sink_l2, bfraw* Op, int ostride, char* lds, int tid) {
  asm volatile("" : "+v"(tid));
  const int w = tid >> 6, lane = tid & 63, fr = lane & 15, fq = lane >> 4;
  const float scale_l2 = 0.125f * LOG2E;
  bf16x8 qf[2][2];
#pragma unroll
  for (int n = 0; n < 2; ++n)
#pragma unroll
    for (int sd = 0; sd < 2; ++sd)
      qf[n][sd] = *(const bf16x8*)(Qp + (long)(w * 32 + n * 16 + fr) * qstride + sd * 32 + fq * 8);
  float m_run[2], l_run[2];
  f32x4 o[4][2];
#pragma unroll
  for (int n = 0; n < 2; ++n) {
    m_run[n] = has_sink ? sink_l2 : -1e30f;
    l_run[n] = (has_sink && fq == 0) ? 1.f : 0.f;
#pragma unroll
    for (int md = 0; md < 4; ++md) o[md][n] = f32x4{0.f, 0.f, 0.f, 0.f};
  }
  const int nt = n1 + n2;
  __syncthreads();
  attn_stage(Kp, VTp, ldv, (0 < n1) ? 0 : tlo, lds, tid);
#pragma unroll 1
  for (int it = 0; it < nt; ++it) {
    wait_vm0();
    __syncthreads();
    if (it + 1 < nt) {
      const int nx = it + 1;
      attn_stage(Kp, VTp, ldv, (nx < n1) ? nx : tlo + (nx - n1), lds + (nx & 1) * 16384, tid);
    }
    const char* sK = lds + (it & 1) * 16384;
    const char* sV = sK + 8192;
    f32x4 s[4][2];
#pragma unroll
    for (int m = 0; m < 4; ++m)
#pragma unroll
      for (int n = 0; n < 2; ++n) s[m][n] = f32x4{0.f, 0.f, 0.f, 0.f};
#pragma unroll
    for (int sd = 0; sd < 2; ++sd) {
#pragma unroll
      for (int m = 0; m < 4; ++m) {
        const int krow = (m >> 1) * 32 + (fr >> 2) * 8 + (m & 1) * 4 + (fr & 3);
        bf16x8 kf = *(const bf16x8*)(sK + sd * 4096 + krow * 64 + fq * 16);
#pragma unroll
        for (int n = 0; n < 2; ++n) s[m][n] = mfma16(kf, qf[n][sd], s[m][n]);
      }
    }
    const int tile = (it < n1) ? it : tlo + (it - n1);
    const bool domask = WINDOW && (it >= n1);
#pragma unroll
    for (int n = 0; n < 2; ++n) {
      if (domask) {
        const int qpos = qpos0 + w * 32 + n * 16 + fr;
#pragma unroll
        for (int m = 0; m < 4; ++m)
#pragma unroll
          for (int j = 0; j < 4; ++j) {
            const int kpos = tile * 64 - CTX + (m >> 1) * 32 + fq * 8 + (m & 1) * 4 + j;
            const int d = qpos - kpos;
            if (d > 128 || d < -128) s[m][n][j] = -1e30f;
          }
      }
      float mx = -1e30f;
#pragma unroll
      for (int m = 0; m < 4; ++m) {
        mx = fmaxf(mx, fmaxf(s[m][n][0], s[m][n][1]));
        mx = fmaxf(mx, fmaxf(s[m][n][2], s[m][n][3]));
      }
      mx = fmaxf(mx, __shfl_xor(mx, 16));
      mx = fmaxf(mx, __shfl_xor(mx, 32));
      const float mxs = mx * scale_l2;
      const bool need = mxs > m_run[n] + 8.f;
      if (__any(need)) {
        const float m_new = need ? mxs : m_run[n];
        const float alpha = __builtin_amdgcn_exp2f(m_run[n] - m_new);
        m_run[n] = m_new;
        l_run[n] *= alpha;
#pragma unroll
        for (int md = 0; md < 4; ++md) {
          o[md][n][0] *= alpha; o[md][n][1] *= alpha; o[md][n][2] *= alpha; o[md][n][3] *= alpha;
        }
      }
      const float nm = -m_run[n];
      float ls = 0.f;
#pragma unroll
      for (int m = 0; m < 4; ++m)
#pragma unroll
        for (int j = 0; j < 4; ++j) {
          const float p = __builtin_amdgcn_exp2f(__builtin_fmaf(s[m][n][j], scale_l2, nm));
          s[m][n][j] = p;
          ls += p;
        }
      l_run[n] += ls;
    }
#pragma unroll
    for (int ks = 0; ks < 2; ++ks) {
      bf16x8 pf[2];
#pragma unroll
      for (int n = 0; n < 2; ++n) {
        const unsigned u0 = pack2(s[2 * ks][n][0], s[2 * ks][n][1]);
        const unsigned u1 = pack2(s[2 * ks][n][2], s[2 * ks][n][3]);
        const unsigned u2 = pack2(s[2 * ks + 1][n][0], s[2 * ks + 1][n][1]);
        const unsigned u3 = pack2(s[2 * ks + 1][n][2], s[2 * ks + 1][n][3]);
        const uint4 uu = make_uint4(u0, u1, u2, u3);
        pf[n] = __builtin_bit_cast(bf16x8, uu);
      }
#pragma unroll
      for (int md = 0; md < 4; ++md) {
        bf16x8 vf = *(const bf16x8*)(sV + ks * 4096 + (md * 16 + fr) * 64 + fq * 16);
#pragma unroll
        for (int n = 0; n < 2; ++n) o[md][n] = mfma16(vf, pf[n], o[md][n]);
      }
    }
  }
#pragma unroll
  for (int n = 0; n < 2; ++n) {
    float l = l_run[n];
    l += __shfl_xor(l, 16);
    l += __shfl_xor(l, 32);
    const float inv = 1.f / l;
    bfraw* orow = Op + (long)(w * 32 + n * 16 + fr) * ostride;
#pragma unroll
    for (int md = 0; md < 4; ++md) {
      uint2 st;
      st.x = pack2(o[md][n][0] * inv, o[md][n][1] * inv);
      st.y = pack2(o[md][n][2] * inv, o[md][n][3] * inv);
      *(uint2*)(orow + md * 16 + fq * 4) = st;
    }
  }
}

DI void xpose_tile(const float* src, long ld_src, bfraw* dst, long ld_dst, int mode, char* lds, int tid) {
  float(*t)[65] = (float(*)[65])lds;
  __syncthreads();
  {
    const int c = tid & 63, r0 = tid >> 6;
#pragma unroll 4
    for (int rr = r0; rr < 64; rr += NWAVE) t[rr][c] = src[(long)rr * ld_src + c];
  }
  __syncthreads();
  {
    const int k8 = (tid & 7) * 8, nn = tid >> 3;
    uint4 v;
    v.x = pack2(t[k8 + 0][nn], t[k8 + 1][nn]);
    v.y = pack2(t[k8 + 2][nn], t[k8 + 3][nn]);
    v.z = pack2(t[k8 + 4][nn], t[k8 + 5][nn]);
    v.w = pack2(t[k8 + 6][nn], t[k8 + 7][nn]);
    const int row = (mode == 0) ? nn : ((nn >> 4) * 32 + (mode == 2 ? 16 : 0) + (nn & 15));
    *(uint4*)(dst + (long)row * ld_dst + k8) = v;
  }
}

constexpr int N_EXPCONV = 16384 + 8192;
DI void expconv_item(const Params& p, int layer, int item, char* lds, int tid) {
  bfraw* WGU = (bfraw*)(p.ws + O_WGU);
  bfraw* WD = (bfraw*)(p.ws + O_WD);
  if (item < 16384) {
    const int type = item & 1;
    int r = item >> 1;
    const int nt = r & 31; r >>= 5;
    const int kt = r & 15; const int e = r >> 4;
    const float* src = (type ? p.w_up : p.w_gate) + ((long)(layer * NE + e) * DM + kt * 64) * FF + nt * 64;
    bfraw* dst = WGU + ((long)e * 4096 + nt * 128) * DM + kt * 64;
    xpose_tile(src, FF, dst, DM, 1 + type, lds, tid);
  } else {
    int r = item - 16384;
    const int nt = r & 15; r >>= 4;
    const int kt = r & 31; const int e = r >> 5;
    const float* src = p.w_down + ((long)(layer * NE + e) * FF + kt * 64) * DM + nt * 64;
    bfraw* dst = WD + ((long)e * DM + nt * 64) * FF + kt * 64;
    xpose_tile(src, DM, dst, FF, 0, lds, tid);
  }
}

DI void prep_mod_item(const Params& p, int item, char* lds, int tid) {
  const int layer = item / 96, chunk = item % 96;
  float* sc = (float*)lds;
  float* red = (float*)(lds + 36864);
  __syncthreads();
  for (int idx = tid; idx < 9 * 1024; idx += NTHR) {
    const int r = idx >> 10, k = idx & 1023;
    const float v = (r < 8) ? p.c[r * 1024 + k] : p.c_ctx[k];
    sc[idx] = v / (1.f + __expf(-v));
  }
  __syncthreads();
  const int w = tid >> 6, lane = tid & 63;
  const int col = chunk * 64 + lane;
  float acc[9];
#pragma unroll
  for (int r = 0; r < 9; ++r) acc[r] = 0.f;
  const float* wp = p.w_mod + ((long)layer * 1024 + w * 128) * 6144 + col;
#pragma unroll 4
  for (int k = 0; k < 128; ++k) {
    const float wv = wp[(long)k * 6144];
#pragma unroll
    for (int r = 0; r < 9; ++r) acc[r] += sc[r * 1024 + w * 128 + k] * wv;
  }
#pragma unroll
  for (int r = 0; r < 9; ++r) red[(w * 9 + r) * 64 + lane] = acc[r];
  __syncthreads();
  float* MOD = (float*)(p.ws + O_MOD);
  for (int idx = tid; idx < 9 * 64; idx += NTHR) {
    const int r = idx >> 6, l = idx & 63;
    float s = p.b_mod[layer * 6144 + chunk * 64 + l];
#pragma unroll
    for (int ww = 0; ww < NWAVE; ++ww) s += red[(ww * 9 + r) * 64 + l];
    MOD[(layer * 9 + r) * 6144 + chunk * 64 + l] = s;
  }
}

DI void prep_four_item(const Params& p, int item, char* lds, int tid) {
  const int layer = item >> 6, g = (item >> 4) & 3, kt = item & 15;
  float* G = (float*)lds;
  float(*Wt)[65] = (float(*)[65])(lds + 32768);
  float* ctab = (float*)(lds + 32768 + 64 * 65 * 4);
  __syncthreads();
  const float* wg = p.w_four + (long)(layer * 4 + g) * 4096;
  for (int idx = tid; idx < 4096; idx += NTHR) Wt[idx >> 6][idx & 63] = wg[idx];
  if (tid < 64) {
    float sn, cs;
    sincospif((float)tid / 32.f, &sn, &cs);
    ctab[tid] = cs;
    ctab[64 + tid] = sn;
  }
  __syncthreads();
  for (int o = tid; o < 4096; o += NTHR) {
    const int c = o >> 6, d = o & 63;
    float s1 = 0.f, s2 = 0.f;
#pragma unroll 4
    for (int c2 = 0; c2 < 64; ++c2) {
      const int a = (c * c2) & 63;
      const float wv = Wt[c2][d];
      s1 += ctab[a] * wv;
      s2 += ctab[64 + a] * wv;
    }
    G[o] = s1;
    G[4096 + o] = s2;
  }
  __syncthreads();
  const float* wi = p.w_in + ((long)layer * 1024 + kt * 64) * 1536 + 768 + g * 64;
  for (int idx = tid; idx < 4096; idx += NTHR) Wt[idx >> 6][idx & 63] = wi[(long)(idx >> 6) * 1536 + (idx & 63)];
  __syncthreads();
  bfraw* WINT = (bfraw*)(p.ws + O_WINT) + (long)layer * NPROJ * 1024;
  for (int o = tid; o < 64 * 128; o += NTHR) {
    const int kk = o & 63, dcol = o >> 6;
    const float* Gs = G + (dcol >> 6) * 4096 + (dcol & 63);
    float s = 0.f;
#pragma unroll 4
    for (int c = 0; c < 64; ++c) s += Wt[kk][c] * Gs[c * 64];
    const int row = (dcol < 64) ? (768 + g * 64 + dcol) : (1024 + g * 64 + (dcol - 64));
    WINT[(long)row * 1024 + kt * 64 + kk] = f2bf(s);
  }
}

constexpr int P0_MOD = 192, P0_FOUR = 128, P0_ROPE = 1, P0_DFTC = 256, P0_DFT = 4096, P0_WIN = 2 * 16 * 24, P0_WOUT = 2 * 16 * 16;
constexpr int P0_TOTAL = P0_MOD + P0_FOUR + P0_ROPE + P0_DFTC + P0_DFT + P0_WIN + P0_WOUT + N_EXPCONV;

DI void phase_prep(const Params& p, char* lds, int tid) {
  if (blockIdx.x == 0 && tid < 64) ((unsigned*)(p.ws + O_CTR))[tid] = 0u;
  for (int item = blockIdx.x; item < P0_TOTAL; item += gridDim.x) {
    int it = item;
    if (it < P0_MOD) { prep_mod_item(p, it, lds, tid); continue; }
    it -= P0_MOD;
    if (it < P0_FOUR) { prep_four_item(p, it, lds, tid); continue; }
    it -= P0_FOUR;
    if (it < P0_ROPE) {
      float* rope = (float*)(p.ws + O_ROPE);
      for (int idx = tid; idx < 1024; idx += NTHR) {
        const int pos = idx >> 4, f = idx & 15;
        const float inv_freq = powf(10000.f, -(float)f / 16.f);
        const float ang = (float)pos * inv_freq;
        rope[idx] = cosf(ang);
        rope[1024 + idx] = sinf(ang);
      }
      continue;
    }
    it -= P0_ROPE;
    if (it < P0_DFTC) {
      bfraw* D = (bfraw*)(p.ws + O_DFTC) + (long)it * 512;
      for (int k = tid; k < 512; k += NTHR) {
        const int kk = k & 255;
        float sn, cs;
        sincospif((float)((it * kk) & 255) / 128.f, &sn, &cs);
        D[k] = f2bf(k < 256 ? cs : -sn);
      }
      continue;
    }
    it -= P0_DFTC;
    if (it < P0_DFT) {
      bfraw* D = (bfraw*)(p.ws + O_DFT) + (long)it * 8192;
      for (int ch = tid; ch < 4096; ch += NTHR) {
        const int k = ch * 2, kk = k & 4095;
        float sn0, cs0, sn1, cs1;
        sincospif((float)((it * kk) & 4095) / 2048.f, &sn0, &cs0);
        sincospif((float)((it * (kk + 1)) & 4095) / 2048.f, &sn1, &cs1);
        *(unsigned*)(D + k) = (k < 4096) ? pack2(cs0, cs1) : pack2(-sn0, -sn1);
      }
      continue;
    }
    it -= P0_DFT;
    if (it < P0_WIN) {
      const int layer = it / 384, r = it % 384, kt = r / 24, nt = r % 24;
      if (nt >= 12 && nt < 16) continue;
      const int col = nt * 64;
      int drow;
      if (col < 768) drow = col;
      else if (col < 1152) drow = col + 256;
      else if (col < 1280) drow = col + 384;
      else if (col < 1408) drow = col + 128;
      else drow = col + 256;
      const float* src = p.w_in + ((long)layer * 1024 + kt * 64) * 1536 + col;
      bfraw* dst = (bfraw*)(p.ws + O_WINT) + ((long)layer * NPROJ + drow) * 1024 + kt * 64;
      xpose_tile(src, 1536, dst, 1024, 0, lds, tid);
      continue;
    }
    it -= P0_WIN;
    if (it < P0_WOUT) {
      const int layer = it >> 8, r = it & 255, kt = r >> 4, nt = r & 15;
      const float* src = p.w_out + ((long)layer * 1024 + kt * 64) * 1024 + nt * 64;
      bfraw* dst = (bfraw*)(p.ws + O_WOUTT) + ((long)layer * 1024 + nt * 64) * 1024 + kt * 64;
      xpose_tile(src, 1024, dst, 1024, 0, lds, tid);
      continue;
    }
    it -= P0_WOUT;
    expconv_item(p, 0, it, lds, tid);
  }
}

DI void ln_stats(const float v[16], float& mean, float& rstd) {
  float s = 0.f;
#pragma unroll
  for (int i = 0; i < 16; ++i) s += v[i];
  mean = wsum(s) * (1.f / 1024.f);
  float q = 0.f;
#pragma unroll
  for (int i = 0; i < 16; ++i) { const float d = v[i] - mean; q += d * d; }
  rstd = rsqrtf(wsum(q) * (1.f / 1024.f) + 1e-5f);
}
DI void load_row16(const float* src, int lane, float v[16]) {
#pragma unroll
  for (int i = 0; i < 4; ++i) {
    const float4 t = *(const float4*)(src + i * 256 + lane * 4);
    v[i * 4 + 0] = t.x; v[i * 4 + 1] = t.y; v[i * 4 + 2] = t.z; v[i * 4 + 3] = t.w;
  }
}
DI void store_row16(float* dst, int lane, const float v[16]) {
#pragma unroll
  for (int i = 0; i < 4; ++i) *(float4*)(dst + i * 256 + lane * 4) = make_float4(v[i * 4], v[i * 4 + 1], v[i * 4 + 2], v[i * 4 + 3]);
}
DI void store_row16_bf(bfraw* dst, int lane, const float v[16]) {
#pragma unroll
  for (int i = 0; i < 4; ++i) {
    uint2 st;
    st.x = pack2(v[i * 4], v[i * 4 + 1]);
    st.y = pack2(v[i * 4 + 2], v[i * 4 + 3]);
    *(uint2*)(dst + i * 256 + lane * 4) = st;
  }
}
DI void modulate16(float v[16], const float* sh, const float* sc, int lane) {
  float mean, rstd;
  ln_stats(v, mean, rstd);
  float a[16], b[16];
  load_row16(sh, lane, a);
  load_row16(sc, lane, b);
#pragma unroll
  for (int i = 0; i < 16; ++i) v[i] = (v[i] - mean) * rstd * (1.f + b[i]) + a[i];
}
DI void postnorm16(float v[16], const float* g, const float* bb, int lane) {
  float mean, rstd;
  ln_stats(v, mean, rstd);
  float a[16], b[16];
  load_row16(g, lane, a);
  load_row16(bb, lane, b);
#pragma unroll
  for (int i = 0; i < 16; ++i) v[i] = (v[i] - mean) * rstd * a[i] + b[i];
}

DI void phase_lnmod0(const Params& p, int tid) {
  const int w = tid >> 6, lane = tid & 63;
  const float* MOD = (const float*)(p.ws + O_MOD);
  for (int row = blockIdx.x * NWAVE + w; row < NT + NCT; row += gridDim.x * NWAVE) {
    float v[16];
    if (row < NT) {
      load_row16(p.x + (long)row * 1024, lane, v);
      const float* mr = MOD + (0 * 9 + row / SEQ) * 6144;
      modulate16(v, mr, mr + 1024, lane);
      store_row16_bf((bfraw*)(p.ws + O_H) + (long)row * 1024, lane, v);
    } else {
      const int rc = row - NT;
      load_row16(p.ctx + (long)rc * 1024, lane, v);
      const float* mr = MOD + (0 * 9 + 8) * 6144;
      modulate16(v, mr, mr + 1024, lane);
      store_row16_bf((bfraw*)(p.ws + O_HC) + (long)rc * 1024, lane, v);
    }
  }
}

DI void proj_item(const Params& p, int layer, bool is_ctx, int rt, int ct, char* lds, int tid) {
  const int T = is_ctx ? CTX : SEQ;
  const bfraw* Hs = (const bfraw*)(p.ws + (is_ctx ? O_HC : O_H));
  const bfraw* W = (const bfraw*)(p.ws + O_WINT) + (long)layer * NPROJ * 1024;
  const int r0 = tid >> 2, c8 = (tid & 3) * 8;
  const bfraw* a0 = Hs + (long)(rt * 256 + r0) * 1024 + c8;
  const bfraw* a1 = a0 + 128 * 1024;
  const bfraw* b0 = W + (long)(ct * 256 + r0) * 1024 + c8;
  const bfraw* b1 = b0 + 128 * 1024;
  char* ws = p.ws;
  if (ct <= 2 || ct == 5) {
    const float* rope = (const float*)(ws + O_ROPE);
    gemm_tile<true>(a0, a1, b0, b1, 1024, lds, tid, [&](f32x4 (&acc)[8][4], int wr, int wc, int fr, int fq) {
      const int rowbase = rt * 256 + wr * 128;
      const int b = rowbase / T;
      const int tbase = rowbase - b * T;
      const bool donorm = (ct < 2) || (ct == 5 && wc < 2);
      const float* gn = ((ct < 2) ? p.q_norm : p.k_norm) + layer * 64;
      bfraw* dst;
      long rstride;
      if (ct < 2) { dst = (bfraw*)(ws + (is_ctx ? O_QAC : O_QA)) + ((long)rowbase * 8 + (ct * 4 + wc)) * 64; rstride = 512; }
      else if (ct == 2) { dst = (bfraw*)(ws + (is_ctx ? O_QCC : O_QC)) + ((long)rowbase * 4 + wc) * 64; rstride = 256; }
      else {
        const int slot0 = is_ctx ? tbase : CTX + tbase;
        dst = (bfraw*)(ws + (wc < 2 ? O_KA : O_KC)) + ((long)(b * 2 + (wc & 1)) * KS + slot0) * 64; rstride = 64;
      }
      float g[4][4];
#pragma unroll
      for (int n = 0; n < 4; ++n) {
        if (donorm) {
          const float4 t = *(const float4*)(gn + n * 16 + fq * 4);
          g[n][0] = t.x; g[n][1] = t.y; g[n][2] = t.z; g[n][3] = t.w;
        } else { g[n][0] = g[n][1] = g[n][2] = g[n][3] = 1.f; }
      }
#pragma unroll
      for (int m = 0; m < 8; ++m) {
        const int rl = m * 16 + fr;
        float rs = 1.f;
        if (donorm) {
          float ss = 0.f;
#pragma unroll
          for (int n = 0; n < 4; ++n)
#pragma unroll
            for (int j = 0; j < 4; ++j) ss += acc[m][n][j] * acc[m][n][j];
          ss += __shfl_xor(ss, 16);
          ss += __shfl_xor(ss, 32);
          rs = rsqrtf(ss * (1.f / 64.f) + 1e-6f);
        }
        float xv[4][4];
#pragma unroll
        for (int n = 0; n < 4; ++n)
#pragma unroll
          for (int j = 0; j < 4; ++j) xv[n][j] = donorm ? acc[m][n][j] * rs * g[n][j] : acc[m][n][j];
        if (!is_ctx) {
          const int t = tbase + rl;
          const int pr = t >> 6, pc = t & 63;
          const float4 c0 = *(const float4*)(rope + pr * 16 + fq * 4), s0 = *(const float4*)(rope + 1024 + pr * 16 + fq * 4);
          const float4 c1 = *(const float4*)(rope + pc * 16 + fq * 4), s1 = *(const float4*)(rope + 1024 + pc * 16 + fq * 4);
          const float c0a[4] = {c0.x, c0.y, c0.z, c0.w}, s0a[4] = {s0.x, s0.y, s0.z, s0.w};
          const float c1a[4] = {c1.x, c1.y, c1.z, c1.w}, s1a[4] = {s1.x, s1.y, s1.z, s1.w};
#pragma unroll
          for (int j = 0; j < 4; ++j) {
            const float y0 = xv[0][j] * c0a[j] - xv[1][j] * s0a[j], y1 = xv[1][j] * c0a[j] + xv[0][j] * s0a[j];
            const float y2 = xv[2][j] * c1a[j] - xv[3][j] * s1a[j], y3 = xv[3][j] * c1a[j] + xv[2][j] * s1a[j];
            xv[0][j] = y0; xv[1][j] = y1; xv[2][j] = y2; xv[3][j] = y3;
          }
        }
        bfraw* d = dst + (long)rl * rstride + fq * 4;
#pragma unroll
        for (int n = 0; n < 4; ++n) {
          uint2 st;
          st.x = pack2(xv[n][0], xv[n][1]);
          st.y = pack2(xv[n][2], xv[n][3]);
          *(uint2*)(d + n * 16) = st;
        }
      }
    });
  } else {
    gemm_tile<false>(a0, a1, b0, b1, 1024, lds, tid, [&](f32x4 (&acc)[8][4], int wr, int wc, int fr, int fq) {
      const int rowbase = rt * 256 + wr * 128;
      const int b = rowbase / T;
      const int tbase = rowbase - b * T;
      bfraw* dst;
      long cstride;
      if (ct == 6) {
        const int slot0 = is_ctx ? tbase : CTX + tbase;
        dst = (bfraw*)(ws + (wc < 2 ? O_VAT : O_VCT)) + (long)(b * 2 + (wc & 1)) * 64 * KS + slot0;
        cstride = KS;
      } else {
        const int ncol0 = wc * 64;
        const int koff = (ct == 4) ? T : 0;
        if (is_ctx) { dst = (bfraw*)(ws + O_VTFC) + ((long)b * 256 + ncol0) * 512 + koff + tbase; cstride = 512; }
        else { dst = (bfraw*)(ws + O_VTF) + ((long)b * 256 + ncol0) * 8192 + koff + tbase; cstride = 8192; }
      }
#pragma unroll
      for (int m = 0; m < 8; ++m)
#pragma unroll
        for (int n = 0; n < 4; ++n) {
          uint2 st;
          st.x = pack2(acc[m][n][0], acc[m][n][1]);
          st.y = pack2(acc[m][n][2], acc[m][n][3]);
          *(uint2*)(dst + (long)(n * 16 + fr) * cstride + m * 16 + fq * 4) = st;
        }
    });
  }
}

DI void phase_proj(const Params& p, int layer, unsigned* ctr, int* s_item, char* lds, int tid) {
  const int n_lat = 128 * 7;
  const int nct_ctx = (layer == 0) ? 7 : 2;
  const int n_ctx = 8 * nct_ctx;
  for (;;) {
    const int item = next_item(ctr, s_item, tid);
    if (item >= n_lat + n_ctx) break;
    if (item < n_lat) proj_item(p, layer, false, item / 7, item % 7, lds, tid);
    else {
      const int r = item - n_lat;
      const int rt = r / nct_ctx, ct = (layer == 0) ? (r % nct_ctx) : (5 + r % nct_ctx);
      proj_item(p, layer, true, rt, ct, lds, tid);
    }
  }
}

DI void four_item(const Params& p, int layer, bool is_ctx, int b, int rt, char* lds, int tid) {
  const int T = is_ctx ? CTX : SEQ;
  const int K = 2 * T;
  const bfraw* A = (const bfraw*)(p.ws + (is_ctx ? O_DFTC : O_DFT));
  const bfraw* Bt = (const bfraw*)(p.ws + (is_ctx ? O_VTFC : O_VTF)) + (long)b * 256 * K;
  const int r0 = tid >> 2, c8 = (tid & 3) * 8;
  const bfraw* a0 = A + (long)(rt * 256 + r0) * K + c8;
  const bfraw* a1 = a0 + 128l * K;
  const bfraw* b0 = Bt + (long)r0 * K + c8;
  const bfraw* b1 = b0 + 128l * K;
  bfraw* MIX = (bfraw*)(p.ws + (is_ctx ? O_MIXC : O_MIX)) + (long)b * T * 1024;
  const float scale = is_ctx ? (1.f / 128.f) : (1.f / 512.f);
  const float* bias = p.b_four + layer * 256;
  gemm_tile<true>(a0, a1, b0, b1, K, lds, tid, [&](f32x4 (&acc)[8][4], int wr, int wc, int fr, int fq) {
#pragma unroll
    for (int n = 0; n < 4; ++n) {
      const int ncol = wc * 64 + n * 16 + fq * 4;
      const float4 bv = *(const float4*)(bias + ncol);
#pragma unroll
      for (int m = 0; m < 8; ++m) {
        const int t = rt * 256 + wr * 128 + m * 16 + fr;
        uint2 st;
        st.x = pack2(acc[m][n][0] * scale + bv.x, acc[m][n][1] * scale + bv.y);
        st.y = pack2(acc[m][n][2] * scale + bv.z, acc[m][n][3] * scale + bv.w);
        *(uint2*)(MIX + (long)t * 1024 + 512 + ncol) = st;
      }
    }
  });
}

DI void phase_mix(const Params& p, int layer, unsigned* ctr, int* s_item, char* lds, int tid) {
  char* ws = p.ws;
  const int nF = 128, nA = 1024, nC = 512;
  const int nFc = (layer == 0) ? 8 : 0, nAc = (layer == 0) ? 64 : 0, nCc = (layer == 0) ? 32 : 0;
  const int total = nF + nA + nC + nFc + nAc + nCc;
  for (;;) {
    const int item = next_item(ctr, s_item, tid);
    if (item >= total) break;
    int it = item;
    if (it < nF) { four_item(p, layer, false, it >> 4, it & 15, lds, tid); continue; }
    it -= nF;
    if (it >= nA + nC && it < nA + nC + nFc) { four_item(p, layer, true, it - nA - nC, 0, lds, tid); continue; }
    int kind, b, h, qb;
    if (it < nA) { kind = 0; b = it >> 7; h = (it >> 4) & 7; qb = it & 15; }
    else if (it < nA + nC) { it -= nA; kind = 1; b = it >> 6; h = (it >> 4) & 3; qb = it & 15; }
    else {
      it -= nA + nC + nFc;
      if (it < nAc) { kind = 2; b = it >> 3; h = it & 7; qb = 0; }
      else { it -= nAc; kind = 3; b = it >> 2; h = it & 3; qb = 0; }
    }
    const bool isA = (kind == 0 || kind == 2), isctx = (kind >= 2);
    const int nh = isA ? 8 : 4;
    const int kvh = isA ? (h >> 2) : (h >> 1);
    const int T = isctx ? CTX : SEQ;
    const long tok0 = (long)b * T + qb * 256;
    const bfraw* Qp = (const bfraw*)(ws + (isA ? (isctx ? O_QAC : O_QA) : (isctx ? O_QCC : O_QC))) + (tok0 * nh + h) * 64;
    const bfraw* Kp = (const bfraw*)(ws + (isA ? O_KA : O_KC)) + (long)(b * 2 + kvh) * KS * 64;
    const bfraw* Vp = (const bfraw*)(ws + (isA ? O_VAT : O_VCT)) + (long)(b * 2 + kvh) * 64 * KS;
    bfraw* Op = (bfraw*)(ws + (isctx ? O_MIXC : O_MIX)) + tok0 * 1024 + (isA ? 0 : 768) + h * 64;
    const float sk = isA ? 0.f : p.sink[layer * 4 + h] * LOG2E;
    if (kind == 1) {
      const int q0 = qb * 256;
      const int lo = (q0 - 128 < 0) ? 0 : q0 - 128;
      const int hi = (q0 + 384 > SEQ) ? SEQ : q0 + 384;
      attn_item<true>(Qp, 256, Kp, Vp, KS, CTX / 64, (CTX + lo) / 64, (hi - lo) / 64, q0, true, sk, Op, 1024, lds, tid);
    } else {
      attn_item<false>(Qp, nh * 64, Kp, Vp, KS, (kind == 0) ? KS / 64 : CTX / 64, 0, 0, 0, !isA, sk, Op, 1024, lds, tid);
    }
  }
}

DI void phase_outproj(const Params& p, int layer, unsigned* ctr, int* s_item, char* lds, int tid) {
  const int n_lat = 128 * 4, n_ctx = (layer == 0) ? 8 * 4 : 0;
  const bfraw* W = (const bfraw*)(p.ws + O_WOUTT) + (long)layer * 1024 * 1024;
  const float* MOD = (const float*)(p.ws + O_MOD);
  for (;;) {
    const int item = next_item(ctr, s_item, tid);
    if (item >= n_lat + n_ctx) break;
    const bool is_ctx = item >= n_lat;
    const int r = is_ctx ? item - n_lat : item;
    const int rt = r >> 2, ct = r & 3;
    const int T = is_ctx ? CTX : SEQ;
    const bfraw* A = (const bfraw*)(p.ws + (is_ctx ? O_MIXC : O_MIX));
    const float* xin = is_ctx ? p.ctx : (layer == 0 ? p.x : p.out);
    float* X1 = (float*)(p.ws + (is_ctx ? O_X1C : O_X1));
    const int r0 = tid >> 2, c8 = (tid & 3) * 8;
    const bfraw* a0 = A + (long)(rt * 256 + r0) * 1024 + c8;
    const bfraw* a1 = a0 + 128 * 1024;
    const bfraw* b0 = W + (long)(ct * 256 + r0) * 1024 + c8;
    const bfraw* b1 = b0 + 128 * 1024;
    gemm_tile<true>(a0, a1, b0, b1, 1024, lds, tid, [&](f32x4 (&acc)[8][4], int wr, int wc, int fr, int fq) {
      const int rowbase = rt * 256 + wr * 128;
      const int b = is_ctx ? 8 : rowbase / T;
      const float* g1 = MOD + (layer * 9 + b) * 6144 + 2048;
#pragma unroll
      for (int n = 0; n < 4; ++n) {
        const int col = ct * 256 + wc * 64 + n * 16 + fq * 4;
        const float4 gv = *(const float4*)(g1 + col);
#pragma unroll
        for (int m = 0; m < 8; ++m) {
          const long idx = (long)(rowbase + m * 16 + fr) * 1024 + col;
          const float4 xv = *(const float4*)(xin + idx);
          float4 o;
          o.x = ALPHA * xv.x + gv.x * acc[m][n][0];
          o.y = ALPHA * xv.y + gv.y * acc[m][n][1];
          o.z = ALPHA * xv.z + gv.z * acc[m][n][2];
          o.w = ALPHA * xv.w + gv.w * acc[m][n][3];
          *(float4*)(X1 + idx) = o;
        }
      }
    });
  }
}

DI void phase_row(const Params& p, int layer, char* lds, int tid) {
  const int w = tid >> 6, lane = tid & 63;
  float* wrl = (float*)lds;
  __syncthreads();
  {
    const float* wr = p.w_router + (long)layer * 1024 * 16;
    for (int idx = tid; idx < 16384; idx += NTHR) wrl[(idx & 15) * 1024 + (idx >> 4)] = wr[idx];
  }
  __syncthreads();
  const float* MOD = (const float*)(p.ws + O_MOD);
  const int nrows = NT + ((layer == 0) ? NCT : 0);
  for (int row = blockIdx.x * NWAVE + w; row < nrows; row += gridDim.x * NWAVE) {
    const bool is_ctx = row >= NT;
    const int rr = is_ctx ? row - NT : row;
    float* X1 = (float*)(p.ws + (is_ctx ? O_X1C : O_X1)) + (long)rr * 1024;
    bfraw* Hd = (bfraw*)(p.ws + (is_ctx ? O_HC : O_H)) + (long)rr * 1024;
    const int T = is_ctx ? CTX : SEQ;
    const int b = rr / T, t = rr - b * T;
    const float* mr = MOD + (layer * 9 + (is_ctx ? 8 : b)) * 6144;
    float v[16];
    load_row16(X1, lane, v);
    postnorm16(v, p.ln1_g + layer * 1024, p.ln1_b + layer * 1024, lane);
    store_row16(X1, lane, v);
    modulate16(v, mr + 3072, mr + 4096, lane);
    store_row16_bf(Hd, lane, v);
    float mylg = -1e30f;
#pragma unroll 2
    for (int e = 0; e < 16; ++e) {
      float s = 0.f;
#pragma unroll
      for (int i = 0; i < 4; ++i) {
        const float4 wv = *(const float4*)(wrl + e * 1024 + i * 256 + lane * 4);
        s += v[i * 4] * wv.x + v[i * 4 + 1] * wv.y + v[i * 4 + 2] * wv.z + v[i * 4 + 3] * wv.w;
      }
      s = wsum(s);
      if (lane == e) mylg = s;
    }
    float mx = mylg;
    mx = fmaxf(mx, __shfl_xor(mx, 1)); mx = fmaxf(mx, __shfl_xor(mx, 2));
    mx = fmaxf(mx, __shfl_xor(mx, 4)); mx = fmaxf(mx, __shfl_xor(mx, 8));
    const float ex = __expf(mylg - mx);
    float den = ex;
    den += __shfl_xor(den, 1); den += __shfl_xor(den, 2); den += __shfl_xor(den, 4); den += __shfl_xor(den, 8);
    const float mine = ex / den;
    if (lane < 16) {
      float* AFF = (float*)(p.ws + (is_ctx ? O_AFFC : O_AFF));
      AFF[((long)b * 16 + lane) * T + t] = mine;
    }
  }
}

DI void topk_item(const Params& p, bool is_ctx, int b, int e, int chunk, char* lds, int tid) {
  const int T = is_ctx ? CTX : SEQ, cap = is_ctx ? CAPC : CAP;
  unsigned* a = (unsigned*)lds;
  const unsigned* AFF = (const unsigned*)(p.ws + (is_ctx ? O_AFFC : O_AFF)) + ((long)b * 16 + e) * T;
  __syncthreads();
  for (int i = tid; i < T; i += NTHR) a[i] = AFF[i];
  __syncthreads();
  const int i = chunk * NTHR + tid;
  if (i >= T) return;
  const unsigned ai = a[i];
  const int i0 = i & ~63;
  int rank = 0;
  const uint4* a4 = (const uint4*)a;
  for (int j4 = 0; j4 < (i0 >> 2); ++j4) {
    const uint4 v = a4[j4];
    rank += (v.x >= ai) + (v.y >= ai) + (v.z >= ai) + (v.w >= ai);
  }
  for (int j = i0; j < i0 + 64; ++j) {
    const unsigned v = a[j];
    rank += (v > ai) || (v == ai && j < i);
  }
  for (int j4 = (i0 + 64) >> 2; j4 < (T >> 2); ++j4) {
    const uint4 v = a4[j4];
    rank += (v.x > ai) + (v.y > ai) + (v.z > ai) + (v.w > ai);
  }
  short* SLOT = (short*)(p.ws + (is_ctx ? O_SLOTC : O_SLOT));
  if (rank < cap) {
    int* IDX = (int*)(p.ws + (is_ctx ? O_IDXC : O_IDX));
    float* GATE = (float*)(p.ws + (is_ctx ? O_GATEC : O_GATE));
    const int prow = (e * 8 + b) * cap + rank;
    IDX[prow] = i;
    GATE[prow] = __uint_as_float(ai);
    SLOT[((long)b * T + i) * 16 + e] = (short)rank;
  } else {
    SLOT[((long)b * T + i) * 16 + e] = (short)-1;
  }
}

DI void phase_topk(const Params& p, int layer, char* lds, int tid) {
  const int n_lat = 1024, n_ctx = (layer == 0) ? 128 : 0, n_conv = (layer == 1) ? N_EXPCONV : 0;
  for (int item = blockIdx.x; item < n_lat + n_ctx + n_conv; item += gridDim.x) {
    int it = item;
    if (it < n_lat) { topk_item(p, false, it >> 7, (it >> 3) & 15, it & 7, lds, tid); continue; }
    it -= n_lat;
    if (it < n_ctx) { topk_item(p, true, it >> 4, it & 15, 0, lds, tid); continue; }
    it -= n_ctx;
    expconv_item(p, 1, it, lds, tid);
  }
}

DI void phase_moe1(const Params& p, int layer, unsigned* ctr, int* s_item, char* lds, int tid) {
  const bfraw* WGU = (const bfraw*)(p.ws + O_WGU);
  const int n_lat = 16 * 16 * 16, n_ctx = (layer == 0) ? 16 * 16 : 0;
  for (;;) {
    const int item = next_item(ctr, s_item, tid);
    if (item >= n_lat + n_ctx) break;
    const bool is_ctx = item >= n_lat;
    const int r = is_ctx ? item - n_lat : item;
    const int RT = is_ctx ? 1 : 16;
    const int cap = is_ctx ? CAPC : CAP, T = is_ctx ? CTX : SEQ;
    const int e = r / (16 * RT), rem = r % (16 * RT), ct = rem / RT, rt = rem % RT;
    const int* IDX = (const int*)(p.ws + (is_ctx ? O_IDXC : O_IDX));
    const bfraw* Hs = (const bfraw*)(p.ws + (is_ctx ? O_HC : O_H));
    bfraw* ACT = (bfraw*)(p.ws + (is_ctx ? O_ACTC : O_ACT));
    const int r0 = tid >> 2, c8 = (tid & 3) * 8;
    const int l0 = rt * 256 + r0, l1 = l0 + 128;
    const int tok0 = IDX[e * 8 * cap + l0], tok1 = IDX[e * 8 * cap + l1];
    const bfraw* a0 = Hs + ((long)(l0 / cap) * T + tok0) * 1024 + c8;
    const bfraw* a1 = Hs + ((long)(l1 / cap) * T + tok1) * 1024 + c8;
    const bfraw* b0 = WGU + ((long)e * 4096 + ct * 256 + r0) * 1024 + c8;
    const bfraw* b1 = b0 + 128 * 1024;
    const long prow0 = (long)e * 8 * cap + rt * 256;
    gemm_tile<true>(a0, a1, b0, b1, 1024, lds, tid, [&](f32x4 (&acc)[8][4], int wr, int wc, int fr, int fq) {
#pragma unroll
      for (int m = 0; m < 8; ++m)
#pragma unroll
        for (int q = 0; q < 2; ++q) {
          const int f = ct * 128 + wc * 32 + q * 16 + fq * 4;
          float sv[4];
#pragma unroll
          for (int j = 0; j < 4; ++j) {
            const float g = acc[m][2 * q][j], u = acc[m][2 * q + 1][j];
            sv[j] = g / (1.f + __expf(-g)) * u;
          }
          uint2 st;
          st.x = pack2(sv[0], sv[1]);
          st.y = pack2(sv[2], sv[3]);
          *(uint2*)(ACT + (prow0 + wr * 128 + m * 16 + fr) * FF + f) = st;
        }
    });
  }
}

DI void phase_moe2(const Params& p, int layer, unsigned* ctr, int* s_item, char* lds, int tid) {
  const bfraw* WD = (const bfraw*)(p.ws + O_WD);
  const int n_lat = 16 * 4 * 16, n_ctx = (layer == 0) ? 16 * 4 : 0;
  for (;;) {
    const int item = next_item(ctr, s_item, tid);
    if (item >= n_lat + n_ctx) break;
    const bool is_ctx = item >= n_lat;
    const int r = is_ctx ? item - n_lat : item;
    const int RT = is_ctx ? 1 : 16;
    const int cap = is_ctx ? CAPC : CAP;
    const int e = r / (4 * RT), rem = r % (4 * RT), ct = rem / RT, rt = rem % RT;
    const bfraw* ACT = (const bfraw*)(p.ws + (is_ctx ? O_ACTC : O_ACT));
    bfraw* Y = (bfraw*)(p.ws + (is_ctx ? O_YC : O_Y));
    const int r0 = tid >> 2, c8 = (tid & 3) * 8;
    const long prow0 = (long)e * 8 * cap + rt * 256;
    const bfraw* a0 = ACT + (prow0 + r0) * FF + c8;
    const bfraw* a1 = a0 + 128 * FF;
    const bfraw* b0 = WD + ((long)e * 1024 + ct * 256 + r0) * FF + c8;
    const bfraw* b1 = b0 + 128 * FF;
    gemm_tile<true>(a0, a1, b0, b1, FF, lds, tid, [&](f32x4 (&acc)[8][4], int wr, int wc, int fr, int fq) {
#pragma unroll
      for (int m = 0; m < 8; ++m)
#pragma unroll
        for (int n = 0; n < 4; ++n) {
          const int col = ct * 256 + wc * 64 + n * 16 + fq * 4;
          uint2 st;
          st.x = pack2(acc[m][n][0], acc[m][n][1]);
          st.y = pack2(acc[m][n][2], acc[m][n][3]);
          *(uint2*)(Y + (prow0 + wr * 128 + m * 16 + fr) * 1024 + col) = st;
        }
    });
  }
}

DI void phase_combine(const Params& p, int layer, int tid) {
  const int w = tid >> 6, lane = tid & 63;
  const float* MOD = (const float*)(p.ws + O_MOD);
  const int nrows = NT + ((layer == 0) ? NCT : 0);
  for (int row = blockIdx.x * NWAVE + w; row < nrows; row += gridDim.x * NWAVE) {
    const bool is_ctx = row >= NT;
    const int rr = is_ctx ? row - NT : row;
    const int T = is_ctx ? CTX : SEQ, cap = is_ctx ? CAPC : CAP;
    const int b = rr / T;
    const float* X1 = (const float*)(p.ws + (is_ctx ? O_X1C : O_X1)) + (long)rr * 1024;
    const short* SLOT = (const short*)(p.ws + (is_ctx ? O_SLOTC : O_SLOT)) + (long)rr * 16;
    const float* GATE = (const float*)(p.ws + (is_ctx ? O_GATEC : O_GATE));
    const bfraw* Y = (const bfraw*)(p.ws + (is_ctx ? O_YC : O_Y));
    const float* mr = MOD + (layer * 9 + (is_ctx ? 8 : b)) * 6144;
    float y[16];
#pragma unroll
    for (int i = 0; i < 16; ++i) y[i] = 0.f;
    for (int e = 0; e < 16; ++e) {
      const int s = SLOT[e];
      if (s >= 0) {
        const long prow = (long)(e * 8 + b) * cap + s;
        const float g = GATE[prow];
        const bfraw* yr = Y + prow * 1024;
#pragma unroll
        for (int i = 0; i < 4; ++i) {
          const uint2 u = *(const uint2*)(yr + i * 256 + lane * 4);
          y[i * 4 + 0] += g * bflo(u.x); y[i * 4 + 1] += g * bfhi(u.x);
          y[i * 4 + 2] += g * bflo(u.y); y[i * 4 + 3] += g * bfhi(u.y);
        }
      }
    }
    float v[16], g2[16];
    load_row16(X1, lane, v);
    load_row16(mr + 5120, lane, g2);
#pragma unroll
    for (int i = 0; i < 16; ++i) v[i] = ALPHA * v[i] + g2[i] * y[i];
    postnorm16(v, p.ln2_g + layer * 1024, p.ln2_b + layer * 1024, lane);
    if (!is_ctx) store_row16(p.out + (long)rr * 1024, lane, v);
    if (layer == 0) {
      const float* mn = MOD + (1 * 9 + (is_ctx ? 8 : b)) * 6144;
      modulate16(v, mn, mn + 1024, lane);
      store_row16_bf((bfraw*)(p.ws + (is_ctx ? O_HC : O_H)) + (long)rr * 1024, lane, v);
    }
  }
}

__global__ void __launch_bounds__(NTHR) fwd_kernel(Params p) {
  extern __shared__ __attribute__((aligned(16))) char smem[];
  __shared__ int s_item;
  for (int ph = p.ph_lo; ph < p.ph_hi; ++ph) {
    if (ph > p.ph_lo) cg::this_grid().sync();
    int tid = threadIdx.x;
    asm volatile("" : "+v"(tid));
    unsigned* ctr = (unsigned*)(p.ws + O_CTR) + ph;
    if (ph == 0) phase_prep(p, smem, tid);
    else if (ph == 1) phase_lnmod0(p, tid);
    else {
      const int layer = (ph - 2) >> 3, sub = (ph - 2) & 7;
      switch (sub) {
        case 0: phase_proj(p, layer, ctr, &s_item, smem, tid); break;
        case 1: phase_mix(p, layer, ctr, &s_item, smem, tid); break;
        case 2: phase_outproj(p, layer, ctr, &s_item, smem, tid); break;
        case 3: phase_row(p, layer, smem, tid); break;
        case 4: phase_topk(p, layer, smem, tid); break;
        case 5: phase_moe1(p, layer, ctr, &s_item, smem, tid); break;
        case 6: phase_moe2(p, layer, ctr, &s_item, smem, tid); break;
        default: phase_combine(p, layer, tid); break;
      }
    }
  }
}

extern "C" void kernel_launch(void* const* d_in, const int* in_sizes, int n_in, void* d_out, int out_size, void* d_ws,
                              size_t ws_size, hipStream_t stream) {
  (void)in_sizes; (void)n_in; (void)out_size;
  if (ws_size < O_END) { fprintf(stderr, "kernel_launch: workspace too small (%zu < %zu)\n", ws_size, (size_t)O_END); return; }
  Params p{};
  const float** pp = (const float**)&p;
  for (int i = 0; i < 21; ++i) pp[i] = (const float*)d_in[i];
  p.out = (float*)d_out;
  p.ws = (char*)d_ws;
  static int grid_blocks = 0;
  if (!grid_blocks) {
    int dev = 0, cus = 0, per_cu = 0;
    hipGetDevice(&dev);
    hipDeviceGetAttribute(&cus, hipDeviceAttributeMultiprocessorCount, dev);
    hipFuncSetAttribute((const void*)fwd_kernel, hipFuncAttributeMaxDynamicSharedMemorySize, LDS_BYTES);
    hipOccupancyMaxActiveBlocksPerMultiprocessor(&per_cu, fwd_kernel, NTHR, LDS_BYTES);
    if (per_cu < 1) per_cu = 1;
    if (per_cu > 1) per_cu = 1;
    grid_blocks = cus * per_cu;
  }
#if ONE_LAUNCH
  p.ph_lo = 0; p.ph_hi = NPHASE;
  void* args[] = {&p};
  hipError_t e = hipLaunchCooperativeKernel((void*)fwd_kernel, dim3(grid_blocks), dim3(NTHR), args, LDS_BYTES, stream);
  if (e != hipSuccess) fprintf(stderr, "cooperative launch failed: %s (grid %d)\n", hipGetErrorString(e), grid_blocks);
#else
  for (int ph = 0; ph < NPHASE; ++ph) {
    p.ph_lo = ph; p.ph_hi = ph + 1;
    hipLaunchKernelGGL(fwd_kernel, dim3(grid_blocks), dim3(NTHR), LDS_BYTES, stream, p);
  }
#endif
}
```

```cpp
#include <hip/hip_runtime.h>
#include <hip/hip_cooperative_groups.h>
#include <cstdio>
namespace cg = cooperative_groups;

#ifndef ONE_LAUNCH
#define ONE_LAUNCH 1
#endif

#define DI __device__ __forceinline__
typedef unsigned short bfraw;
using bf16x8 = __attribute__((ext_vector_type(8))) short;
using f32x4 = __attribute__((ext_vector_type(4))) float;

constexpr int NB = 8, SEQ = 4096, DM = 1024, CTX = 256;
constexpr int NT = NB * SEQ, NCT = NB * CTX;
constexpr int NPROJ = 1792;
constexpr int KS = CTX + SEQ;
constexpr int NE = 16, FF = 2048;
constexpr int CAP = 512, CAPC = 32;
constexpr float ALPHA = 1.41421356237f;
constexpr float LOG2E = 1.44269504089f;
constexpr int NPHASE = 18;
constexpr int NTHR = 512;
constexpr int NWAVE = NTHR / 64;
constexpr int LDS_BYTES = 131072;

constexpr size_t al(size_t x) { return (x + 255) & ~size_t(255); }
constexpr size_t O_MOD = 0;
constexpr size_t O_ROPE = al(O_MOD + 2 * 9 * 6144 * 4);
constexpr size_t O_CTR = al(O_ROPE + 2 * 1024 * 4);
constexpr size_t O_WINT = al(O_CTR + 64 * 4);
constexpr size_t O_WOUTT = al(O_WINT + 2ull * NPROJ * 1024 * 2);
constexpr size_t O_DFT = al(O_WOUTT + 2ull * 1024 * 1024 * 2);
constexpr size_t O_DFTC = al(O_DFT + 4096ull * 8192 * 2);
constexpr size_t O_WGU = al(O_DFTC + 256ull * 512 * 2);
constexpr size_t O_WD = al(O_WGU + 16ull * 4096 * 1024 * 2);
constexpr size_t O_X1 = al(O_WD + 16ull * 1024 * 2048 * 2);
constexpr size_t O_X1C = al(O_X1 + (size_t)NT * 1024 * 4);
constexpr size_t O_H = al(O_X1C + (size_t)NCT * 1024 * 4);
constexpr size_t O_HC = al(O_H + (size_t)NT * 1024 * 2);
constexpr size_t O_AFF = al(O_HC + (size_t)NCT * 1024 * 2);
constexpr size_t O_AFFC = al(O_AFF + 8ull * 16 * 4096 * 4);
constexpr size_t O_IDX = al(O_AFFC + 8ull * 16 * 256 * 4);
constexpr size_t O_GATE = al(O_IDX + 16ull * 8 * 512 * 4);
constexpr size_t O_SLOT = al(O_GATE + 16ull * 8 * 512 * 4);
constexpr size_t O_IDXC = al(O_SLOT + 8ull * 4096 * 16 * 2);
constexpr size_t O_GATEC = al(O_IDXC + 16ull * 8 * 32 * 4);
constexpr size_t O_SLOTC = al(O_GATEC + 16ull * 8 * 32 * 4);
constexpr size_t O_Y = al(O_SLOTC + 8ull * 256 * 16 * 2);
constexpr size_t O_YC = al(O_Y + 65536ull * 1024 * 2);
constexpr size_t O_ACTC = al(O_YC + 4096ull * 1024 * 2);
constexpr size_t O_R = al(O_ACTC + 4096ull * 2048 * 2);
constexpr size_t O_ACT = O_R;
constexpr size_t O_QA = O_R;
constexpr size_t O_QC = al(O_QA + (size_t)NT * 512 * 2);
constexpr size_t O_KA = al(O_QC + (size_t)NT * 256 * 2);
constexpr size_t O_VAT = al(O_KA + 8ull * 2 * KS * 64 * 2);
constexpr size_t O_KC = al(O_VAT + 8ull * 2 * KS * 64 * 2);
constexpr size_t O_VCT = al(O_KC + 8ull * 2 * KS * 64 * 2);
constexpr size_t O_VTF = al(O_VCT + 8ull * 2 * KS * 64 * 2);
constexpr size_t O_MIX = al(O_VTF + 8ull * 256 * 8192 * 2);
constexpr size_t O_QAC = al(O_MIX + (size_t)NT * 1024 * 2);
constexpr size_t O_QCC = al(O_QAC + (size_t)NCT * 512 * 2);
constexpr size_t O_VTFC = al(O_QCC + (size_t)NCT * 256 * 2);
constexpr size_t O_MIXC = al(O_VTFC + 8ull * 256 * 512 * 2);
constexpr size_t O_REND = al(O_MIXC + (size_t)NCT * 1024 * 2);
constexpr size_t O_END = O_R + 65536ull * 2048 * 2;
static_assert(O_REND <= O_END, "mixer buffers must fit in the ACT region");
static_assert(O_END <= 1073741824ull, "workspace too large");

struct Params {
  const float *x, *c, *ctx, *c_ctx, *w_mod, *b_mod, *w_in, *q_norm, *k_norm, *w_four, *b_four, *sink, *w_out,
      *ln1_g, *ln1_b, *w_router, *w_gate, *w_up, *w_down, *ln2_g, *ln2_b;
  float* out;
  char* ws;
  int ph_lo, ph_hi;
};

typedef __bf16 hwbf2 __attribute__((ext_vector_type(2)));
typedef float hwf2 __attribute__((ext_vector_type(2)));
DI unsigned pack2(float a, float b) {
  hwf2 f = {a, b};
  return __builtin_bit_cast(unsigned, __builtin_convertvector(f, hwbf2));
}
DI bfraw f2bf(float x) { return (bfraw)(pack2(x, 0.f) & 0xffffu); }
DI float bflo(unsigned u) { return __uint_as_float(u << 16); }
DI float bfhi(unsigned u) { return __uint_as_float(u & 0xffff0000u); }
DI float wsum(float v) {
#pragma unroll
  for (int o = 32; o; o >>= 1) v += __shfl_xor(v, o);
  return v;
}
DI void glds16(const void* g, char* l) {
  __builtin_amdgcn_global_load_lds((const unsigned*)g, (unsigned*)l, 16, 0, 0);
}
DI void wait_vm0() { asm volatile("s_waitcnt vmcnt(0)" ::: "memory"); }
DI f32x4 mfma16(bf16x8 a, bf16x8 b, f32x4 c) { return __builtin_amdgcn_mfma_f32_16x16x32_bf16(a, b, c, 0, 0, 0); }

DI int next_item(unsigned* ctr, int* s_item, int tid) {
  __syncthreads();
  if (tid == 0) *s_item = (int)atomicAdd(ctr, 1u);
  __syncthreads();
  return *s_item;
}

DI void gemm_stage(const bfraw* a0, const bfraw* a1, const bfraw* b0, const bfraw* b1, int k0, char* st, int tid) {
#pragma unroll
  for (int i = 0; i < 4; ++i) {
    const bfraw* ga = ((i & 1) ? a1 : a0) + k0 + (i >> 1) * 32;
    glds16(ga, st + (i * NTHR + tid) * 16);
  }
#pragma unroll
  for (int i = 0; i < 4; ++i) {
    const bfraw* gb = ((i & 1) ? b1 : b0) + k0 + (i >> 1) * 32;
    glds16(gb, st + 32768 + (i * NTHR + tid) * 16);
  }
}

template <bool SWAP, class Epi>
DI void gemm_tile(const bfraw* a0, const bfraw* a1, const bfraw* b0, const bfraw* b1, int K, char* lds, int tid, Epi epi) {
  asm volatile("" : "+v"(tid));
  const int w = tid >> 6, lane = tid & 63, wr = w >> 2, wc = w & 3, fr = lane & 15, fq = lane >> 4;
  f32x4 acc[8][4];
#pragma unroll
  for (int m = 0; m < 8; ++m)
#pragma unroll
    for (int n = 0; n < 4; ++n) acc[m][n] = f32x4{0.f, 0.f, 0.f, 0.f};
  const int nk = K >> 6;
  __syncthreads();
  gemm_stage(a0, a1, b0, b1, 0, lds, tid);
#pragma unroll 1
  for (int kt = 0; kt < nk; ++kt) {
    wait_vm0();
    __syncthreads();
    if (kt + 1 < nk) gemm_stage(a0, a1, b0, b1, (kt + 1) * 64, lds + ((kt + 1) & 1) * 65536, tid);
    const char* sA = lds + (kt & 1) * 65536;
    const char* sB = sA + 32768;
#pragma unroll
    for (int h = 0; h < 2; ++h) {
      bf16x8 bfr[4];
#pragma unroll
      for (int n = 0; n < 4; ++n) bfr[n] = *(const bf16x8*)(sB + h * 16384 + (wc * 64 + n * 16 + fr) * 64 + fq * 16);
#pragma unroll
      for (int m = 0; m < 8; ++m) {
        const bf16x8 af = *(const bf16x8*)(sA + h * 16384 + (wr * 128 + m * 16 + fr) * 64 + fq * 16);
#pragma unroll
        for (int n = 0; n < 4; ++n) acc[m][n] = SWAP ? mfma16(bfr[n], af, acc[m][n]) : mfma16(af, bfr[n], acc[m][n]);
      }
    }
  }
  epi(acc, wr, wc, fr, fq);
}

DI void attn_stage(const bfraw* Kp, const bfraw* VTp, int ldv, int tile, char* st, int tid) {
  const int slot0 = tile * 64;
  const int h = tid >> 8, r = (tid & 255) >> 2, c8 = (tid & 3) * 8;
  glds16(Kp + (long)(slot0 + r) * 64 + h * 32 + c8, st + tid * 16);
  glds16(VTp + (long)r * ldv + slot0 + h * 32 + c8, st + 8192 + tid * 16);
}

template <bool WINDOW>
DI void attn_item(const bfraw* Qp, int qstride, const bfraw* Kp, const bfraw* VTp, int ldv, int n1, int tlo, int n2,
                  int qpos0, bool has_sink, float sink_l2, bfraw* Op, int ostride, char* lds, int tid) {
  asm volatile("" : "+v"(tid));
  const int w = tid >> 6, lane = tid & 63, fr = lane & 15, fq = lane >> 4;
  const float scale_l2 = 0.125f * LOG2E;
  bf16x8 qf[2][2];
#pragma unroll
  for (int n = 0; n < 2; ++n)
#pragma unroll
    for (int sd = 0; sd < 2; ++sd)
      qf[n][sd] = *(const bf16x8*)(Qp + (long)(w * 32 + n * 16 + fr) * qstride + sd * 32 + fq * 8);
  float m_run[2], l_run[2];
  f32x4 o[4][2];
#pragma unroll
  for (int n = 0; n < 2; ++n) {
    m_run[n] = has_sink ? sink_l2 : -1e30f;
    l_run[n] = (has_sink && fq == 0) ? 1.f : 0.f;
#pragma unroll
    for (int md = 0; md < 4; ++md) o[md][n] = f32x4{0.f, 0.f, 0.f, 0.f};
  }
  const int nt = n1 + n2;
  __syncthreads();
  attn_stage(Kp, VTp, ldv, (0 < n1) ? 0 : tlo, lds, tid);
#pragma unroll 1
  for (int it = 0; it < nt; ++it) {
    wait_vm0();
    __syncthreads();
    if (it + 1 < nt) {
      const int nx = it + 1;
      attn_stage(Kp, VTp, ldv, (nx < n1) ? nx : tlo + (nx - n1), lds + (nx & 1) * 16384, tid);
    }
    const char* sK = lds + (it & 1) * 16384;
    const char* sV = sK + 8192;
    f32x4 s[4][2];
#pragma unroll
    for (int m = 0; m < 4; ++m)
#pragma unroll
      for (int n = 0; n < 2; ++n) s[m][n] = f32x4{0.f, 0.f, 0.f, 0.f};
#pragma unroll
    for (int sd = 0; sd < 2; ++sd) {
#pragma unroll
      for (int m = 0; m < 4; ++m) {
        const int krow = (m >> 1) * 32 + (fr >> 2) * 8 + (m & 1) * 4 + (fr & 3);
        bf16x8 kf = *(const bf16x8*)(sK + sd * 4096 + krow * 64 + fq * 16);
#pragma unroll
        for (int n = 0; n < 2; ++n) s[m][n] = mfma16(kf, qf[n][sd], s[m][n]);
      }
    }
    const int tile = (it < n1) ? it : tlo + (it - n1);
    const bool domask = WINDOW && (it >= n1);
#pragma unroll
    for (int n = 0; n < 2; ++n) {
      if (domask) {
        const int qpos = qpos0 + w * 32 + n * 16 + fr;
#pragma unroll
        for (int m = 0; m < 4; ++m)
#pragma unroll
          for (int j = 0; j < 4; ++j) {
            const int kpos = tile * 64 - CTX + (m >> 1) * 32 + fq * 8 + (m & 1) * 4 + j;
            const int d = qpos - kpos;
            if (d > 128 || d < -128) s[m][n][j] = -1e30f;
          }
      }
      float mx = -1e30f;
#pragma unroll
      for (int m = 0; m < 4; ++m) {
        mx = fmaxf(mx, fmaxf(s[m][n][0], s[m][n][1]));
        mx = fmaxf(mx, fmaxf(s[m][n][2], s[m][n][3]));
      }
      mx = fmaxf(mx, __shfl_xor(mx, 16));
      mx = fmaxf(mx, __shfl_xor(mx, 32));
      const float mxs = mx * scale_l2;
      const bool need = mxs > m_run[n] + 8.f;
      if (__any(need)) {
        const float m_new = need ? mxs : m_run[n];
        const float alpha = __builtin_amdgcn_exp2f(m_run[n] - m_new);
        m_run[n] = m_new;
        l_run[n] *= alpha;
#pragma unroll
        for (int md = 0; md < 4; ++md) {
          o[md][n][0] *= alpha; o[md][n][1] *= alpha; o[md][n][2] *= alpha; o[md][n][3] *= alpha;
        }
      }
      const float nm = -m_run[n];
      float ls = 0.f;
#pragma unroll
      for (int m = 0; m < 4; ++m)
#pragma unroll
        for (int j = 0; j < 4; ++j) {
          const float p = __builtin_amdgcn_exp2f(__builtin_fmaf(s[m][n][j], scale_l2, nm));
          s[m][n][j] = p;
          ls += p;
        }
      l_run[n] += ls;
    }
#pragma unroll
    for (int ks = 0; ks < 2; ++ks) {
      bf16x8 pf[2];
#pragma unroll
      for (int n = 0; n < 2; ++n) {
        const unsigned u0 = pack2(s[2 * ks][n][0], s[2 * ks][n][1]);
        const unsigned u1 = pack2(s[2 * ks][n][2], s[2 * ks][n][3]);
        const unsigned u2 = pack2(s[2 * ks + 1][n][0], s[2 * ks + 1][n][1]);
        const unsigned u3 = pack2(s[2 * ks + 1][n][2], s[2 * ks + 1][n][3]);
        const uint4 uu = make_uint4(u0, u1, u2, u3);
        pf[n] = __builtin_bit_cast(bf16x8, uu);
      }
#pragma unroll
      for (int md = 0; md < 4; ++md) {
        bf16x8 vf = *(const bf16x8*)(sV + ks * 4096 + (md * 16 + fr) * 64 + fq * 16);
#pragma unroll
        for (int n = 0; n < 2; ++n) o[md][n] = mfma16(vf, pf[n], o[md][n]);
      }
    }
  }
#pragma unroll
  for (int n = 0; n < 2; ++n) {
    float l = l_run[n];
    l += __shfl_xor(l, 16);
    l += __shfl_xor(l, 32);
    const float inv = 1.f / l;
    bfraw* orow = Op + (long)(w * 32 + n * 16 + fr) * ostride;
#pragma unroll
    for (int md = 0; md < 4; ++md) {
      uint2 st;
      st.x = pack2(o[md][n][0] * inv, o[md][n][1] * inv);
      st.y = pack2(o[md][n][2] * inv, o[md][n][3] * inv);
      *(uint2*)(orow + md * 16 + fq * 4) = st;
    }
  }
}

DI void xpose_tile(const float* src, long ld_src, bfraw* dst, long ld_dst, int mode, char* lds, int tid) {
  float(*t)[65] = (float(*)[65])lds;
  __syncthreads();
  {
    const int c = tid & 63, r0 = tid >> 6;
#pragma unroll 4
    for (int rr = r0; rr < 64; rr += NWAVE) t[rr][c] = src[(long)rr * ld_src + c];
  }
  __syncthreads();
  {
    const int k8 = (tid & 7) * 8, nn = tid >> 3;
    uint4 v;
    v.x = pack2(t[k8 + 0][nn], t[k8 + 1][nn]);
    v.y = pack2(t[k8 + 2][nn], t[k8 + 3][nn]);
    v.z = pack2(t[k8 + 4][nn], t[k8 + 5][nn]);
    v.w = pack2(t[k8 + 6][nn], t[k8 + 7][nn]);
    const int row = (mode == 0) ? nn : ((nn >> 4) * 32 + (mode == 2 ? 16 : 0) + (nn & 15));
    *(uint4*)(dst + (long)row * ld_dst + k8) = v;
  }
}

DI void xpose256(const float* src, long ld_src, bfraw* dst, long ld_dst, int mode, char* lds, int tid) {
  const int w = tid >> 6, lane = tid & 63;
  float4 v[8];
#pragma unroll
  for (int i = 0; i < 8; ++i) {
    const int k = 2 * (w + 8 * (i >> 1)) + (i & 1);
    v[i] = *(const float4*)(src + (long)k * ld_src + lane * 4);
  }
  __syncthreads();
#pragma unroll
  for (int i2 = 0; i2 < 4; ++i2) {
    const int k = 2 * (w + 8 * i2);
    char* base = lds + (lane * 4) * 136 + k * 2;
    *(unsigned*)(base + 0 * 136) = pack2(v[2 * i2].x, v[2 * i2 + 1].x);
    *(unsigned*)(base + 1 * 136) = pack2(v[2 * i2].y, v[2 * i2 + 1].y);
    *(unsigned*)(base + 2 * 136) = pack2(v[2 * i2].z, v[2 * i2 + 1].z);
    *(unsigned*)(base + 3 * 136) = pack2(v[2 * i2].w, v[2 * i2 + 1].w);
  }
  __syncthreads();
#pragma unroll
  for (int q = 0; q < 4; ++q) {
    const int c = tid + NTHR * q;
    const int n = c >> 3, k8 = (c & 7) * 8;
    const uint2 lo = *(const uint2*)(lds + n * 136 + k8 * 2);
    const uint2 hi = *(const uint2*)(lds + n * 136 + k8 * 2 + 8);
    const int row = (mode == 0) ? n : ((n >> 4) * 32 + (mode == 2 ? 16 : 0) + (n & 15));
    *(uint4*)(dst + (long)row * ld_dst + k8) = make_uint4(lo.x, lo.y, hi.x, hi.y);
  }
}

constexpr int N_EXPCONV = 4096 + 2048;
DI void expconv_item(const Params& p, int layer, int item, char* lds, int tid) {
  bfraw* WGU = (bfraw*)(p.ws + O_WGU);
  bfraw* WD = (bfraw*)(p.ws + O_WD);
  if (item < 4096) {
    const int type = item & 1;
    int r = item >> 1;
    const int nt = r & 7; r >>= 3;
    const int kt = r & 15; const int e = r >> 4;
    const float* src = (type ? p.w_up : p.w_gate) + ((long)(layer * NE + e) * DM + kt * 64) * FF + nt * 256;
    bfraw* dst = WGU + ((long)e * 4096 + nt * 512) * DM + kt * 64;
    xpose256(src, FF, dst, DM, 1 + type, lds, tid);
  } else {
    int r = item - 4096;
    const int nt = r & 3; r >>= 2;
    const int kt = r & 31; const int e = r >> 5;
    const float* src = p.w_down + ((long)(layer * NE + e) * FF + kt * 64) * DM + nt * 256;
    bfraw* dst = WD + ((long)e * DM + nt * 256) * FF + kt * 64;
    xpose256(src, DM, dst, FF, 0, lds, tid);
  }
}

DI void prep_mod_item(const Params& p, int item, char* lds, int tid) {
  const int layer = item / 96, chunk = item % 96;
  float* sc = (float*)lds;
  float* red = (float*)(lds + 36864);
  __syncthreads();
  for (int idx = tid; idx < 9 * 1024; idx += NTHR) {
    const int r = idx >> 10, k = idx & 1023;
    const float v = (r < 8) ? p.c[r * 1024 + k] : p.c_ctx[k];
    sc[idx] = v / (1.f + __expf(-v));
  }
  __syncthreads();
  const int w = tid >> 6, lane = tid & 63;
  const int col = chunk * 64 + lane;
  float acc[9];
#pragma unroll
  for (int r = 0; r < 9; ++r) acc[r] = 0.f;
  const float* wp = p.w_mod + ((long)layer * 1024 + w * 128) * 6144 + col;
#pragma unroll 4
  for (int k = 0; k < 128; ++k) {
    const float wv = wp[(long)k * 6144];
#pragma unroll
    for (int r = 0; r < 9; ++r) acc[r] += sc[r * 1024 + w * 128 + k] * wv;
  }
#pragma unroll
  for (int r = 0; r < 9; ++r) red[(w * 9 + r) * 64 + lane] = acc[r];
  __syncthreads();
  float* MOD = (float*)(p.ws + O_MOD);
  for (int idx = tid; idx < 9 * 64; idx += NTHR) {
    const int r = idx >> 6, l = idx & 63;
    float s = p.b_mod[layer * 6144 + chunk * 64 + l];
#pragma unroll
    for (int ww = 0; ww < NWAVE; ++ww) s += red[(ww * 9 + r) * 64 + l];
    MOD[(layer * 9 + r) * 6144 + chunk * 64 + l] = s;
  }
}

DI void prep_four_item(const Params& p, int item, char* lds, int tid) {
  const int layer = item >> 6, g = (item >> 4) & 3, kt = item & 15;
  float* G = (float*)lds;
  float(*Wt)[65] = (float(*)[65])(lds + 32768);
  float* ctab = (float*)(lds + 32768 + 64 * 65 * 4);
  __syncthreads();
  const float* wg = p.w_four + (long)(layer * 4 + g) * 4096;
  for (int idx = tid; idx < 4096; idx += NTHR) Wt[idx >> 6][idx & 63] = wg[idx];
  if (tid < 64) {
    float sn, cs;
    sincospif((float)tid / 32.f, &sn, &cs);
    ctab[tid] = cs;
    ctab[64 + tid] = sn;
  }
  __syncthreads();
  for (int o = tid; o < 4096; o += NTHR) {
    const int c = o >> 6, d = o & 63;
    float s1 = 0.f, s2 = 0.f;
#pragma unroll 4
    for (int c2 = 0; c2 < 64; ++c2) {
      const int a = (c * c2) & 63;
      const float wv = Wt[c2][d];
      s1 += ctab[a] * wv;
      s2 += ctab[64 + a] * wv;
    }
    G[o] = s1;
    G[4096 + o] = s2;
  }
  __syncthreads();
  const float* wi = p.w_in + ((long)layer * 1024 + kt * 64) * 1536 + 768 + g * 64;
  for (int idx = tid; idx < 4096; idx += NTHR) Wt[idx >> 6][idx & 63] = wi[(long)(idx >> 6) * 1536 + (idx & 63)];
  __syncthreads();
  bfraw* WINT = (bfraw*)(p.ws + O_WINT) + (long)layer * NPROJ * 1024;
  for (int o = tid; o < 64 * 128; o += NTHR) {
    const int kk = o & 63, dcol = o >> 6;
    const float* Gs = G + (dcol >> 6) * 4096 + (dcol & 63);
    float s = 0.f;
#pragma unroll 4
    for (int c = 0; c < 64; ++c) s += Wt[kk][c] * Gs[c * 64];
    const int row = (dcol < 64) ? (768 + g * 64 + dcol) : (1024 + g * 64 + (dcol - 64));
    WINT[(long)row * 1024 + kt * 64 + kk] = f2bf(s);
  }
}

constexpr int P0_MOD = 192, P0_FOUR = 128, P0_ROPE = 1, P0_DFTC = 256, P0_DFT = 4096, P0_WIN = 2 * 16 * 24, P0_WOUT = 2 * 16 * 16;
constexpr int P0_TOTAL = P0_MOD + P0_FOUR + P0_ROPE + P0_DFTC + P0_DFT + P0_WIN + P0_WOUT + N_EXPCONV;

DI void phase_prep(const Params& p, char* lds, int tid) {
  if (blockIdx.x == 0 && tid < 64) ((unsigned*)(p.ws + O_CTR))[tid] = 0u;
  for (int item = blockIdx.x; item < P0_TOTAL; item += gridDim.x) {
    int it = item;
    if (it < P0_MOD) { prep_mod_item(p, it, lds, tid); continue; }
    it -= P0_MOD;
    if (it < P0_FOUR) { prep_four_item(p, it, lds, tid); continue; }
    it -= P0_FOUR;
    if (it < P0_ROPE) {
      float* rope = (float*)(p.ws + O_ROPE);
      for (int idx = tid; idx < 1024; idx += NTHR) {
        const int pos = idx >> 4, f = idx & 15;
        const float inv_freq = powf(10000.f, -(float)f / 16.f);
        const float ang = (float)pos * inv_freq;
        rope[idx] = cosf(ang);
        rope[1024 + idx] = sinf(ang);
      }
      continue;
    }
    it -= P0_ROPE;
    if (it < P0_DFTC) {
      bfraw* D = (bfraw*)(p.ws + O_DFTC) + (long)it * 512;
      for (int k = tid; k < 512; k += NTHR) {
        const int kk = k & 255;
        float sn, cs;
        sincospif((float)((it * kk) & 255) / 128.f, &sn, &cs);
        D[k] = f2bf(k < 256 ? cs : -sn);
      }
      continue;
    }
    it -= P0_DFTC;
    if (it < P0_DFT) {
      bfraw* D = (bfraw*)(p.ws + O_DFT) + (long)it * 8192;
      for (int ch = tid; ch < 4096; ch += NTHR) {
        const int k = ch * 2, kk = k & 4095;
        float sn0, cs0, sn1, cs1;
        sincospif((float)((it * kk) & 4095) / 2048.f, &sn0, &cs0);
        sincospif((float)((it * (kk + 1)) & 4095) / 2048.f, &sn1, &cs1);
        *(unsigned*)(D + k) = (k < 4096) ? pack2(cs0, cs1) : pack2(-sn0, -sn1);
      }
      continue;
    }
    it -= P0_DFT;
    if (it < P0_WIN) {
      const int layer = it / 384, r = it % 384, kt = r / 24, nt = r % 24;
      if (nt >= 12 && nt < 16) continue;
      const int col = nt * 64;
      int drow;
      if (col < 768) drow = col;
      else if (col < 1152) drow = col + 256;
      else if (col < 1280) drow = col + 384;
      else if (col < 1408) drow = col + 128;
      else drow = col + 256;
      const float* src = p.w_in + ((long)layer * 1024 + kt * 64) * 1536 + col;
      bfraw* dst = (bfraw*)(p.ws + O_WINT) + ((long)layer * NPROJ + drow) * 1024 + kt * 64;
      xpose_tile(src, 1536, dst, 1024, 0, lds, tid);
      continue;
    }
    it -= P0_WIN;
    if (it < P0_WOUT) {
      const int layer = it >> 8, r = it & 255, kt = r >> 4, nt = r & 15;
      const float* src = p.w_out + ((long)layer * 1024 + kt * 64) * 1024 + nt * 64;
      bfraw* dst = (bfraw*)(p.ws + O_WOUTT) + ((long)layer * 1024 + nt * 64) * 1024 + kt * 64;
      xpose_tile(src, 1024, dst, 1024, 0, lds, tid);
      continue;
    }
    it -= P0_WOUT;
    expconv_item(p, 0, it, lds, tid);
  }
}

DI void ln_stats(const float v[16], float& mean, float& rstd) {
  float s = 0.f;
#pragma unroll
  for (int i = 0; i < 16; ++i) s += v[i];
  mean = wsum(s) * (1.f / 1024.f);
  float q = 0.f;
#pragma unroll
  for (int i = 0; i < 16; ++i) { const float d = v[i] - mean; q += d * d; }
  rstd = rsqrtf(wsum(q) * (1.f / 1024.f) + 1e-5f);
}
DI void load_row16(const float* src, int lane, float v[16]) {
#pragma unroll
  for (int i = 0; i < 4; ++i) {
    const float4 t = *(const float4*)(src + i * 256 + lane * 4);
    v[i * 4 + 0] = t.x; v[i * 4 + 1] = t.y; v[i * 4 + 2] = t.z; v[i * 4 + 3] = t.w;
  }
}
DI void store_row16(float* dst, int lane, const float v[16]) {
#pragma unroll
  for (int i = 0; i < 4; ++i) *(float4*)(dst + i * 256 + lane * 4) = make_float4(v[i * 4], v[i * 4 + 1], v[i * 4 + 2], v[i * 4 + 3]);
}
DI void store_row16_bf(bfraw* dst, int lane, const float v[16]) {
#pragma unroll
  for (int i = 0; i < 4; ++i) {
    uint2 st;
    st.x = pack2(v[i * 4], v[i * 4 + 1]);
    st.y = pack2(v[i * 4 + 2], v[i * 4 + 3]);
    *(uint2*)(dst + i * 256 + lane * 4) = st;
  }
}
DI void modulate16(float v[16], const float* sh, const float* sc, int lane) {
  float mean, rstd;
  ln_stats(v, mean, rstd);
  float a[16], b[16];
  load_row16(sh, lane, a);
  load_row16(sc, lane, b);
#pragma unroll
  for (int i = 0; i < 16; ++i) v[i] = (v[i] - mean) * rstd * (1.f + b[i]) + a[i];
}
DI void postnorm16(float v[16], const float* g, const float* bb, int lane) {
  float mean, rstd;
  ln_stats(v, mean, rstd);
  float a[16], b[16];
  load_row16(g, lane, a);
  load_row16(bb, lane, b);
#pragma unroll
  for (int i = 0; i < 16; ++i) v[i] = (v[i] - mean) * rstd * a[i] + b[i];
}

DI void phase_lnmod0(const Params& p, int tid) {
  const int w = tid >> 6, lane = tid & 63;
  const float* MOD = (const float*)(p.ws + O_MOD);
  for (int row = blockIdx.x * NWAVE + w; row < NT + NCT; row += gridDim.x * NWAVE) {
    float v[16];
    if (row < NT) {
      load_row16(p.x + (long)row * 1024, lane, v);
      const float* mr = MOD + (0 * 9 + row / SEQ) * 6144;
      modulate16(v, mr, mr + 1024, lane);
      store_row16_bf((bfraw*)(p.ws + O_H) + (long)row * 1024, lane, v);
    } else {
      const int rc = row - NT;
      load_row16(p.ctx + (long)rc * 1024, lane, v);
      const float* mr = MOD + (0 * 9 + 8) * 6144;
      modulate16(v, mr, mr + 1024, lane);
      store_row16_bf((bfraw*)(p.ws + O_HC) + (long)rc * 1024, lane, v);
    }
  }
}

DI void proj_item(const Params& p, int layer, bool is_ctx, int rt, int ct, char* lds, int tid) {
  const int T = is_ctx ? CTX : SEQ;
  const bfraw* Hs = (const bfraw*)(p.ws + (is_ctx ? O_HC : O_H));
  const bfraw* W = (const bfraw*)(p.ws + O_WINT) + (long)layer * NPROJ * 1024;
  const int r0 = tid >> 2, c8 = (tid & 3) * 8;
  const bfraw* a0 = Hs + (long)(rt * 256 + r0) * 1024 + c8;
  const bfraw* a1 = a0 + 128 * 1024;
  const bfraw* b0 = W + (long)(ct * 256 + r0) * 1024 + c8;
  const bfraw* b1 = b0 + 128 * 1024;
  char* ws = p.ws;
  if (ct <= 2 || ct == 5) {
    const float* rope = (const float*)(ws + O_ROPE);
    gemm_tile<true>(a0, a1, b0, b1, 1024, lds, tid, [&](f32x4 (&acc)[8][4], int wr, int wc, int fr, int fq) {
      const int rowbase = rt * 256 + wr * 128;
      const int b = rowbase / T;
      const int tbase = rowbase - b * T;
      const bool donorm = (ct < 2) || (ct == 5 && wc < 2);
      const float* gn = ((ct < 2) ? p.q_norm : p.k_norm) + layer * 64;
      bfraw* dst;
      long rstride;
      if (ct < 2) { dst = (bfraw*)(ws + (is_ctx ? O_QAC : O_QA)) + ((long)rowbase * 8 + (ct * 4 + wc)) * 64; rstride = 512; }
      else if (ct == 2) { dst = (bfraw*)(ws + (is_ctx ? O_QCC : O_QC)) + ((long)rowbase * 4 + wc) * 64; rstride = 256; }
      else {
        const int slot0 = is_ctx ? tbase : CTX + tbase;
        dst = (bfraw*)(ws + (wc < 2 ? O_KA : O_KC)) + ((long)(b * 2 + (wc & 1)) * KS + slot0) * 64; rstride = 64;
      }
      float g[4][4];
#pragma unroll
      for (int n = 0; n < 4; ++n) {
        if (donorm) {
          const float4 t = *(const float4*)(gn + n * 16 + fq * 4);
          g[n][0] = t.x; g[n][1] = t.y; g[n][2] = t.z; g[n][3] = t.w;
        } else { g[n][0] = g[n][1] = g[n][2] = g[n][3] = 1.f; }
      }
#pragma unroll
      for (int m = 0; m < 8; ++m) {
        const int rl = m * 16 + fr;
        float rs = 1.f;
        if (donorm) {
          float ss = 0.f;
#pragma unroll
          for (int n = 0; n < 4; ++n)
#pragma unroll
            for (int j = 0; j < 4; ++j) ss += acc[m][n][j] * acc[m][n][j];
          ss += __shfl_xor(ss, 16);
          ss += __shfl_xor(ss, 32);
          rs = rsqrtf(ss * (1.f / 64.f) + 1e-6f);
        }
        float xv[4][4];
#pragma unroll
        for (int n = 0; n < 4; ++n)
#pragma unroll
          for (int j = 0; j < 4; ++j) xv[n][j] = donorm ? acc[m][n][j] * rs * g[n][j] : acc[m][n][j];
        if (!is_ctx) {
          const int t = tbase + rl;
          const int pr = t >> 6, pc = t & 63;
          const float4 c0 = *(const float4*)(rope + pr * 16 + fq * 4), s0 = *(const float4*)(rope + 1024 + pr * 16 + fq * 4);
          const float4 c1 = *(const float4*)(rope + pc * 16 + fq * 4), s1 = *(const float4*)(rope + 1024 + pc * 16 + fq * 4);
          const float c0a[4] = {c0.x, c0.y, c0.z, c0.w}, s0a[4] = {s0.x, s0.y, s0.z, s0.w};
          const float c1a[4] = {c1.x, c1.y, c1.z, c1.w}, s1a[4] = {s1.x, s1.y, s1.z, s1.w};
#pragma unroll
          for (int j = 0; j < 4; ++j) {
            const float y0 = xv[0][j] * c0a[j] - xv[1][j] * s0a[j], y1 = xv[1][j] * c0a[j] + xv[0][j] * s0a[j];
            const float y2 = xv[2][j] * c1a[j] - xv[3][j] * s1a[j], y3 = xv[3][j] * c1a[j] + xv[2][j] * s1a[j];
            xv[0][j] = y0; xv[1][j] = y1; xv[2][j] = y2; xv[3][j] = y3;
          }
        }
        bfraw* d = dst + (long)rl * rstride + fq * 4;
#pragma unroll
        for (int n = 0; n < 4; ++n) {
          uint2 st;
          st.x = pack2(xv[n][0], xv[n][1]);
          st.y = pack2(xv[n][2], xv[n][3]);
          *(uint2*)(d + n * 16) = st;
        }
      }
    });
  } else {
    gemm_tile<false>(a0, a1, b0, b1, 1024, lds, tid, [&](f32x4 (&acc)[8][4], int wr, int wc, int fr, int fq) {
      const int rowbase = rt * 256 + wr * 128;
      const int b = rowbase / T;
      const int tbase = rowbase - b * T;
      bfraw* dst;
      long cstride;
      if (ct == 6) {
        const int slot0 = is_ctx ? tbase : CTX + tbase;
        dst = (bfraw*)(ws + (wc < 2 ? O_VAT : O_VCT)) + (long)(b * 2 + (wc & 1)) * 64 * KS + slot0;
        cstride = KS;
      } else {
        const int ncol0 = wc * 64;
        const int koff = (ct == 4) ? T : 0;
        if (is_ctx) { dst = (bfraw*)(ws + O_VTFC) + ((long)b * 256 + ncol0) * 512 + koff + tbase; cstride = 512; }
        else { dst = (bfraw*)(ws + O_VTF) + ((long)b * 256 + ncol0) * 8192 + koff + tbase; cstride = 8192; }
      }
#pragma unroll
      for (int m = 0; m < 8; ++m)
#pragma unroll
        for (int n = 0; n < 4; ++n) {
          uint2 st;
          st.x = pack2(acc[m][n][0], acc[m][n][1]);
          st.y = pack2(acc[m][n][2], acc[m][n][3]);
          *(uint2*)(dst + (long)(n * 16 + fr) * cstride + m * 16 + fq * 4) = st;
        }
    });
  }
}

DI void phase_proj(const Params& p, int layer, unsigned* ctr, int* s_item, char* lds, int tid) {
  const int n_lat = 128 * 7;
  const int nct_ctx = (layer == 0) ? 7 : 2;
  const int n_ctx = 8 * nct_ctx;
  for (;;) {
    const int item = next_item(ctr, s_item, tid);
    if (item >= n_lat + n_ctx) break;
    if (item < n_lat) proj_item(p, layer, false, item / 7, item % 7, lds, tid);
    else {
      const int r = item - n_lat;
      const int rt = r / nct_ctx, ct = (layer == 0) ? (r % nct_ctx) : (5 + r % nct_ctx);
      proj_item(p, layer, true, rt, ct, lds, tid);
    }
  }
}

DI void four_item(const Params& p, int layer, bool is_ctx, int b, int rt, char* lds, int tid) {
  const int T = is_ctx ? CTX : SEQ;
  const int K = 2 * T;
  const bfraw* A = (const bfraw*)(p.ws + (is_ctx ? O_DFTC : O_DFT));
  const bfraw* Bt = (const bfraw*)(p.ws + (is_ctx ? O_VTFC : O_VTF)) + (long)b * 256 * K;
  const int r0 = tid >> 2, c8 = (tid & 3) * 8;
  const bfraw* a0 = A + (long)(rt * 256 + r0) * K + c8;
  const bfraw* a1 = a0 + 128l * K;
  const bfraw* b0 = Bt + (long)r0 * K + c8;
  const bfraw* b1 = b0 + 128l * K;
  bfraw* MIX = (bfraw*)(p.ws + (is_ctx ? O_MIXC : O_MIX)) + (long)b * T * 1024;
  const float scale = is_ctx ? (1.f / 128.f) : (1.f / 512.f);
  const float* bias = p.b_four + layer * 256;
  gemm_tile<true>(a0, a1, b0, b1, K, lds, tid, [&](f32x4 (&acc)[8][4], int wr, int wc, int fr, int fq) {
#pragma unroll
    for (int n = 0; n < 4; ++n) {
      const int ncol = wc * 64 + n * 16 + fq * 4;
      const float4 bv = *(const float4*)(bias + ncol);
#pragma unroll
      for (int m = 0; m < 8; ++m) {
        const int t = rt * 256 + wr * 128 + m * 16 + fr;
        uint2 st;
        st.x = pack2(acc[m][n][0] * scale + bv.x, acc[m][n][1] * scale + bv.y);
        st.y = pack2(acc[m][n][2] * scale + bv.z, acc[m][n][3] * scale + bv.w);
        *(uint2*)(MIX + (long)t * 1024 + 512 + ncol) = st;
      }
    }
  });
}

DI void phase_mix(const Params& p, int layer, unsigned* ctr, int* s_item, char* lds, int tid) {
  char* ws = p.ws;
  const int nF = 128, nA = 1024, nC = 512;
  const int nFc = (layer == 0) ? 8 : 0, nAc = (layer == 0) ? 64 : 0, nCc = (layer == 0) ? 32 : 0;
  const int total = nF + nA + nC + nFc + nAc + nCc;
  for (;;) {
    const int item = next_item(ctr, s_item, tid);
    if (item >= total) break;
    int it = item;
    if (it < nF) { four_item(p, layer, false, it >> 4, it & 15, lds, tid); continue; }
    it -= nF;
    if (it >= nA + nC && it < nA + nC + nFc) { four_item(p, layer, true, it - nA - nC, 0, lds, tid); continue; }
    int kind, b, h, qb;
    if (it < nA) { kind = 0; b = it >> 7; h = (it >> 4) & 7; qb = it & 15; }
    else if (it < nA + nC) { it -= nA; kind = 1; b = it >> 6; h = (it >> 4) & 3; qb = it & 15; }
    else {
      it -= nA + nC + nFc;
      if (it < nAc) { kind = 2; b = it >> 3; h = it & 7; qb = 0; }
      else { it -= nAc; kind = 3; b = it >> 2; h = it & 3; qb = 0; }
    }
    const bool isA = (kind == 0 || kind == 2), isctx = (kind >= 2);
    const int nh = isA ? 8 : 4;
    const int kvh = isA ? (h >> 2) : (h >> 1);
    const int T = isctx ? CTX : SEQ;
    const long tok0 = (long)b * T + qb * 256;
    const bfraw* Qp = (const bfraw*)(ws + (isA ? (isctx ? O_QAC : O_QA) : (isctx ? O_QCC : O_QC))) + (tok0 * nh + h) * 64;
    const bfraw* Kp = (const bfraw*)(ws + (isA ? O_KA : O_KC)) + (long)(b * 2 + kvh) * KS * 64;
    const bfraw* Vp = (const bfraw*)(ws + (isA ? O_VAT : O_VCT)) + (long)(b * 2 + kvh) * 64 * KS;
    bfraw* Op = (bfraw*)(ws + (isctx ? O_MIXC : O_MIX)) + tok0 * 1024 + (isA ? 0 : 768) + h * 64;
    const float sk = isA ? 0.f : p.sink[layer * 4 + h] * LOG2E;
    if (kind == 1) {
      const int q0 = qb * 256;
      const int lo = (q0 - 128 < 0) ? 0 : q0 - 128;
      const int hi = (q0 + 384 > SEQ) ? SEQ : q0 + 384;
      attn_item<true>(Qp, 256, Kp, Vp, KS, CTX / 64, (CTX + lo) / 64, (hi - lo) / 64, q0, true, sk, Op, 1024, lds, tid);
    } else {
      attn_item<false>(Qp, nh * 64, Kp, Vp, KS, (kind == 0) ? KS / 64 : CTX / 64, 0, 0, 0, !isA, sk, Op, 1024, lds, tid);
    }
  }
}

DI void phase_outproj(const Params& p, int layer, unsigned* ctr, int* s_item, char* lds, int tid) {
  const int n_lat = 128 * 4, n_ctx = (layer == 0) ? 8 * 4 : 0;
  const bfraw* W = (const bfraw*)(p.ws + O_WOUTT) + (long)layer * 1024 * 1024;
  const float* MOD = (const float*)(p.ws + O_MOD);
  for (;;) {
    const int item = next_item(ctr, s_item, tid);
    if (item >= n_lat + n_ctx) break;
    const bool is_ctx = item >= n_lat;
    const int r = is_ctx ? item - n_lat : item;
    const int rt = r >> 2, ct = r & 3;
    const int T = is_ctx ? CTX : SEQ;
    const bfraw* A = (const bfraw*)(p.ws + (is_ctx ? O_MIXC : O_MIX));
    const float* xin = is_ctx ? p.ctx : (layer == 0 ? p.x : p.out);
    float* X1 = (float*)(p.ws + (is_ctx ? O_X1C : O_X1));
    const int r0 = tid >> 2, c8 = (tid & 3) * 8;
    const bfraw* a0 = A + (long)(rt * 256 + r0) * 1024 + c8;
    const bfraw* a1 = a0 + 128 * 1024;
    const bfraw* b0 = W + (long)(ct * 256 + r0) * 1024 + c8;
    const bfraw* b1 = b0 + 128 * 1024;
    gemm_tile<true>(a0, a1, b0, b1, 1024, lds, tid, [&](f32x4 (&acc)[8][4], int wr, int wc, int fr, int fq) {
      const int rowbase = rt * 256 + wr * 128;
      const int b = is_ctx ? 8 : rowbase / T;
      const float* g1 = MOD + (layer * 9 + b) * 6144 + 2048;
#pragma unroll
      for (int n = 0; n < 4; ++n) {
        const int col = ct * 256 + wc * 64 + n * 16 + fq * 4;
        const float4 gv = *(const float4*)(g1 + col);
#pragma unroll
        for (int m = 0; m < 8; ++m) {
          const long idx = (long)(rowbase + m * 16 + fr) * 1024 + col;
          const float4 xv = *(const float4*)(xin + idx);
          float4 o;
          o.x = ALPHA * xv.x + gv.x * acc[m][n][0];
          o.y = ALPHA * xv.y + gv.y * acc[m][n][1];
          o.z = ALPHA * xv.z + gv.z * acc[m][n][2];
          o.w = ALPHA * xv.w + gv.w * acc[m][n][3];
          *(float4*)(X1 + idx) = o;
        }
      }
    });
  }
}

DI void phase_row(const Params& p, int layer, char* lds, int tid) {
  const int w = tid >> 6, lane = tid & 63;
  float* wrl = (float*)lds;
  __syncthreads();
  {
    const float* wr = p.w_router + (long)layer * 1024 * 16;
    for (int idx = tid; idx < 16384; idx += NTHR) wrl[(idx & 15) * 1024 + (idx >> 4)] = wr[idx];
  }
  __syncthreads();
  const float* MOD = (const float*)(p.ws + O_MOD);
  const int nrows = NT + ((layer == 0) ? NCT : 0);
  for (int row = blockIdx.x * NWAVE + w; row < nrows; row += gridDim.x * NWAVE) {
    const bool is_ctx = row >= NT;
    const int rr = is_ctx ? row - NT : row;
    float* X1 = (float*)(p.ws + (is_ctx ? O_X1C : O_X1)) + (long)rr * 1024;
    bfraw* Hd = (bfraw*)(p.ws + (is_ctx ? O_HC : O_H)) + (long)rr * 1024;
    const int T = is_ctx ? CTX : SEQ;
    const int b = rr / T, t = rr - b * T;
    const float* mr = MOD + (layer * 9 + (is_ctx ? 8 : b)) * 6144;
    float v[16];
    load_row16(X1, lane, v);
    postnorm16(v, p.ln1_g + layer * 1024, p.ln1_b + layer * 1024, lane);
    store_row16(X1, lane, v);
    modulate16(v, mr + 3072, mr + 4096, lane);
    store_row16_bf(Hd, lane, v);
    float mylg = -1e30f;
#pragma unroll 2
    for (int e = 0; e < 16; ++e) {
      float s = 0.f;
#pragma unroll
      for (int i = 0; i < 4; ++i) {
        const float4 wv = *(const float4*)(wrl + e * 1024 + i * 256 + lane * 4);
        s += v[i * 4] * wv.x + v[i * 4 + 1] * wv.y + v[i * 4 + 2] * wv.z + v[i * 4 + 3] * wv.w;
      }
      s = wsum(s);
      if (lane == e) mylg = s;
    }
    float mx = mylg;
    mx = fmaxf(mx, __shfl_xor(mx, 1)); mx = fmaxf(mx, __shfl_xor(mx, 2));
    mx = fmaxf(mx, __shfl_xor(mx, 4)); mx = fmaxf(mx, __shfl_xor(mx, 8));
    const float ex = __expf(mylg - mx);
    float den = ex;
    den += __shfl_xor(den, 1); den += __shfl_xor(den, 2); den += __shfl_xor(den, 4); den += __shfl_xor(den, 8);
    const float mine = ex / den;
    if (lane < 16) {
      float* AFF = (float*)(p.ws + (is_ctx ? O_AFFC : O_AFF));
      AFF[((long)b * 16 + lane) * T + t] = mine;
    }
  }
}

DI void topk_item(const Params& p, bool is_ctx, int b, int e, char* lds, int tid) {
  const int T = is_ctx ? CTX : SEQ, cap = is_ctx ? CAPC : CAP;
  unsigned* hist = (unsigned*)lds;
  unsigned* sel = hist + 256;
  unsigned* wtot = hist + 264;
  const unsigned* AFF = (const unsigned*)(p.ws + (is_ctx ? O_AFFC : O_AFF)) + ((long)b * 16 + e) * T;
  const int lane = tid & 63, w = tid >> 6;
  const bool have = tid * 8 < T;
  unsigned v[8];
  if (have) {
    const uint4 t0 = *(const uint4*)(AFF + tid * 8), t1 = *(const uint4*)(AFF + tid * 8 + 4);
    v[0] = t0.x; v[1] = t0.y; v[2] = t0.z; v[3] = t0.w; v[4] = t1.x; v[5] = t1.y; v[6] = t1.z; v[7] = t1.w;
  } else {
#pragma unroll
    for (int i = 0; i < 8; ++i) v[i] = 0u;
  }
  unsigned prefix = 0u, kk = (unsigned)cap;
#pragma unroll 1
  for (int pass = 3; pass >= 0; --pass) {
    __syncthreads();
    if (tid < 256) hist[tid] = 0u;
    __syncthreads();
    if (have) {
#pragma unroll
      for (int i = 0; i < 8; ++i) {
        const bool match = (pass == 3) ? true : ((v[i] >> (8 * (pass + 1))) == prefix);
        if (match) atomicAdd(&hist[(v[i] >> (8 * pass)) & 255u], 1u);
      }
    }
    __syncthreads();
    if (tid < 256) {
      unsigned sfx = 0u;
      for (int d = tid + 1; d < 256; ++d) sfx += hist[d];
      const unsigned me = hist[tid];
      if (sfx < kk && sfx + me >= kk) { sel[0] = (unsigned)tid; sel[1] = kk - sfx; }
    }
    __syncthreads();
    prefix = (prefix << 8) | sel[0];
    kk = sel[1];
  }
  const unsigned thr = prefix;
  unsigned cg = 0u, ce = 0u;
  if (have) {
#pragma unroll
    for (int i = 0; i < 8; ++i) { cg += (v[i] > thr); ce += (v[i] == thr); }
  }
  unsigned pk = cg | (ce << 16);
  unsigned inc = pk;
#pragma unroll
  for (int o = 1; o < 64; o <<= 1) {
    const unsigned t = __shfl_up(inc, o);
    if (lane >= o) inc += t;
  }
  __syncthreads();
  if (lane == 63) wtot[w] = inc;
  __syncthreads();
  unsigned base = 0u, total = 0u;
#pragma unroll
  for (int ww = 0; ww < NWAVE; ++ww) { const unsigned t = wtot[ww]; if (ww < w) base += t; total += t; }
  const unsigned excl = base + inc - pk;
  unsigned pos_g = excl & 0xffffu, pos_e = excl >> 16;
  const unsigned n_gt = total & 0xffffu;
  if (have) {
    short* SLOT = (short*)(p.ws + (is_ctx ? O_SLOTC : O_SLOT));
    int* IDX = (int*)(p.ws + (is_ctx ? O_IDXC : O_IDX));
    float* GATE = (float*)(p.ws + (is_ctx ? O_GATEC : O_GATE));
#pragma unroll
    for (int i = 0; i < 8; ++i) {
      const int idx = tid * 8 + i;
      int slot = -1;
      if (v[i] > thr) { slot = (int)pos_g; ++pos_g; }
      else if (v[i] == thr) { if (pos_e < kk) slot = (int)(n_gt + pos_e); ++pos_e; }
      if (slot >= 0) {
        const int prow = (e * 8 + b) * cap + slot;
        IDX[prow] = idx;
        GATE[prow] = __uint_as_float(v[i]);
      }
      SLOT[((long)b * T + idx) * 16 + e] = (short)slot;
    }
  }
}

DI void phase_topk(const Params& p, int layer, char* lds, int tid) {
  const int n_lat = 128, n_ctx = (layer == 0) ? 128 : 0, n_conv = (layer == 1) ? N_EXPCONV : 0;
  for (int item = blockIdx.x; item < n_lat + n_ctx + n_conv; item += gridDim.x) {
    int it = item;
    if (it < n_lat) { topk_item(p, false, it >> 4, it & 15, lds, tid); continue; }
    it -= n_lat;
    if (it < n_ctx) { topk_item(p, true, it >> 4, it & 15, lds, tid); continue; }
    it -= n_ctx;
    expconv_item(p, 1, it, lds, tid);
  }
}

DI void phase_moe1(const Params& p, int layer, unsigned* ctr, int* s_item, char* lds, int tid) {
  const bfraw* WGU = (const bfraw*)(p.ws + O_WGU);
  const int n_lat = 16 * 16 * 16, n_ctx = (layer == 0) ? 16 * 16 : 0;
  for (;;) {
    const int item = next_item(ctr, s_item, tid);
    if (item >= n_lat + n_ctx) break;
    const bool is_ctx = item >= n_lat;
    const int r = is_ctx ? item - n_lat : item;
    const int RT = is_ctx ? 1 : 16;
    const int cap = is_ctx ? CAPC : CAP, T = is_ctx ? CTX : SEQ;
    const int e = r / (16 * RT), rem = r % (16 * RT), ct = rem / RT, rt = rem % RT;
    const int* IDX = (const int*)(p.ws + (is_ctx ? O_IDXC : O_IDX));
    const bfraw* Hs = (const bfraw*)(p.ws + (is_ctx ? O_HC : O_H));
    bfraw* ACT = (bfraw*)(p.ws + (is_ctx ? O_ACTC : O_ACT));
    const int r0 = tid >> 2, c8 = (tid & 3) * 8;
    const int l0 = rt * 256 + r0, l1 = l0 + 128;
    const int tok0 = IDX[e * 8 * cap + l0], tok1 = IDX[e * 8 * cap + l1];
    const bfraw* a0 = Hs + ((long)(l0 / cap) * T + tok0) * 1024 + c8;
    const bfraw* a1 = Hs + ((long)(l1 / cap) * T + tok1) * 1024 + c8;
    const bfraw* b0 = WGU + ((long)e * 4096 + ct * 256 + r0) * 1024 + c8;
    const bfraw* b1 = b0 + 128 * 1024;
    const long prow0 = (long)e * 8 * cap + rt * 256;
    gemm_tile<true>(a0, a1, b0, b1, 1024, lds, tid, [&](f32x4 (&acc)[8][4], int wr, int wc, int fr, int fq) {
#pragma unroll
      for (int m = 0; m < 8; ++m)
#pragma unroll
        for (int q = 0; q < 2; ++q) {
          const int f = ct * 128 + wc * 32 + q * 16 + fq * 4;
          float sv[4];
#pragma unroll
          for (int j = 0; j < 4; ++j) {
            const float g = acc[m][2 * q][j], u = acc[m][2 * q + 1][j];
            sv[j] = g / (1.f + __expf(-g)) * u;
          }
          uint2 st;
          st.x = pack2(sv[0], sv[1]);
          st.y = pack2(sv[2], sv[3]);
          *(uint2*)(ACT + (prow0 + wr * 128 + m * 16 + fr) * FF + f) = st;
        }
    });
  }
}

DI void phase_moe2(const Params& p, int layer, unsigned* ctr, int* s_item, char* lds, int tid) {
  const bfraw* WD = (const bfraw*)(p.ws + O_WD);
  const int n_lat = 16 * 4 * 16, n_ctx = (layer == 0) ? 16 * 4 : 0;
  for (;;) {
    const int item = next_item(ctr, s_item, tid);
    if (item >= n_lat + n_ctx) break;
    const bool is_ctx = item >= n_lat;
    const int r = is_ctx ? item - n_lat : item;
    const int RT = is_ctx ? 1 : 16;
    const int cap = is_ctx ? CAPC : CAP;
    const int e = r / (4 * RT), rem = r % (4 * RT), ct = rem / RT, rt = rem % RT;
    const bfraw* ACT = (const bfraw*)(p.ws + (is_ctx ? O_ACTC : O_ACT));
    bfraw* Y = (bfraw*)(p.ws + (is_ctx ? O_YC : O_Y));
    const int r0 = tid >> 2, c8 = (tid & 3) * 8;
    const long prow0 = (long)e * 8 * cap + rt * 256;
    const bfraw* a0 = ACT + (prow0 + r0) * FF + c8;
    const bfraw* a1 = a0 + 128 * FF;
    const bfraw* b0 = WD + ((long)e * 1024 + ct * 256 + r0) * FF + c8;
    const bfraw* b1 = b0 + 128 * FF;
    gemm_tile<true>(a0, a1, b0, b1, FF, lds, tid, [&](f32x4 (&acc)[8][4], int wr, int wc, int fr, int fq) {
#pragma unroll
      for (int m = 0; m < 8; ++m)
#pragma unroll
        for (int n = 0; n < 4; ++n) {
          const int col = ct * 256 + wc * 64 + n * 16 + fq * 4;
          uint2 st;
          st.x = pack2(acc[m][n][0], acc[m][n][1]);
          st.y = pack2(acc[m][n][2], acc[m][n][3]);
          *(uint2*)(Y + (prow0 + wr * 128 + m * 16 + fr) * 1024 + col) = st;
        }
    });
  }
}

DI void phase_combine(const Params& p, int layer, int tid) {
  const int w = tid >> 6, lane = tid & 63;
  const float* MOD = (const float*)(p.ws + O_MOD);
  const int nrows = NT + ((layer == 0) ? NCT : 0);
  for (int row = blockIdx.x * NWAVE + w; row < nrows; row += gridDim.x * NWAVE) {
    const bool is_ctx = row >= NT;
    const int rr = is_ctx ? row - NT : row;
    const int T = is_ctx ? CTX : SEQ, cap = is_ctx ? CAPC : CAP;
    const int b = rr / T;
    const float* X1 = (const float*)(p.ws + (is_ctx ? O_X1C : O_X1)) + (long)rr * 1024;
    const short* SLOT = (const short*)(p.ws + (is_ctx ? O_SLOTC : O_SLOT)) + (long)rr * 16;
    const float* GATE = (const float*)(p.ws + (is_ctx ? O_GATEC : O_GATE));
    const bfraw* Y = (const bfraw*)(p.ws + (is_ctx ? O_YC : O_Y));
    const float* mr = MOD + (layer * 9 + (is_ctx ? 8 : b)) * 6144;
    float y[16];
#pragma unroll
    for (int i = 0; i < 16; ++i) y[i] = 0.f;
    for (int e = 0; e < 16; ++e) {
      const int s = SLOT[e];
      if (s >= 0) {
        const long prow = (long)(e * 8 + b) * cap + s;
        const float g = GATE[prow];
        const bfraw* yr = Y + prow * 1024;
#pragma unroll
        for (int i = 0; i < 4; ++i) {
          const uint2 u = *(const uint2*)(yr + i * 256 + lane * 4);
          y[i * 4 + 0] += g * bflo(u.x); y[i * 4 + 1] += g * bfhi(u.x);
          y[i * 4 + 2] += g * bflo(u.y); y[i * 4 + 3] += g * bfhi(u.y);
        }
      }
    }
    float v[16], g2[16];
    load_row16(X1, lane, v);
    load_row16(mr + 5120, lane, g2);
#pragma unroll
    for (int i = 0; i < 16; ++i) v[i] = ALPHA * v[i] + g2[i] * y[i];
    postnorm16(v, p.ln2_g + layer * 1024, p.ln2_b + layer * 1024, lane);
    if (!is_ctx) store_row16(p.out + (long)rr * 1024, lane, v);
    if (layer == 0) {
      const float* mn = MOD + (1 * 9 + (is_ctx ? 8 : b)) * 6144;
      modulate16(v, mn, mn + 1024, lane);
      store_row16_bf((bfraw*)(p.ws + (is_ctx ? O_HC : O_H)) + (long)rr * 1024, lane, v);
    }
  }
}

#ifndef DUP_MASK
#define DUP_MASK 0
#endif
DI void run_phase(const Params& p, int ph, unsigned* ctr, int* s_item, char* smem, int tid) {
  if (ph == 0) phase_prep(p, smem, tid);
  else if (ph == 1) phase_lnmod0(p, tid);
  else {
    const int layer = (ph - 2) >> 3, sub = (ph - 2) & 7;
    switch (sub) {
      case 0: phase_proj(p, layer, ctr, s_item, smem, tid); break;
      case 1: phase_mix(p, layer, ctr, s_item, smem, tid); break;
      case 2: phase_outproj(p, layer, ctr, s_item, smem, tid); break;
      case 3: phase_row(p, layer, smem, tid); break;
      case 4: phase_topk(p, layer, smem, tid); break;
      case 5: phase_moe1(p, layer, ctr, s_item, smem, tid); break;
      case 6: phase_moe2(p, layer, ctr, s_item, smem, tid); break;
      default: phase_combine(p, layer, tid); break;
    }
  }
}

__global__ void __launch_bounds__(NTHR) fwd_kernel(Params p) {
  extern __shared__ __attribute__((aligned(16))) char smem[];
  __shared__ int s_item;
  for (int ph = p.ph_lo; ph < p.ph_hi; ++ph) {
    if (ph > p.ph_lo) cg::this_grid().sync();
    int tid = threadIdx.x;
    asm volatile("" : "+v"(tid));
    unsigned* ctr = (unsigned*)(p.ws + O_CTR) + ph;
    run_phase(p, ph, ctr, &s_item, smem, tid);
#if DUP_MASK
    {
      const int bit = (ph == 0) ? 8 : (ph == 1) ? 9 : ((ph - 2) & 7);
      if ((DUP_MASK >> bit) & 1) {
        cg::this_grid().sync();
        asm volatile("" : "+v"(tid));
        run_phase(p, ph, ctr + 32, &s_item, smem, tid);
      }
    }
#endif
  }
}

extern "C" void kernel_launch(void* const* d_in, const int* in_sizes, int n_in, void* d_out, int out_size, void* d_ws,
                              size_t ws_size, hipStream_t stream) {
  (void)in_sizes; (void)n_in; (void)out_size;
  if (ws_size < O_END) { fprintf(stderr, "kernel_launch: workspace too small (%zu < %zu)\n", ws_size, (size_t)O_END); return; }
  Params p{};
  const float** pp = (const float**)&p;
  for (int i = 0; i < 21; ++i) pp[i] = (const float*)d_in[i];
  p.out = (float*)d_out;
  p.ws = (char*)d_ws;
  static int grid_blocks = 0;
  if (!grid_blocks) {
    int dev = 0, cus = 0, per_cu = 0;
    hipGetDevice(&dev);
    hipDeviceGetAttribute(&cus, hipDeviceAttributeMultiprocessorCount, dev);
    hipFuncSetAttribute((const void*)fwd_kernel, hipFuncAttributeMaxDynamicSharedMemorySize, LDS_BYTES);
    hipOccupancyMaxActiveBlocksPerMultiprocessor(&per_cu, fwd_kernel, NTHR, LDS_BYTES);
    if (per_cu < 1) per_cu = 1;
    if (per_cu > 1) per_cu = 1;
    grid_blocks = cus * per_cu;
  }
#if ONE_LAUNCH
  p.ph_lo = 0; p.ph_hi = NPHASE;
  void* args[] = {&p};
  hipError_t e = hipLaunchCooperativeKernel((void*)fwd_kernel, dim3(grid_blocks), dim3(NTHR), args, LDS_BYTES, stream);
  if (e != hipSuccess) fprintf(stderr, "cooperative launch failed: %s (grid %d)\n", hipGetErrorString(e), grid_blocks);
#else
  for (int ph = 0; ph < NPHASE; ++ph) {
    p.ph_lo = ph; p.ph_hi = ph + 1;
    hipLaunchKernelGGL(fwd_kernel, dim3(grid_blocks), dim3(NTHR), LDS_BYTES, stream, p);
  }
#endif
}
```

```cpp
#include <hip/hip_runtime.h>
#include <hip/hip_cooperative_groups.h>
#include <cstdio>
namespace cg = cooperative_groups;

#ifndef ONE_LAUNCH
#define ONE_LAUNCH 1
#endif

#define DI __device__ __forceinline__
typedef unsigned short bfraw;
using bf16x8 = __attribute__((ext_vector_type(8))) short;
using f32x4 = __attribute__((ext_vector_type(4))) float;

constexpr int NB = 8, SEQ = 4096, DM = 1024, CTX = 256;
constexpr int NT = NB * SEQ, NCT = NB * CTX;
constexpr int NPROJ = 1792;
constexpr int KS = CTX + SEQ;
constexpr int NE = 16, FF = 2048;
constexpr int CAP = 512, CAPC = 32;
constexpr float ALPHA = 1.41421356237f;
constexpr float LOG2E = 1.44269504089f;
constexpr int NPHASE = 18;
constexpr int NTHR = 512;
constexpr int NWAVE = NTHR / 64;
constexpr int LDS_BYTES = 131072;

constexpr size_t al(size_t x) { return (x + 255) & ~size_t(255); }
constexpr size_t O_MOD = 0;
constexpr size_t O_ROPE = al(O_MOD + 2 * 9 * 6144 * 4);
constexpr size_t O_CTR = al(O_ROPE + 2 * 1024 * 4);
constexpr size_t O_WINT = al(O_CTR + 64 * 4);
constexpr size_t O_WOUTT = al(O_WINT + 2ull * NPROJ * 1024 * 2);
constexpr size_t O_DFT = al(O_WOUTT + 2ull * 1024 * 1024 * 2);
constexpr size_t O_DFTC = al(O_DFT + 4096ull * 8192 * 2);
constexpr size_t O_WGU = al(O_DFTC + 256ull * 512 * 2);
constexpr size_t O_WD = al(O_WGU + 16ull * 4096 * 1024 * 2);
constexpr size_t O_X1 = al(O_WD + 16ull * 1024 * 2048 * 2);
constexpr size_t O_X1C = al(O_X1 + (size_t)NT * 1024 * 4);
constexpr size_t O_H = al(O_X1C + (size_t)NCT * 1024 * 4);
constexpr size_t O_HC = al(O_H + (size_t)NT * 1024 * 2);
constexpr size_t O_AFF = al(O_HC + (size_t)NCT * 1024 * 2);
constexpr size_t O_AFFC = al(O_AFF + 8ull * 16 * 4096 * 4);
constexpr size_t O_IDX = al(O_AFFC + 8ull * 16 * 256 * 4);
constexpr size_t O_GATE = al(O_IDX + 16ull * 8 * 512 * 4);
constexpr size_t O_SLOT = al(O_GATE + 16ull * 8 * 512 * 4);
constexpr size_t O_IDXC = al(O_SLOT + 8ull * 4096 * 16 * 2);
constexpr size_t O_GATEC = al(O_IDXC + 16ull * 8 * 32 * 4);
constexpr size_t O_SLOTC = al(O_GATEC + 16ull * 8 * 32 * 4);
constexpr size_t O_Y = al(O_SLOTC + 8ull * 256 * 16 * 2);
constexpr size_t O_YC = al(O_Y + 65536ull * 1024 * 2);
constexpr size_t O_ACTC = al(O_YC + 4096ull * 1024 * 2);
constexpr size_t O_R = al(O_ACTC + 4096ull * 2048 * 2);
constexpr size_t O_ACT = O_R;
constexpr size_t O_QA = O_R;
constexpr size_t O_QC = al(O_QA + (size_t)NT * 512 * 2);
constexpr size_t O_KA = al(O_QC + (size_t)NT * 256 * 2);
constexpr size_t O_VAT = al(O_KA + 8ull * 2 * KS * 64 * 2);
constexpr size_t O_KC = al(O_VAT + 8ull * 2 * KS * 64 * 2);
constexpr size_t O_VCT = al(O_KC + 8ull * 2 * KS * 64 * 2);
constexpr size_t O_VTF = al(O_VCT + 8ull * 2 * KS * 64 * 2);
constexpr size_t O_MIX = al(O_VTF + 8ull * 256 * 8192 * 2);
constexpr size_t O_QAC = al(O_MIX + (size_t)NT * 1024 * 2);
constexpr size_t O_QCC = al(O_QAC + (size_t)NCT * 512 * 2);
constexpr size_t O_VTFC = al(O_QCC + (size_t)NCT * 256 * 2);
constexpr size_t O_MIXC = al(O_VTFC + 8ull * 256 * 512 * 2);
constexpr size_t O_REND = al(O_MIXC + (size_t)NCT * 1024 * 2);
constexpr size_t O_END = O_R + 65536ull * 2048 * 2;
static_assert(O_REND <= O_END, "mixer buffers must fit in the ACT region");
static_assert(O_END <= 1073741824ull, "workspace too large");

struct Params {
  const float *x, *c, *ctx, *c_ctx, *w_mod, *b_mod, *w_in, *q_norm, *k_norm, *w_four, *b_four, *sink, *w_out,
      *ln1_g, *ln1_b, *w_router, *w_gate, *w_up, *w_down, *ln2_g, *ln2_b;
  float* out;
  char* ws;
  int ph_lo, ph_hi;
};

typedef __bf16 hwbf2 __attribute__((ext_vector_type(2)));
typedef float hwf2 __attribute__((ext_vector_type(2)));
DI unsigned pack2(float a, float b) {
  hwf2 f = {a, b};
  return __builtin_bit_cast(unsigned, __builtin_convertvector(f, hwbf2));
}
DI bfraw f2bf(float x) { return (bfraw)(pack2(x, 0.f) & 0xffffu); }
DI float bflo(unsigned u) { return __uint_as_float(u << 16); }
DI float bfhi(unsigned u) { return __uint_as_float(u & 0xffff0000u); }
DI float wsum(float v) {
#pragma unroll
  for (int o = 32; o; o >>= 1) v += __shfl_xor(v, o);
  return v;
}
DI void glds16(const void* g, char* l) {
  __builtin_amdgcn_global_load_lds((const unsigned*)g, (unsigned*)l, 16, 0, 0);
}
DI void wait_vm0() { asm volatile("s_waitcnt vmcnt(0)" ::: "memory"); }
DI f32x4 mfma16(bf16x8 a, bf16x8 b, f32x4 c) { return __builtin_amdgcn_mfma_f32_16x16x32_bf16(a, b, c, 0, 0, 0); }

DI int next_item(unsigned* ctr, int* s_item, int tid) {
  __syncthreads();
  if (tid == 0) *s_item = (int)atomicAdd(ctr, 1u);
  __syncthreads();
  return *s_item;
}

DI void gemm_stage(const bfraw* a0, const bfraw* a1, const bfraw* b0, const bfraw* b1, int k0, char* st, int tid) {
  glds16(a0 + k0, st + tid * 16);
  glds16(a1 + k0, st + (NTHR + tid) * 16);
  glds16(b0 + k0, st + 16384 + tid * 16);
  glds16(b1 + k0, st + 16384 + (NTHR + tid) * 16);
}

template <bool SWAP, class Epi>
DI void gemm_tile(const bfraw* a0, const bfraw* a1, const bfraw* b0, const bfraw* b1, int K, char* lds, int tid, Epi epi) {
  asm volatile("" : "+v"(tid));
  const int w = tid >> 6, lane = tid & 63, wr = w >> 2, wc = w & 3, fr = lane & 15, fq = lane >> 4;
  f32x4 acc[8][4];
#pragma unroll
  for (int m = 0; m < 8; ++m)
#pragma unroll
    for (int n = 0; n < 4; ++n) acc[m][n] = f32x4{0.f, 0.f, 0.f, 0.f};
  const int ns = K >> 5;
  __syncthreads();
  gemm_stage(a0, a1, b0, b1, 0, lds, tid);
  gemm_stage(a0, a1, b0, b1, 32, lds + 32768, tid);
  gemm_stage(a0, a1, b0, b1, 64, lds + 65536, tid);
  asm volatile("s_waitcnt vmcnt(8)" ::: "memory");
  __builtin_amdgcn_s_barrier();
  asm volatile("" ::: "memory");
  const int aoff = (wr * 128 + fr) * 64 + fq * 16;
  const int boff = 16384 + (wc * 64 + fr) * 64 + fq * 16;
#pragma unroll 1
  for (int j = 0; j < ns; ++j) {
    const char* st = lds + (j & 3) * 32768;
    bf16x8 bfr[4], af[8];
#pragma unroll
    for (int n = 0; n < 4; ++n) bfr[n] = *(const bf16x8*)(st + boff + n * 1024);
#pragma unroll
    for (int m = 0; m < 8; ++m) af[m] = *(const bf16x8*)(st + aoff + m * 1024);
    if (j + 1 < ns) {
      if (j + 2 < ns) asm volatile("s_waitcnt vmcnt(4)" ::: "memory");
      else asm volatile("s_waitcnt vmcnt(0)" ::: "memory");
      __builtin_amdgcn_s_barrier();
      asm volatile("" ::: "memory");
      if (j + 3 < ns) gemm_stage(a0, a1, b0, b1, (j + 3) * 32, lds + ((j + 3) & 3) * 32768, tid);
    }
#pragma unroll
    for (int m = 0; m < 8; ++m)
#pragma unroll
      for (int n = 0; n < 4; ++n) acc[m][n] = SWAP ? mfma16(bfr[n], af[m], acc[m][n]) : mfma16(af[m], bfr[n], acc[m][n]);
  }
  epi(acc, wr, wc, fr, fq);
}

DI void attn_stage(const bfraw* Kp, const bfraw* VTp, int ldv, int tile, char* st, int tid) {
  const int slot0 = tile * 64;
  const int h = tid >> 8, r = (tid & 255) >> 2, c8 = (tid & 3) * 8;
  glds16(Kp + (long)(slot0 + r) * 64 + h * 32 + c8, st + tid * 16);
  glds16(VTp + (long)r * ldv + slot0 + h * 32 + c8, st + 8192 + tid * 16);
}

template <bool WINDOW>
DI void attn_item(const bfraw* Qp, int qstride, const bfraw* Kp, const bfraw* VTp, int ldv, int n1, int tlo, int n2,
                  int qpos0, bool has_sink, float sink_l2, bfraw* Op, int ostride, char* lds, int tid) {
  asm volatile("" : "+v"(tid));
  const int w = tid >> 6, lane = tid & 63, fr = lane & 15, fq = lane >> 4;
  const float scale_l2 = 0.125f * LOG2E;
  bf16x8 qf[2][2];
#pragma unroll
  for (int n = 0; n < 2; ++n)
#pragma unroll
    for (int sd = 0; sd < 2; ++sd)
      qf[n][sd] = *(const bf16x8*)(Qp + (long)(w * 32 + n * 16 + fr) * qstride + sd * 32 + fq * 8);
  float m_run[2], l_run[2];
  f32x4 o[4][2];
#pragma unroll
  for (int n = 0; n < 2; ++n) {
    m_run[n] = has_sink ? sink_l2 : -1e30f;
    l_run[n] = (has_sink && fq == 0) ? 1.f : 0.f;
#pragma unroll
    for (int md = 0; md < 4; ++md) o[md][n] = f32x4{0.f, 0.f, 0.f, 0.f};
  }
  const int nt = n1 + n2;
  __syncthreads();
  attn_stage(Kp, VTp, ldv, (0 < n1) ? 0 : tlo, lds, tid);
#pragma unroll 1
  for (int it = 0; it < nt; ++it) {
    wait_vm0();
    __syncthreads();
    if (it + 1 < nt) {
      const int nx = it + 1;
      attn_stage(Kp, VTp, ldv, (nx < n1) ? nx : tlo + (nx - n1), lds + (nx & 1) * 16384, tid);
    }
    const char* sK = lds + (it & 1) * 16384;
    const char* sV = sK + 8192;
    f32x4 s[4][2];
#pragma unroll
    for (int m = 0; m < 4; ++m)
#pragma unroll
      for (int n = 0; n < 2; ++n) s[m][n] = f32x4{0.f, 0.f, 0.f, 0.f};
#pragma unroll
    for (int sd = 0; sd < 2; ++sd) {
#pragma unroll
      for (int m = 0; m < 4; ++m) {
        const int krow = (m >> 1) * 32 + (fr >> 2) * 8 + (m & 1) * 4 + (fr & 3);
        bf16x8 kf = *(const bf16x8*)(sK + sd * 4096 + krow * 64 + fq * 16);
#pragma unroll
        for (int n = 0; n < 2; ++n) s[m][n] = mfma16(kf, qf[n][sd], s[m][n]);
      }
    }
    const int tile = (it < n1) ? it : tlo + (it - n1);
    const bool domask = WINDOW && (it >= n1);
#pragma unroll
    for (int n = 0; n < 2; ++n) {
      if (domask) {
        const int qpos = qpos0 + w * 32 + n * 16 + fr;
#pragma unroll
        for (int m = 0; m < 4; ++m)
#pragma unroll
          for (int j = 0; j < 4; ++j) {
            const int kpos = tile * 64 - CTX + (m >> 1) * 32 + fq * 8 + (m & 1) * 4 + j;
            const int d = qpos - kpos;
            if (d > 128 || d < -128) s[m][n][j] = -1e30f;
          }
      }
      float mx = -1e30f;
#pragma unroll
      for (int m = 0; m < 4; ++m) {
        mx = fmaxf(mx, fmaxf(s[m][n][0], s[m][n][1]));
        mx = fmaxf(mx, fmaxf(s[m][n][2], s[m][n][3]));
      }
      mx = fmaxf(mx, __shfl_xor(mx, 16));
      mx = fmaxf(mx, __shfl_xor(mx, 32));
      const float mxs = mx * scale_l2;
      const bool need = mxs > m_run[n] + 8.f;
      if (__any(need)) {
        const float m_new = need ? mxs : m_run[n];
        const float alpha = __builtin_amdgcn_exp2f(m_run[n] - m_new);
        m_run[n] = m_new;
        l_run[n] *= alpha;
#pragma unroll
        for (int md = 0; md < 4; ++md) {
          o[md][n][0] *= alpha; o[md][n][1] *= alpha; o[md][n][2] *= alpha; o[md][n][3] *= alpha;
        }
      }
      const float nm = -m_run[n];
      float ls = 0.f;
#pragma unroll
      for (int m = 0; m < 4; ++m)
#pragma unroll
        for (int j = 0; j < 4; ++j) {
          const float p = __builtin_amdgcn_exp2f(__builtin_fmaf(s[m][n][j], scale_l2, nm));
          s[m][n][j] = p;
          ls += p;
        }
      l_run[n] += ls;
    }
#pragma unroll
    for (int ks = 0; ks < 2; ++ks) {
      bf16x8 pf[2];
#pragma unroll
      for (int n = 0; n < 2; ++n) {
        const unsigned u0 = pack2(s[2 * ks][n][0], s[2 * ks][n][1]);
        const unsigned u1 = pack2(s[2 * ks][n][2], s[2 * ks][n][3]);
        const unsigned u2 = pack2(s[2 * ks + 1][n][0], s[2 * ks + 1][n][1]);
        const unsigned u3 = pack2(s[2 * ks + 1][n][2], s[2 * ks + 1][n][3]);
        const uint4 uu = make_uint4(u0, u1, u2, u3);
        pf[n] = __builtin_bit_cast(bf16x8, uu);
      }
#pragma unroll
      for (int md = 0; md < 4; ++md) {
        bf16x8 vf = *(const bf16x8*)(sV + ks * 4096 + (md * 16 + fr) * 64 + fq * 16);
#pragma unroll
        for (int n = 0; n < 2; ++n) o[md][n] = mfma16(vf, pf[n], o[md][n]);
      }
    }
  }
#pragma unroll
  for (int n = 0; n < 2; ++n) {
    float l = l_run[n];
    l += __shfl_xor(l, 16);
    l += __shfl_xor(l, 32);
    const float inv = 1.f / l;
    bfraw* orow = Op + (long)(w * 32 + n * 16 + fr) * ostride;
#pragma unroll
    for (int md = 0; md < 4; ++md) {
      uint2 st;
      st.x = pack2(o[md][n][0] * inv, o[md][n][1] * inv);
      st.y = pack2(o[md][n][2] * inv, o[md][n][3] * inv);
      *(uint2*)(orow + md * 16 + fq * 4) = st;
    }
  }
}

DI void xpose_tile(const float* src, long ld_src, bfraw* dst, long ld_dst, int mode, char* lds, int tid) {
  float(*t)[65] = (float(*)[65])lds;
  __syncthreads();
  {
    const int c = tid & 63, r0 = tid >> 6;
#pragma unroll 4
    for (int rr = r0; rr < 64; rr += NWAVE) t[rr][c] = src[(long)rr * ld_src + c];
  }
  __syncthreads();
  {
    const int k8 = (tid & 7) * 8, nn = tid >> 3;
    uint4 v;
    v.x = pack2(t[k8 + 0][nn], t[k8 + 1][nn]);
    v.y = pack2(t[k8 + 2][nn], t[k8 + 3][nn]);
    v.z = pack2(t[k8 + 4][nn], t[k8 + 5][nn]);
    v.w = pack2(t[k8 + 6][nn], t[k8 + 7][nn]);
    const int row = (mode == 0) ? nn : ((nn >> 4) * 32 + (mode == 2 ? 16 : 0) + (nn & 15));
    *(uint4*)(dst + (long)row * ld_dst + k8) = v;
  }
}

DI void xpose256(const float* src, long ld_src, bfraw* dst, long ld_dst, int mode, char* lds, int tid) {
  const int w = tid >> 6, lane = tid & 63;
  float4 v[8];
#pragma unroll
  for (int i = 0; i < 8; ++i) {
    const int k = 2 * (w + 8 * (i >> 1)) + (i & 1);
    v[i] = *(const float4*)(src + (long)k * ld_src + lane * 4);
  }
  __syncthreads();
#pragma unroll
  for (int i2 = 0; i2 < 4; ++i2) {
    const int k = 2 * (w + 8 * i2);
    char* base = lds + (lane * 4) * 136 + k * 2;
    *(unsigned*)(base + 0 * 136) = pack2(v[2 * i2].x, v[2 * i2 + 1].x);
    *(unsigned*)(base + 1 * 136) = pack2(v[2 * i2].y, v[2 * i2 + 1].y);
    *(unsigned*)(base + 2 * 136) = pack2(v[2 * i2].z, v[2 * i2 + 1].z);
    *(unsigned*)(base + 3 * 136) = pack2(v[2 * i2].w, v[2 * i2 + 1].w);
  }
  __syncthreads();
#pragma unroll
  for (int q = 0; q < 4; ++q) {
    const int c = tid + NTHR * q;
    const int n = c >> 3, k8 = (c & 7) * 8;
    const uint2 lo = *(const uint2*)(lds + n * 136 + k8 * 2);
    const uint2 hi = *(const uint2*)(lds + n * 136 + k8 * 2 + 8);
    const int row = (mode == 0) ? n : ((n >> 4) * 32 + (mode == 2 ? 16 : 0) + (n & 15));
    *(uint4*)(dst + (long)row * ld_dst + k8) = make_uint4(lo.x, lo.y, hi.x, hi.y);
  }
}

constexpr int N_EXPCONV = 4096 + 2048;
DI void expconv_item(const Params& p, int layer, int item, char* lds, int tid) {
  bfraw* WGU = (bfraw*)(p.ws + O_WGU);
  bfraw* WD = (bfraw*)(p.ws + O_WD);
  if (item < 4096) {
    const int type = item & 1;
    int r = item >> 1;
    const int nt = r & 7; r >>= 3;
    const int kt = r & 15; const int e = r >> 4;
    const float* src = (type ? p.w_up : p.w_gate) + ((long)(layer * NE + e) * DM + kt * 64) * FF + nt * 256;
    bfraw* dst = WGU + ((long)e * 4096 + nt * 512) * DM + kt * 64;
    xpose256(src, FF, dst, DM, 1 + type, lds, tid);
  } else {
    int r = item - 4096;
    const int nt = r & 3; r >>= 2;
    const int kt = r & 31; const int e = r >> 5;
    const float* src = p.w_down + ((long)(layer * NE + e) * FF + kt * 64) * DM + nt * 256;
    bfraw* dst = WD + ((long)e * DM + nt * 256) * FF + kt * 64;
    xpose256(src, DM, dst, FF, 0, lds, tid);
  }
}

DI void prep_mod_item(const Params& p, int item, char* lds, int tid) {
  const int layer = item / 96, chunk = item % 96;
  float* sc = (float*)lds;
  float* red = (float*)(lds + 36864);
  __syncthreads();
  for (int idx = tid; idx < 9 * 1024; idx += NTHR) {
    const int r = idx >> 10, k = idx & 1023;
    const float v = (r < 8) ? p.c[r * 1024 + k] : p.c_ctx[k];
    sc[idx] = v / (1.f + __expf(-v));
  }
  __syncthreads();
  const int w = tid >> 6, lane = tid & 63;
  const int col = chunk * 64 + lane;
  float acc[9];
#pragma unroll
  for (int r = 0; r < 9; ++r) acc[r] = 0.f;
  const float* wp = p.w_mod + ((long)layer * 1024 + w * 128) * 6144 + col;
#pragma unroll 4
  for (int k = 0; k < 128; ++k) {
    const float wv = wp[(long)k * 6144];
#pragma unroll
    for (int r = 0; r < 9; ++r) acc[r] += sc[r * 1024 + w * 128 + k] * wv;
  }
#pragma unroll
  for (int r = 0; r < 9; ++r) red[(w * 9 + r) * 64 + lane] = acc[r];
  __syncthreads();
  float* MOD = (float*)(p.ws + O_MOD);
  for (int idx = tid; idx < 9 * 64; idx += NTHR) {
    const int r = idx >> 6, l = idx & 63;
    float s = p.b_mod[layer * 6144 + chunk * 64 + l];
#pragma unroll
    for (int ww = 0; ww < NWAVE; ++ww) s += red[(ww * 9 + r) * 64 + l];
    MOD[(layer * 9 + r) * 6144 + chunk * 64 + l] = s;
  }
}

DI void prep_four_item(const Params& p, int item, char* lds, int tid) {
  const int layer = item >> 6, g = (item >> 4) & 3, kt = item & 15;
  float* G = (float*)lds;
  float(*Wt)[65] = (float(*)[65])(lds + 32768);
  float* ctab = (float*)(lds + 32768 + 64 * 65 * 4);
  __syncthreads();
  const float* wg = p.w_four + (long)(layer * 4 + g) * 4096;
  for (int idx = tid; idx < 4096; idx += NTHR) Wt[idx >> 6][idx & 63] = wg[idx];
  if (tid < 64) {
    float sn, cs;
    sincospif((float)tid / 32.f, &sn, &cs);
    ctab[tid] = cs;
    ctab[64 + tid] = sn;
  }
  __syncthreads();
  for (int o = tid; o < 4096; o += NTHR) {
    const int c = o >> 6, d = o & 63;
    float s1 = 0.f, s2 = 0.f;
#pragma unroll 4
    for (int c2 = 0; c2 < 64; ++c2) {
      const int a = (c * c2) & 63;
      const float wv = Wt[c2][d];
      s1 += ctab[a] * wv;
      s2 += ctab[64 + a] * wv;
    }
    G[o] = s1;
    G[4096 + o] = s2;
  }
  __syncthreads();
  const float* wi = p.w_in + ((long)layer * 1024 + kt * 64) * 1536 + 768 + g * 64;
  for (int idx = tid; idx < 4096; idx += NTHR) Wt[idx >> 6][idx & 63] = wi[(long)(idx >> 6) * 1536 + (idx & 63)];
  __syncthreads();
  bfraw* WINT = (bfraw*)(p.ws + O_WINT) + (long)layer * NPROJ * 1024;
  for (int o = tid; o < 64 * 128; o += NTHR) {
    const int kk = o & 63, dcol = o >> 6;
    const float* Gs = G + (dcol >> 6) * 4096 + (dcol & 63);
    float s = 0.f;
#pragma unroll 4
    for (int c = 0; c < 64; ++c) s += Wt[kk][c] * Gs[c * 64];
    const int row = (dcol < 64) ? (768 + g * 64 + dcol) : (1024 + g * 64 + (dcol - 64));
    WINT[(long)row * 1024 + kt * 64 + kk] = f2bf(s);
  }
}

constexpr int P0_MOD = 192, P0_FOUR = 128, P0_ROPE = 1, P0_DFTC = 256, P0_DFT = 4096, P0_WIN = 2 * 16 * 24, P0_WOUT = 2 * 16 * 16;
constexpr int P0_TOTAL = P0_MOD + P0_FOUR + P0_ROPE + P0_DFTC + P0_DFT + P0_WIN + P0_WOUT + N_EXPCONV;

DI void phase_prep(const Params& p, char* lds, int tid) {
  if (blockIdx.x == 0 && tid < 64) ((unsigned*)(p.ws + O_CTR))[tid] = 0u;
  for (int item = blockIdx.x; item < P0_TOTAL; item += gridDim.x) {
    int it = item;
    if (it < P0_MOD) { prep_mod_item(p, it, lds, tid); continue; }
    it -= P0_MOD;
    if (it < P0_FOUR) { prep_four_item(p, it, lds, tid); continue; }
    it -= P0_FOUR;
    if (it < P0_ROPE) {
      float* rope = (float*)(p.ws + O_ROPE);
      for (int idx = tid; idx < 1024; idx += NTHR) {
        const int pos = idx >> 4, f = idx & 15;
        const float inv_freq = powf(10000.f, -(float)f / 16.f);
        const float ang = (float)pos * inv_freq;
        rope[idx] = cosf(ang);
        rope[1024 + idx] = sinf(ang);
      }
      continue;
    }
    it -= P0_ROPE;
    if (it < P0_DFTC) {
      bfraw* D = (bfraw*)(p.ws + O_DFTC) + (long)it * 512;
      for (int k = tid; k < 512; k += NTHR) {
        const int kk = k & 255;
        float sn, cs;
        sincospif((float)((it * kk) & 255) / 128.f, &sn, &cs);
        D[k] = f2bf(k < 256 ? cs : -sn);
      }
      continue;
    }
    it -= P0_DFTC;
    if (it < P0_DFT) {
      bfraw* D = (bfraw*)(p.ws + O_DFT) + (long)it * 8192;
      for (int ch = tid; ch < 4096; ch += NTHR) {
        const int k = ch * 2, kk = k & 4095;
        float sn0, cs0, sn1, cs1;
        sincospif((float)((it * kk) & 4095) / 2048.f, &sn0, &cs0);
        sincospif((float)((it * (kk + 1)) & 4095) / 2048.f, &sn1, &cs1);
        *(unsigned*)(D + k) = (k < 4096) ? pack2(cs0, cs1) : pack2(-sn0, -sn1);
      }
      continue;
    }
    it -= P0_DFT;
    if (it < P0_WIN) {
      const int layer = it / 384, r = it % 384, kt = r / 24, nt = r % 24;
      if (nt >= 12 && nt < 16) continue;
      const int col = nt * 64;
      int drow;
      if (col < 768) drow = col;
      else if (col < 1152) drow = col + 256;
      else if (col < 1280) drow = col + 384;
      else if (col < 1408) drow = col + 128;
      else drow = col + 256;
      const float* src = p.w_in + ((long)layer * 1024 + kt * 64) * 1536 + col;
      bfraw* dst = (bfraw*)(p.ws + O_WINT) + ((long)layer * NPROJ + drow) * 1024 + kt * 64;
      xpose_tile(src, 1536, dst, 1024, 0, lds, tid);
      continue;
    }
    it -= P0_WIN;
    if (it < P0_WOUT) {
      const int layer = it >> 8, r = it & 255, kt = r >> 4, nt = r & 15;
      const float* src = p.w_out + ((long)layer * 1024 + kt * 64) * 1024 + nt * 64;
      bfraw* dst = (bfraw*)(p.ws + O_WOUTT) + ((long)layer * 1024 + nt * 64) * 1024 + kt * 64;
      xpose_tile(src, 1024, dst, 1024, 0, lds, tid);
      continue;
    }
    it -= P0_WOUT;
    expconv_item(p, 0, it, lds, tid);
  }
}

DI void ln_stats(const float v[16], float& mean, float& rstd) {
  float s = 0.f;
#pragma unroll
  for (int i = 0; i < 16; ++i) s += v[i];
  mean = wsum(s) * (1.f / 1024.f);
  float q = 0.f;
#pragma unroll
  for (int i = 0; i < 16; ++i) { const float d = v[i] - mean; q += d * d; }
  rstd = rsqrtf(wsum(q) * (1.f / 1024.f) + 1e-5f);
}
DI void load_row16(const float* src, int lane, float v[16]) {
#pragma unroll
  for (int i = 0; i < 4; ++i) {
    const float4 t = *(const float4*)(src + i * 256 + lane * 4);
    v[i * 4 + 0] = t.x; v[i * 4 + 1] = t.y; v[i * 4 + 2] = t.z; v[i * 4 + 3] = t.w;
  }
}
DI void store_row16(float* dst, int lane, const float v[16]) {
#pragma unroll
  for (int i = 0; i < 4; ++i) *(float4*)(dst + i * 256 + lane * 4) = make_float4(v[i * 4], v[i * 4 + 1], v[i * 4 + 2], v[i * 4 + 3]);
}
DI void store_row16_bf(bfraw* dst, int lane, const float v[16]) {
#pragma unroll
  for (int i = 0; i < 4; ++i) {
    uint2 st;
    st.x = pack2(v[i * 4], v[i * 4 + 1]);
    st.y = pack2(v[i * 4 + 2], v[i * 4 + 3]);
    *(uint2*)(dst + i * 256 + lane * 4) = st;
  }
}
DI void modulate16(float v[16], const float* sh, const float* sc, int lane) {
  float mean, rstd;
  ln_stats(v, mean, rstd);
  float a[16], b[16];
  load_row16(sh, lane, a);
  load_row16(sc, lane, b);
#pragma unroll
  for (int i = 0; i < 16; ++i) v[i] = (v[i] - mean) * rstd * (1.f + b[i]) + a[i];
}
DI void postnorm16(float v[16], const float* g, const float* bb, int lane) {
  float mean, rstd;
  ln_stats(v, mean, rstd);
  float a[16], b[16];
  load_row16(g, lane, a);
  load_row16(bb, lane, b);
#pragma unroll
  for (int i = 0; i < 16; ++i) v[i] = (v[i] - mean) * rstd * a[i] + b[i];
}

DI void phase_lnmod0(const Params& p, int tid) {
  const int w = tid >> 6, lane = tid & 63;
  const float* MOD = (const float*)(p.ws + O_MOD);
  for (int row = blockIdx.x * NWAVE + w; row < NT + NCT; row += gridDim.x * NWAVE) {
    float v[16];
    if (row < NT) {
      load_row16(p.x + (long)row * 1024, lane, v);
      const float* mr = MOD + (0 * 9 + row / SEQ) * 6144;
      modulate16(v, mr, mr + 1024, lane);
      store_row16_bf((bfraw*)(p.ws + O_H) + (long)row * 1024, lane, v);
    } else {
      const int rc = row - NT;
      load_row16(p.ctx + (long)rc * 1024, lane, v);
      const float* mr = MOD + (0 * 9 + 8) * 6144;
      modulate16(v, mr, mr + 1024, lane);
      store_row16_bf((bfraw*)(p.ws + O_HC) + (long)rc * 1024, lane, v);
    }
  }
}

DI void proj_item(const Params& p, int layer, bool is_ctx, int rt, int ct, char* lds, int tid) {
  const int T = is_ctx ? CTX : SEQ;
  const bfraw* Hs = (const bfraw*)(p.ws + (is_ctx ? O_HC : O_H));
  const bfraw* W = (const bfraw*)(p.ws + O_WINT) + (long)layer * NPROJ * 1024;
  const int r0 = tid >> 2, c8 = (tid & 3) * 8;
  const bfraw* a0 = Hs + (long)(rt * 256 + r0) * 1024 + c8;
  const bfraw* a1 = a0 + 128 * 1024;
  const bfraw* b0 = W + (long)(ct * 256 + r0) * 1024 + c8;
  const bfraw* b1 = b0 + 128 * 1024;
  char* ws = p.ws;
  if (ct <= 2 || ct == 5) {
    const float* rope = (const float*)(ws + O_ROPE);
    gemm_tile<true>(a0, a1, b0, b1, 1024, lds, tid, [&](f32x4 (&acc)[8][4], int wr, int wc, int fr, int fq) {
      const int rowbase = rt * 256 + wr * 128;
      const int b = rowbase / T;
      const int tbase = rowbase - b * T;
      const bool donorm = (ct < 2) || (ct == 5 && wc < 2);
      const float* gn = ((ct < 2) ? p.q_norm : p.k_norm) + layer * 64;
      bfraw* dst;
      long rstride;
      if (ct < 2) { dst = (bfraw*)(ws + (is_ctx ? O_QAC : O_QA)) + ((long)rowbase * 8 + (ct * 4 + wc)) * 64; rstride = 512; }
      else if (ct == 2) { dst = (bfraw*)(ws + (is_ctx ? O_QCC : O_QC)) + ((long)rowbase * 4 + wc) * 64; rstride = 256; }
      else {
        const int slot0 = is_ctx ? tbase : CTX + tbase;
        dst = (bfraw*)(ws + (wc < 2 ? O_KA : O_KC)) + ((long)(b * 2 + (wc & 1)) * KS + slot0) * 64; rstride = 64;
      }
#pragma unroll
      for (int m = 0; m < 8; ++m) {
        const int rl = m * 16 + fr;
        float rs = 1.f;
        if (donorm) {
          float ss = 0.f;
#pragma unroll
          for (int n = 0; n < 4; ++n)
#pragma unroll
            for (int j = 0; j < 4; ++j) ss += acc[m][n][j] * acc[m][n][j];
          ss += __shfl_xor(ss, 16);
          ss += __shfl_xor(ss, 32);
          rs = rsqrtf(ss * (1.f / 64.f) + 1e-6f);
        }
        float xv[4][4];
        const float* gp = gn;
        asm volatile("" : "+s"(gp));
#pragma unroll
        for (int n = 0; n < 4; ++n) {
          if (donorm) {
            const float4 t = *(const float4*)(gp + n * 16 + fq * 4);
            xv[n][0] = acc[m][n][0] * rs * t.x; xv[n][1] = acc[m][n][1] * rs * t.y;
            xv[n][2] = acc[m][n][2] * rs * t.z; xv[n][3] = acc[m][n][3] * rs * t.w;
          } else {
            xv[n][0] = acc[m][n][0]; xv[n][1] = acc[m][n][1]; xv[n][2] = acc[m][n][2]; xv[n][3] = acc[m][n][3];
          }
        }
        if (!is_ctx) {
          const int t = tbase + rl;
          const int pr = t >> 6, pc = t & 63;
          const float4 c0 = *(const float4*)(rope + pr * 16 + fq * 4), s0 = *(const float4*)(rope + 1024 + pr * 16 + fq * 4);
          const float4 c1 = *(const float4*)(rope + pc * 16 + fq * 4), s1 = *(const float4*)(rope + 1024 + pc * 16 + fq * 4);
          const float c0a[4] = {c0.x, c0.y, c0.z, c0.w}, s0a[4] = {s0.x, s0.y, s0.z, s0.w};
          const float c1a[4] = {c1.x, c1.y, c1.z, c1.w}, s1a[4] = {s1.x, s1.y, s1.z, s1.w};
#pragma unroll
          for (int j = 0; j < 4; ++j) {
            const float y0 = xv[0][j] * c0a[j] - xv[1][j] * s0a[j], y1 = xv[1][j] * c0a[j] + xv[0][j] * s0a[j];
            const float y2 = xv[2][j] * c1a[j] - xv[3][j] * s1a[j], y3 = xv[3][j] * c1a[j] + xv[2][j] * s1a[j];
            xv[0][j] = y0; xv[1][j] = y1; xv[2][j] = y2; xv[3][j] = y3;
          }
        }
        bfraw* d = dst + (long)rl * rstride + fq * 4;
#pragma unroll
        for (int n = 0; n < 4; ++n) {
          uint2 st;
          st.x = pack2(xv[n][0], xv[n][1]);
          st.y = pack2(xv[n][2], xv[n][3]);
          *(uint2*)(d + n * 16) = st;
        }
      }
    });
  } else {
    gemm_tile<false>(a0, a1, b0, b1, 1024, lds, tid, [&](f32x4 (&acc)[8][4], int wr, int wc, int fr, int fq) {
      const int rowbase = rt * 256 + wr * 128;
      const int b = rowbase / T;
      const int tbase = rowbase - b * T;
      bfraw* dst;
      long cstride;
      if (ct == 6) {
        const int slot0 = is_ctx ? tbase : CTX + tbase;
        dst = (bfraw*)(ws + (wc < 2 ? O_VAT : O_VCT)) + (long)(b * 2 + (wc & 1)) * 64 * KS + slot0;
        cstride = KS;
      } else {
        const int ncol0 = wc * 64;
        const int koff = (ct == 4) ? T : 0;
        if (is_ctx) { dst = (bfraw*)(ws + O_VTFC) + ((long)b * 256 + ncol0) * 512 + koff + tbase; cstride = 512; }
        else { dst = (bfraw*)(ws + O_VTF) + ((long)b * 256 + ncol0) * 8192 + koff + tbase; cstride = 8192; }
      }
#pragma unroll
      for (int m = 0; m < 8; ++m)
#pragma unroll
        for (int n = 0; n < 4; ++n) {
          uint2 st;
          st.x = pack2(acc[m][n][0], acc[m][n][1]);
          st.y = pack2(acc[m][n][2], acc[m][n][3]);
          *(uint2*)(dst + (long)(n * 16 + fr) * cstride + m * 16 + fq * 4) = st;
        }
    });
  }
}

DI void phase_proj(const Params& p, int layer, unsigned* ctr, int* s_item, char* lds, int tid) {
  const int n_lat = 128 * 7;
  const int nct_ctx = (layer == 0) ? 7 : 2;
  const int n_ctx = 8 * nct_ctx;
  for (;;) {
    const int item = next_item(ctr, s_item, tid);
    if (item >= n_lat + n_ctx) break;
    if (item < n_lat) proj_item(p, layer, false, item / 7, item % 7, lds, tid);
    else {
      const int r = item - n_lat;
      const int rt = r / nct_ctx, ct = (layer == 0) ? (r % nct_ctx) : (5 + r % nct_ctx);
      proj_item(p, layer, true, rt, ct, lds, tid);
    }
  }
}

DI void four_item(const Params& p, int layer, bool is_ctx, int b, int rt, char* lds, int tid) {
  const int T = is_ctx ? CTX : SEQ;
  const int K = 2 * T;
  const bfraw* A = (const bfraw*)(p.ws + (is_ctx ? O_DFTC : O_DFT));
  const bfraw* Bt = (const bfraw*)(p.ws + (is_ctx ? O_VTFC : O_VTF)) + (long)b * 256 * K;
  const int r0 = tid >> 2, c8 = (tid & 3) * 8;
  const bfraw* a0 = A + (long)(rt * 256 + r0) * K + c8;
  const bfraw* a1 = a0 + 128l * K;
  const bfraw* b0 = Bt + (long)r0 * K + c8;
  const bfraw* b1 = b0 + 128l * K;
  bfraw* MIX = (bfraw*)(p.ws + (is_ctx ? O_MIXC : O_MIX)) + (long)b * T * 1024;
  const float scale = is_ctx ? (1.f / 128.f) : (1.f / 512.f);
  const float* bias = p.b_four + layer * 256;
  gemm_tile<true>(a0, a1, b0, b1, K, lds, tid, [&](f32x4 (&acc)[8][4], int wr, int wc, int fr, int fq) {
#pragma unroll
    for (int n = 0; n < 4; ++n) {
      const int ncol = wc * 64 + n * 16 + fq * 4;
      const float4 bv = *(const float4*)(bias + ncol);
#pragma unroll
      for (int m = 0; m < 8; ++m) {
        const int t = rt * 256 + wr * 128 + m * 16 + fr;
        uint2 st;
        st.x = pack2(acc[m][n][0] * scale + bv.x, acc[m][n][1] * scale + bv.y);
        st.y = pack2(acc[m][n][2] * scale + bv.z, acc[m][n][3] * scale + bv.w);
        *(uint2*)(MIX + (long)t * 1024 + 512 + ncol) = st;
      }
    }
  });
}

DI void phase_mix(const Params& p, int layer, unsigned* ctr, int* s_item, char* lds, int tid) {
  char* ws = p.ws;
  const int nF = 128, nA = 1024, nC = 512;
  const int nFc = (layer == 0) ? 8 : 0, nAc = (layer == 0) ? 64 : 0, nCc = (layer == 0) ? 32 : 0;
  const int total = nF + nA + nC + nFc + nAc + nCc;
  for (;;) {
    const int item = next_item(ctr, s_item, tid);
    if (item >= total) break;
    int it = item;
    if (it < nF) { four_item(p, layer, false, it >> 4, it & 15, lds, tid); continue; }
    it -= nF;
    if (it >= nA + nC && it < nA + nC + nFc) { four_item(p, layer, true, it - nA - nC, 0, lds, tid); continue; }
    int kind, b, h, qb;
    if (it < nA) { kind = 0; b = it >> 7; h = (it >> 4) & 7; qb = it & 15; }
    else if (it < nA + nC) { it -= nA; kind = 1; b = it >> 6; h = (it >> 4) & 3; qb = it & 15; }
    else {
      it -= nA + nC + nFc;
      if (it < nAc) { kind = 2; b = it >> 3; h = it & 7; qb = 0; }
      else { it -= nAc; kind = 3; b = it >> 2; h = it & 3; qb = 0; }
    }
    const bool isA = (kind == 0 || kind == 2), isctx = (kind >= 2);
    const int nh = isA ? 8 : 4;
    const int kvh = isA ? (h >> 2) : (h >> 1);
    const int T = isctx ? CTX : SEQ;
    const long tok0 = (long)b * T + qb * 256;
    const bfraw* Qp = (const bfraw*)(ws + (isA ? (isctx ? O_QAC : O_QA) : (isctx ? O_QCC : O_QC))) + (tok0 * nh + h) * 64;
    const bfraw* Kp = (const bfraw*)(ws + (isA ? O_KA : O_KC)) + (long)(b * 2 + kvh) * KS * 64;
    const bfraw* Vp = (const bfraw*)(ws + (isA ? O_VAT : O_VCT)) + (long)(b * 2 + kvh) * 64 * KS;
    bfraw* Op = (bfraw*)(ws + (isctx ? O_MIXC : O_MIX)) + tok0 * 1024 + (isA ? 0 : 768) + h * 64;
    const float sk = isA ? 0.f : p.sink[layer * 4 + h] * LOG2E;
    if (kind == 1) {
      const int q0 = qb * 256;
      const int lo = (q0 - 128 < 0) ? 0 : q0 - 128;
      const int hi = (q0 + 384 > SEQ) ? SEQ : q0 + 384;
      attn_item<true>(Qp, 256, Kp, Vp, KS, CTX / 64, (CTX + lo) / 64, (hi - lo) / 64, q0, true, sk, Op, 1024, lds, tid);
    } else {
      attn_item<false>(Qp, nh * 64, Kp, Vp, KS, (kind == 0) ? KS / 64 : CTX / 64, 0, 0, 0, !isA, sk, Op, 1024, lds, tid);
    }
  }
}

DI void phase_outproj(const Params& p, int layer, unsigned* ctr, int* s_item, char* lds, int tid) {
  const int n_lat = 128 * 4, n_ctx = (layer == 0) ? 8 * 4 : 0;
  const bfraw* W = (const bfraw*)(p.ws + O_WOUTT) + (long)layer * 1024 * 1024;
  const float* MOD = (const float*)(p.ws + O_MOD);
  for (;;) {
    const int item = next_item(ctr, s_item, tid);
    if (item >= n_lat + n_ctx) break;
    const bool is_ctx = item >= n_lat;
    const int r = is_ctx ? item - n_lat : item;
    const int rt = r >> 2, ct = r & 3;
    const int T = is_ctx ? CTX : SEQ;
    const bfraw* A = (const bfraw*)(p.ws + (is_ctx ? O_MIXC : O_MIX));
    const float* xin = is_ctx ? p.ctx : (layer == 0 ? p.x : p.out);
    float* X1 = (float*)(p.ws + (is_ctx ? O_X1C : O_X1));
    const int r0 = tid >> 2, c8 = (tid & 3) * 8;
    const bfraw* a0 = A + (long)(rt * 256 + r0) * 1024 + c8;
    const bfraw* a1 = a0 + 128 * 1024;
    const bfraw* b0 = W + (long)(ct * 256 + r0) * 1024 + c8;
    const bfraw* b1 = b0 + 128 * 1024;
    gemm_tile<true>(a0, a1, b0, b1, 1024, lds, tid, [&](f32x4 (&acc)[8][4], int wr, int wc, int fr, int fq) {
      const int rowbase = rt * 256 + wr * 128;
      const int b = is_ctx ? 8 : rowbase / T;
      const float* g1 = MOD + (layer * 9 + b) * 6144 + 2048;
#pragma unroll
      for (int n = 0; n < 4; ++n) {
        const int col = ct * 256 + wc * 64 + n * 16 + fq * 4;
        const float4 gv = *(const float4*)(g1 + col);
#pragma unroll
        for (int m = 0; m < 8; ++m) {
          const long idx = (long)(rowbase + m * 16 + fr) * 1024 + col;
          const float4 xv = *(const float4*)(xin + idx);
          float4 o;
          o.x = ALPHA * xv.x + gv.x * acc[m][n][0];
          o.y = ALPHA * xv.y + gv.y * acc[m][n][1];
          o.z = ALPHA * xv.z + gv.z * acc[m][n][2];
          o.w = ALPHA * xv.w + gv.w * acc[m][n][3];
          *(float4*)(X1 + idx) = o;
        }
      }
    });
  }
}

DI void phase_row(const Params& p, int layer, char* lds, int tid) {
  const int w = tid >> 6, lane = tid & 63;
  float* wrl = (float*)lds;
  __syncthreads();
  {
    const float* wr = p.w_router + (long)layer * 1024 * 16;
    for (int idx = tid; idx < 16384; idx += NTHR) wrl[(idx & 15) * 1024 + (idx >> 4)] = wr[idx];
  }
  __syncthreads();
  const float* MOD = (const float*)(p.ws + O_MOD);
  const int nrows = NT + ((layer == 0) ? NCT : 0);
  for (int row = blockIdx.x * NWAVE + w; row < nrows; row += gridDim.x * NWAVE) {
    const bool is_ctx = row >= NT;
    const int rr = is_ctx ? row - NT : row;
    float* X1 = (float*)(p.ws + (is_ctx ? O_X1C : O_X1)) + (long)rr * 1024;
    bfraw* Hd = (bfraw*)(p.ws + (is_ctx ? O_HC : O_H)) + (long)rr * 1024;
    const int T = is_ctx ? CTX : SEQ;
    const int b = rr / T, t = rr - b * T;
    const float* mr = MOD + (layer * 9 + (is_ctx ? 8 : b)) * 6144;
    float v[16];
    load_row16(X1, lane, v);
    postnorm16(v, p.ln1_g + layer * 1024, p.ln1_b + layer * 1024, lane);
    store_row16(X1, lane, v);
    modulate16(v, mr + 3072, mr + 4096, lane);
    store_row16_bf(Hd, lane, v);
    float mylg = -1e30f;
#pragma unroll 2
    for (int e = 0; e < 16; ++e) {
      float s = 0.f;
#pragma unroll
      for (int i = 0; i < 4; ++i) {
        const float4 wv = *(const float4*)(wrl + e * 1024 + i * 256 + lane * 4);
        s += v[i * 4] * wv.x + v[i * 4 + 1] * wv.y + v[i * 4 + 2] * wv.z + v[i * 4 + 3] * wv.w;
      }
      s = wsum(s);
      if (lane == e) mylg = s;
    }
    float mx = mylg;
    mx = fmaxf(mx, __shfl_xor(mx, 1)); mx = fmaxf(mx, __shfl_xor(mx, 2));
    mx = fmaxf(mx, __shfl_xor(mx, 4)); mx = fmaxf(mx, __shfl_xor(mx, 8));
    const float ex = __expf(mylg - mx);
    float den = ex;
    den += __shfl_xor(den, 1); den += __shfl_xor(den, 2); den += __shfl_xor(den, 4); den += __shfl_xor(den, 8);
    const float mine = ex / den;
    if (lane < 16) {
      float* AFF = (float*)(p.ws + (is_ctx ? O_AFFC : O_AFF));
      AFF[((long)b * 16 + lane) * T + t] = mine;
    }
  }
}

DI void topk_item(const Params& p, bool is_ctx, int b, int e, char* lds, int tid) {
  const int T = is_ctx ? CTX : SEQ, cap = is_ctx ? CAPC : CAP;
  unsigned* hist = (unsigned*)lds;
  unsigned* sel = hist + 256;
  unsigned* wtot = hist + 264;
  const unsigned* AFF = (const unsigned*)(p.ws + (is_ctx ? O_AFFC : O_AFF)) + ((long)b * 16 + e) * T;
  const int lane = tid & 63, w = tid >> 6;
  const bool have = tid * 8 < T;
  unsigned v[8];
  if (have) {
    const uint4 t0 = *(const uint4*)(AFF + tid * 8), t1 = *(const uint4*)(AFF + tid * 8 + 4);
    v[0] = t0.x; v[1] = t0.y; v[2] = t0.z; v[3] = t0.w; v[4] = t1.x; v[5] = t1.y; v[6] = t1.z; v[7] = t1.w;
  } else {
#pragma unroll
    for (int i = 0; i < 8; ++i) v[i] = 0u;
  }
  unsigned prefix = 0u, kk = (unsigned)cap;
#pragma unroll 1
  for (int pass = 3; pass >= 0; --pass) {
    __syncthreads();
    if (tid < 256) hist[tid] = 0u;
    __syncthreads();
    if (have) {
#pragma unroll
      for (int i = 0; i < 8; ++i) {
        const bool match = (pass == 3) ? true : ((v[i] >> (8 * (pass + 1))) == prefix);
        if (match) atomicAdd(&hist[(v[i] >> (8 * pass)) & 255u], 1u);
      }
    }
    __syncthreads();
    if (tid < 256) {
      unsigned sfx = 0u;
      for (int d = tid + 1; d < 256; ++d) sfx += hist[d];
      const unsigned me = hist[tid];
      if (sfx < kk && sfx + me >= kk) { sel[0] = (unsigned)tid; sel[1] = kk - sfx; }
    }
    __syncthreads();
    prefix = (prefix << 8) | sel[0];
    kk = sel[1];
  }
  const unsigned thr = prefix;
  unsigned cg = 0u, ce = 0u;
  if (have) {
#pragma unroll
    for (int i = 0; i < 8; ++i) { cg += (v[i] > thr); ce += (v[i] == thr); }
  }
  unsigned pk = cg | (ce << 16);
  unsigned inc = pk;
#pragma unroll
  for (int o = 1; o < 64; o <<= 1) {
    const unsigned t = __shfl_up(inc, o);
    if (lane >= o) inc += t;
  }
  __syncthreads();
  if (lane == 63) wtot[w] = inc;
  __syncthreads();
  unsigned base = 0u, total = 0u;
#pragma unroll
  for (int ww = 0; ww < NWAVE; ++ww) { const unsigned t = wtot[ww]; if (ww < w) base += t; total += t; }
  const unsigned excl = base + inc - pk;
  unsigned pos_g = excl & 0xffffu, pos_e = excl >> 16;
  const unsigned n_gt = total & 0xffffu;
  if (have) {
    short* SLOT = (short*)(p.ws + (is_ctx ? O_SLOTC : O_SLOT));
    int* IDX = (int*)(p.ws + (is_ctx ? O_IDXC : O_IDX));
    float* GATE = (float*)(p.ws + (is_ctx ? O_GATEC : O_GATE));
#pragma unroll
    for (int i = 0; i < 8; ++i) {
      const int idx = tid * 8 + i;
      int slot = -1;
      if (v[i] > thr) { slot = (int)pos_g; ++pos_g; }
      else if (v[i] == thr) { if (pos_e < kk) slot = (int)(n_gt + pos_e); ++pos_e; }
      if (slot >= 0) {
        const int prow = (e * 8 + b) * cap + slot;
        IDX[prow] = idx;
        GATE[prow] = __uint_as_float(v[i]);
      }
      SLOT[((long)b * T + idx) * 16 + e] = (short)slot;
    }
  }
}

DI void phase_topk(const Params& p, int layer, char* lds, int tid) {
  const int n_lat = 128, n_ctx = (layer == 0) ? 128 : 0, n_conv = (layer == 1) ? N_EXPCONV : 0;
  for (int item = blockIdx.x; item < n_lat + n_ctx + n_conv; item += gridDim.x) {
    int it = item;
    if (it < n_lat) { topk_item(p, false, it >> 4, it & 15, lds, tid); continue; }
    it -= n_lat;
    if (it < n_ctx) { topk_item(p, true, it >> 4, it & 15, lds, tid); continue; }
    it -= n_ctx;
    expconv_item(p, 1, it, lds, tid);
  }
}

DI void phase_moe1(const Params& p, int layer, unsigned* ctr, int* s_item, char* lds, int tid) {
  const bfraw* WGU = (const bfraw*)(p.ws + O_WGU);
  const int n_lat = 16 * 16 * 16, n_ctx = (layer == 0) ? 16 * 16 : 0;
  for (;;) {
    const int item = next_item(ctr, s_item, tid);
    if (item >= n_lat + n_ctx) break;
    const bool is_ctx = item >= n_lat;
    const int r = is_ctx ? item - n_lat : item;
    const int RT = is_ctx ? 1 : 16;
    const int cap = is_ctx ? CAPC : CAP, T = is_ctx ? CTX : SEQ;
    const int e = r / (16 * RT), rem = r % (16 * RT), ct = rem / RT, rt = rem % RT;
    const int* IDX = (const int*)(p.ws + (is_ctx ? O_IDXC : O_IDX));
    const bfraw* Hs = (const bfraw*)(p.ws + (is_ctx ? O_HC : O_H));
    bfraw* ACT = (bfraw*)(p.ws + (is_ctx ? O_ACTC : O_ACT));
    const int r0 = tid >> 2, c8 = (tid & 3) * 8;
    const int l0 = rt * 256 + r0, l1 = l0 + 128;
    const int tok0 = IDX[e * 8 * cap + l0], tok1 = IDX[e * 8 * cap + l1];
    const bfraw* a0 = Hs + ((long)(l0 / cap) * T + tok0) * 1024 + c8;
    const bfraw* a1 = Hs + ((long)(l1 / cap) * T + tok1) * 1024 + c8;
    const bfraw* b0 = WGU + ((long)e * 4096 + ct * 256 + r0) * 1024 + c8;
    const bfraw* b1 = b0 + 128 * 1024;
    const long prow0 = (long)e * 8 * cap + rt * 256;
    gemm_tile<true>(a0, a1, b0, b1, 1024, lds, tid, [&](f32x4 (&acc)[8][4], int wr, int wc, int fr, int fq) {
#pragma unroll
      for (int m = 0; m < 8; ++m)
#pragma unroll
        for (int q = 0; q < 2; ++q) {
          const int f = ct * 128 + wc * 32 + q * 16 + fq * 4;
          float sv[4];
#pragma unroll
          for (int j = 0; j < 4; ++j) {
            const float g = acc[m][2 * q][j], u = acc[m][2 * q + 1][j];
            sv[j] = g / (1.f + __expf(-g)) * u;
          }
          uint2 st;
          st.x = pack2(sv[0], sv[1]);
          st.y = pack2(sv[2], sv[3]);
          *(uint2*)(ACT + (prow0 + wr * 128 + m * 16 + fr) * FF + f) = st;
        }
    });
  }
}

DI void phase_moe2(const Params& p, int layer, unsigned* ctr, int* s_item, char* lds, int tid) {
  const bfraw* WD = (const bfraw*)(p.ws + O_WD);
  const int n_lat = 16 * 4 * 16, n_ctx = (layer == 0) ? 16 * 4 : 0;
  for (;;) {
    const int item = next_item(ctr, s_item, tid);
    if (item >= n_lat + n_ctx) break;
    const bool is_ctx = item >= n_lat;
    const int r = is_ctx ? item - n_lat : item;
    const int RT = is_ctx ? 1 : 16;
    const int cap = is_ctx ? CAPC : CAP;
    const int e = r / (4 * RT), rem = r % (4 * RT), ct = rem / RT, rt = rem % RT;
    const bfraw* ACT = (const bfraw*)(p.ws + (is_ctx ? O_ACTC : O_ACT));
    bfraw* Y = (bfraw*)(p.ws + (is_ctx ? O_YC : O_Y));
    const int r0 = tid >> 2, c8 = (tid & 3) * 8;
    const long prow0 = (long)e * 8 * cap + rt * 256;
    const bfraw* a0 = ACT + (prow0 + r0) * FF + c8;
    const bfraw* a1 = a0 + 128 * FF;
    const bfraw* b0 = WD + ((long)e * 1024 + ct * 256 + r0) * FF + c8;
    const bfraw* b1 = b0 + 128 * FF;
    gemm_tile<true>(a0, a1, b0, b1, FF, lds, tid, [&](f32x4 (&acc)[8][4], int wr, int wc, int fr, int fq) {
#pragma unroll
      for (int m = 0; m < 8; ++m)
#pragma unroll
        for (int n = 0; n < 4; ++n) {
          const int col = ct * 256 + wc * 64 + n * 16 + fq * 4;
          uint2 st;
          st.x = pack2(acc[m][n][0], acc[m][n][1]);
          st.y = pack2(acc[m][n][2], acc[m][n][3]);
          *(uint2*)(Y + (prow0 + wr * 128 + m * 16 + fr) * 1024 + col) = st;
        }
    });
  }
}

DI void phase_combine(const Params& p, int layer, int tid) {
  const int w = tid >> 6, lane = tid & 63;
  const float* MOD = (const float*)(p.ws + O_MOD);
  const int nrows = NT + ((layer == 0) ? NCT : 0);
  for (int row = blockIdx.x * NWAVE + w; row < nrows; row += gridDim.x * NWAVE) {
    const bool is_ctx = row >= NT;
    const int rr = is_ctx ? row - NT : row;
    const int T = is_ctx ? CTX : SEQ, cap = is_ctx ? CAPC : CAP;
    const int b = rr / T;
    const float* X1 = (const float*)(p.ws + (is_ctx ? O_X1C : O_X1)) + (long)rr * 1024;
    const short* SLOT = (const short*)(p.ws + (is_ctx ? O_SLOTC : O_SLOT)) + (long)rr * 16;
    const float* GATE = (const float*)(p.ws + (is_ctx ? O_GATEC : O_GATE));
    const bfraw* Y = (const bfraw*)(p.ws + (is_ctx ? O_YC : O_Y));
    const float* mr = MOD + (layer * 9 + (is_ctx ? 8 : b)) * 6144;
    float y[16];
#pragma unroll
    for (int i = 0; i < 16; ++i) y[i] = 0.f;
    for (int e = 0; e < 16; ++e) {
      const int s = SLOT[e];
      if (s >= 0) {
        const long prow = (long)(e * 8 + b) * cap + s;
        const float g = GATE[prow];
        const bfraw* yr = Y + prow * 1024;
#pragma unroll
        for (int i = 0; i < 4; ++i) {
          const uint2 u = *(const uint2*)(yr + i * 256 + lane * 4);
          y[i * 4 + 0] += g * bflo(u.x); y[i * 4 + 1] += g * bfhi(u.x);
          y[i * 4 + 2] += g * bflo(u.y); y[i * 4 + 3] += g * bfhi(u.y);
        }
      }
    }
    float v[16], g2[16];
    load_row16(X1, lane, v);
    load_row16(mr + 5120, lane, g2);
#pragma unroll
    for (int i = 0; i < 16; ++i) v[i] = ALPHA * v[i] + g2[i] * y[i];
    postnorm16(v, p.ln2_g + layer * 1024, p.ln2_b + layer * 1024, lane);
    if (!is_ctx) store_row16(p.out + (long)rr * 1024, lane, v);
    if (layer == 0) {
      const float* mn = MOD + (1 * 9 + (is_ctx ? 8 : b)) * 6144;
      modulate16(v, mn, mn + 1024, lane);
      store_row16_bf((bfraw*)(p.ws + (is_ctx ? O_HC : O_H)) + (long)rr * 1024, lane, v);
    }
  }
}

#ifndef DUP_MASK
#define DUP_MASK 0
#endif
DI void run_phase(const Params& p, int ph, unsigned* ctr, int* s_item, char* smem, int tid) {
  if (ph == 0) phase_prep(p, smem, tid);
  else if (ph == 1) phase_lnmod0(p, tid);
  else {
    const int layer = (ph - 2) >> 3, sub = (ph - 2) & 7;
    switch (sub) {
      case 0: phase_proj(p, layer, ctr, s_item, smem, tid); break;
      case 1: phase_mix(p, layer, ctr, s_item, smem, tid); break;
      case 2: phase_outproj(p, layer, ctr, s_item, smem, tid); break;
      case 3: phase_row(p, layer, smem, tid); break;
      case 4: phase_topk(p, layer, smem, tid); break;
      case 5: phase_moe1(p, layer, ctr, s_item, smem, tid); break;
      case 6: phase_moe2(p, layer, ctr, s_item, smem, tid); break;
      default: phase_combine(p, layer, tid); break;
    }
  }
}

__global__ void __launch_bounds__(NTHR) fwd_kernel(Params p) {
  extern __shared__ __attribute__((aligned(16))) char smem[];
  __shared__ int s_item;
  const int wave_id = __builtin_amdgcn_readfirstlane((int)(threadIdx.x >> 6));
  for (int ph = p.ph_lo; ph < p.ph_hi; ++ph) {
    if (ph > p.ph_lo) cg::this_grid().sync();
    int tid;
    asm volatile("v_mbcnt_lo_u32_b32 %0, -1, 0\n\tv_mbcnt_hi_u32_b32 %0, -1, %0" : "=v"(tid));
    tid += wave_id * 64;
    unsigned* ctr = (unsigned*)(p.ws + O_CTR) + ph;
    run_phase(p, ph, ctr, &s_item, smem, tid);
#if DUP_MASK
    {
      const int bit = (ph == 0) ? 8 : (ph == 1) ? 9 : ((ph - 2) & 7);
      if ((DUP_MASK >> bit) & 1) {
        cg::this_grid().sync();
        asm volatile("" : "+v"(tid));
        run_phase(p, ph, ctr + 32, &s_item, smem, tid);
      }
    }
#endif
  }
}

extern "C" void kernel_launch(void* const* d_in, const int* in_sizes, int n_in, void* d_out, int out_size, void* d_ws,
                              size_t ws_size, hipStream_t stream) {
  (void)in_sizes; (void)n_in; (void)out_size;
  if (ws_size < O_END) { fprintf(stderr, "kernel_launch: workspace too small (%zu < %zu)\n", ws_size, (size_t)O_END); return; }
  Params p{};
  const float** pp = (const float**)&p;
  for (int i = 0; i < 21; ++i) pp[i] = (const float*)d_in[i];
  p.out = (float*)d_out;
  p.ws = (char*)d_ws;
  static int grid_blocks = 0;
  if (!grid_blocks) {
    int dev = 0, cus = 0, per_cu = 0;
    hipGetDevice(&dev);
    hipDeviceGetAttribute(&cus, hipDeviceAttributeMultiprocessorCount, dev);
    hipFuncSetAttribute((const void*)fwd_kernel, hipFuncAttributeMaxDynamicSharedMemorySize, LDS_BYTES);
    hipOccupancyMaxActiveBlocksPerMultiprocessor(&per_cu, fwd_kernel, NTHR, LDS_BYTES);
    if (per_cu < 1) per_cu = 1;
    if (per_cu > 1) per_cu = 1;
    grid_blocks = cus * per_cu;
  }
#if ONE_LAUNCH
  p.ph_lo = 0; p.ph_hi = NPHASE;
  void* args[] = {&p};
  hipError_t e = hipLaunchCooperativeKernel((void*)fwd_kernel, dim3(grid_blocks), dim3(NTHR), args, LDS_BYTES, stream);
  if (e != hipSuccess) fprintf(stderr, "cooperative launch failed: %s (grid %d)\n", hipGetErrorString(e), grid_blocks);
#else
  for (int ph = 0; ph < NPHASE; ++ph) {
    p.ph_lo = ph; p.ph_hi = ph + 1;
    hipLaunchKernelGGL(fwd_kernel, dim3(grid_blocks), dim3(NTHR), LDS_BYTES, stream, p);
  }
#endif
}
```

```cpp
#include <hip/hip_runtime.h>
#include <hip/hip_cooperative_groups.h>
#include <cstdio>
namespace cg = cooperative_groups;

#ifndef ONE_LAUNCH
#define ONE_LAUNCH 1
#endif

#define DI __device__ __forceinline__
typedef unsigned short bfraw;
using bf16x8 = __attribute__((ext_vector_type(8))) short;
using f32x4 = __attribute__((ext_vector_type(4))) float;

constexpr int NB = 8, SEQ = 4096, DM = 1024, CTX = 256;
constexpr int NT = NB * SEQ, NCT = NB * CTX;
constexpr int NPROJ = 1792;
constexpr int KS = CTX + SEQ;
constexpr int NE = 16, FF = 2048;
constexpr int CAP = 512, CAPC = 32;
constexpr float ALPHA = 1.41421356237f;
constexpr float LOG2E = 1.44269504089f;
constexpr int NPHASE = 18;
constexpr int NTHR = 512;
constexpr int NWAVE = NTHR / 64;
constexpr int LDS_BYTES = 131072;

constexpr size_t al(size_t x) { return (x + 255) & ~size_t(255); }
constexpr size_t O_MOD = 0;
constexpr size_t O_ROPE = al(O_MOD + 2 * 9 * 6144 * 4);
constexpr size_t O_CTR = al(O_ROPE + 2 * 1024 * 4);
constexpr size_t O_BAR = al(O_CTR + 1024 * 4);
constexpr size_t O_WINT = al(O_BAR + 3456 * 4);
constexpr size_t O_WOUTT = al(O_WINT + 2ull * NPROJ * 1024 * 2);
constexpr size_t O_DFT = al(O_WOUTT + 2ull * 1024 * 1024 * 2);
constexpr size_t O_PSCR = O_DFT + 2ull * 2048 * 4096 * 2;
constexpr size_t O_DFTC = al(O_DFT + 4096ull * 8192 * 2);
constexpr size_t O_WGU = al(O_DFTC + 256ull * 512 * 2);
constexpr size_t O_WD = al(O_WGU + 16ull * 4096 * 1024 * 2);
constexpr size_t O_X1 = al(O_WD + 16ull * 1024 * 2048 * 2);
constexpr size_t O_X1C = al(O_X1 + (size_t)NT * 1024 * 4);
constexpr size_t O_H = al(O_X1C + (size_t)NCT * 1024 * 4);
constexpr size_t O_HC = al(O_H + (size_t)NT * 1024 * 2);
constexpr size_t O_AFF = al(O_HC + (size_t)NCT * 1024 * 2);
constexpr size_t O_AFFC = al(O_AFF + 8ull * 16 * 4096 * 4);
constexpr size_t O_IDX = al(O_AFFC + 8ull * 16 * 256 * 4);
constexpr size_t O_GATE = al(O_IDX + 16ull * 8 * 512 * 4);
constexpr size_t O_SLOT = al(O_GATE + 16ull * 8 * 512 * 4);
constexpr size_t O_IDXC = al(O_SLOT + 8ull * 4096 * 16 * 2);
constexpr size_t O_GATEC = al(O_IDXC + 16ull * 8 * 32 * 4);
constexpr size_t O_SLOTC = al(O_GATEC + 16ull * 8 * 32 * 4);
constexpr size_t O_Y = al(O_SLOTC + 8ull * 256 * 16 * 2);
constexpr size_t O_YC = al(O_Y + 65536ull * 1024 * 2);
constexpr size_t O_ACTC = al(O_YC + 4096ull * 1024 * 2);
constexpr size_t O_R = al(O_ACTC + 4096ull * 2048 * 2);
constexpr size_t O_ACT = O_R;
constexpr size_t O_QA = O_R;
constexpr size_t O_QC = al(O_QA + (size_t)NT * 512 * 2);
constexpr size_t O_KA = al(O_QC + (size_t)NT * 256 * 2);
constexpr size_t O_VAT = al(O_KA + 8ull * 2 * KS * 64 * 2);
constexpr size_t O_KC = al(O_VAT + 8ull * 2 * KS * 64 * 2);
constexpr size_t O_VCT = al(O_KC + 8ull * 2 * KS * 64 * 2);
constexpr size_t O_VTF = al(O_VCT + 8ull * 2 * KS * 64 * 2);
constexpr size_t O_MIX = al(O_VTF + 8ull * 256 * 8192 * 2);
constexpr size_t O_QAC = al(O_MIX + (size_t)NT * 1024 * 2);
constexpr size_t O_QCC = al(O_QAC + (size_t)NCT * 512 * 2);
constexpr size_t O_VTFC = al(O_QCC + (size_t)NCT * 256 * 2);
constexpr size_t O_MIXC = al(O_VTFC + 8ull * 256 * 512 * 2);
constexpr size_t O_REND = al(O_MIXC + (size_t)NCT * 1024 * 2);
constexpr size_t O_END = O_R + 65536ull * 2048 * 2;
static_assert(O_REND <= O_END, "mixer buffers must fit in the ACT region");
static_assert(O_END <= 1073741824ull, "workspace too large");

struct Params {
  const float *x, *c, *ctx, *c_ctx, *w_mod, *b_mod, *w_in, *q_norm, *k_norm, *w_four, *b_four, *sink, *w_out,
      *ln1_g, *ln1_b, *w_router, *w_gate, *w_up, *w_down, *ln2_g, *ln2_b;
  float* out;
  char* ws;
  int ph_lo, ph_hi;
};

typedef __bf16 hwbf2 __attribute__((ext_vector_type(2)));
typedef float hwf2 __attribute__((ext_vector_type(2)));
DI unsigned pack2(float a, float b) {
  hwf2 f = {a, b};
  return __builtin_bit_cast(unsigned, __builtin_convertvector(f, hwbf2));
}
DI bfraw f2bf(float x) { return (bfraw)(pack2(x, 0.f) & 0xffffu); }
DI float bflo(unsigned u) { return __uint_as_float(u << 16); }
DI float bfhi(unsigned u) { return __uint_as_float(u & 0xffff0000u); }
DI float wsum(float v) {
#pragma unroll
  for (int o = 32; o; o >>= 1) v += __shfl_xor(v, o);
  return v;
}
DI void glds16(const void* g, char* l) {
  __builtin_amdgcn_global_load_lds((const unsigned*)g, (unsigned*)l, 16, 0, 0);
}
DI void wait_vm0() { asm volatile("s_waitcnt vmcnt(0)" ::: "memory"); }
DI f32x4 mfma16(bf16x8 a, bf16x8 b, f32x4 c) { return __builtin_amdgcn_mfma_f32_16x16x32_bf16(a, b, c, 0, 0, 0); }

DI int swz4(int q) { return (-q) & 3; }

struct XQ { int kk; int list; int idx; int wv; };
DI bool next_item_s(int n_per, int& tid, XQ& q) {
  if (q.wv < 0) { q.wv = __builtin_amdgcn_readfirstlane(tid >> 6); q.idx = (int)(blockIdx.x >> 3); q.list = (int)(blockIdx.x & 7); }
  else q.idx += (int)((gridDim.x + 7 - (blockIdx.x & 7)) >> 3);
  asm volatile("v_mbcnt_lo_u32_b32 %0, -1, 0\n\tv_mbcnt_hi_u32_b32 %0, -1, %0" : "=v"(tid));
  tid += q.wv * 64;
  return q.idx < n_per;
}
DI bool next_item_x(unsigned* ctr, int n_per, int* s_item, int& tid, XQ& q) {
  if (q.wv < 0) q.wv = __builtin_amdgcn_readfirstlane(tid >> 6);
  asm volatile("v_mbcnt_lo_u32_b32 %0, -1, 0\n\tv_mbcnt_hi_u32_b32 %0, -1, %0" : "=v"(tid));
  tid += q.wv * 64;
  for (;;) {
    if (q.kk >= 8) return false;
    q.list = ((int)(__builtin_amdgcn_s_getreg(20 | (3 << 11)) & 7) + q.kk) & 7;
    __syncthreads();
    if (tid == 0) *s_item = (int)atomicAdd(ctr + q.list, 1u);
    __syncthreads();
    q.idx = *s_item;
    if (q.idx < n_per) return true;
    ++q.kk;
  }
}

#define XB_TMO      128
#define XB_XCNT(j)  (256  + 64 * (j))
#define XB_XSUB(j)  (1280 + 64 * (j))
#define XB_XGEN(j)  (2304 + 64 * (j))
#define XB_TOP      3328
#define XB_TOPGEN   3392
#define XCD_BAR_WORDS 3456
#define XB_SPIN_CAP (1u << 18)
DI unsigned xb_ld(unsigned* p) { return __hip_atomic_load(p, __ATOMIC_RELAXED, __HIP_MEMORY_SCOPE_AGENT); }
DI unsigned xb_add(unsigned* p, unsigned v) { return __hip_atomic_fetch_add(p, v, __ATOMIC_RELAXED, __HIP_MEMORY_SCOPE_AGENT); }
DI unsigned xb_xcc_id() { return (unsigned)__builtin_amdgcn_s_getreg((3 << 11) | 20) & 0xFu; }
#define XB_SPIN(cond, bar) do { unsigned _sp = 0; while (cond) { __builtin_amdgcn_s_sleep(1); \
    if ((++_sp & 255u) == 0u) { if (xb_ld(&(bar)[XB_TMO])) break; if (_sp > XB_SPIN_CAP) { atomicAdd(&(bar)[XB_TMO], 1u); break; } } } } while (0)

DI void xcd_barrier_post(unsigned* bar, int tid) {
  if (tid == 0) (void)xb_add(&bar[XB_XCNT(xb_xcc_id())], 1u);
}
DI void xcd_barrier_complete(unsigned* bar, unsigned x, unsigned& nloc, unsigned& nx) {
  const unsigned G = gridDim.x;
  unsigned sum, cnt, mine, sp = 0u;
  for (;;) {
    sum = 0u; cnt = 0u; mine = 0u;
#pragma unroll
    for (unsigned j = 0; j < 16; ++j) { const unsigned c = xb_ld(&bar[XB_XCNT(j)]); sum += c; cnt += (c > 0u) ? 1u : 0u; mine = (j == x) ? c : mine; }
    if (sum == G) break;
    __builtin_amdgcn_s_sleep(1);
    if ((++sp & 255u) == 0u) { if (xb_ld(&bar[XB_TMO])) break; if (sp > XB_SPIN_CAP) { atomicAdd(&bar[XB_TMO], 1u); break; } }
  }
  nloc = mine > 0u ? mine : 1u; nx = cnt > 0u ? cnt : 1u;
}
DI void xcd_barrier(unsigned* bar, volatile unsigned* st, int tid) {
  asm volatile("s_waitcnt vmcnt(0)" ::: "memory");
  __syncthreads();
  if (tid == 0) {
    const unsigned x = xb_xcc_id();
    __builtin_amdgcn_s_waitcnt(0);
    unsigned nloc = st[0], nx = st[1];
    if (nloc == 0u) { xcd_barrier_complete(bar, x, nloc, nx); st[0] = nloc; st[1] = nx; }
    const unsigned old = xb_add(&bar[XB_XSUB(x)], 1u);
    const unsigned gen = old / nloc;
    if (old + 1u == (gen + 1u) * nloc) {
      __builtin_amdgcn_fence(__ATOMIC_RELEASE, "agent");
      asm volatile("s_waitcnt vmcnt(0)" ::: "memory");
      const unsigned og = xb_add(&bar[XB_TOP], 1u);
      const unsigned tg = og / nx;
      if (og + 1u == (tg + 1u) * nx) xb_add(&bar[XB_TOPGEN], 1u);
      else XB_SPIN(xb_ld(&bar[XB_TOPGEN]) == tg, bar);
      __builtin_amdgcn_fence(__ATOMIC_ACQUIRE, "agent");
      xb_add(&bar[XB_XGEN(x)], 1u);
      asm volatile("s_waitcnt vmcnt(0)" ::: "memory");
    } else {
      XB_SPIN(xb_ld(&bar[XB_XGEN(x)]) == gen, bar);
      __builtin_amdgcn_fence(__ATOMIC_ACQUIRE, "agent");
      asm volatile("s_waitcnt vmcnt(0)" ::: "memory");
    }
  }
  __syncthreads();
}

DI void rows4(const bfraw* base, long ld, int row0, int tid, const bfraw* (&out)[4]) {
  const int r0 = (tid & 255) >> 2, c8 = ((tid & 3) ^ swz4(tid >> 4)) * 8;
#pragma unroll
  for (int i = 0; i < 4; ++i) out[i] = base + (long)(row0 + i * 64 + r0) * ld + c8;
}
DI void gemm_stage(const bfraw* const (&ap)[4], const bfraw* const (&bp)[4], int k0, char* st, int tid) {
  const int t = tid & 255;
#pragma unroll
  for (int i = 0; i < 4; ++i) {
    glds16(ap[i] + k0, st + (i * 256 + t) * 16);
    glds16(bp[i] + k0, st + 16384 + (i * 256 + t) * 16);
  }
}

template <bool SWAP, int VAR = 0, class Epi>
DI void gemm_tile(const bfraw* const (&ap)[4], const bfraw* const (&bp)[4], int K, char* lds, int tid, Epi epi) {
  asm volatile("" : "+v"(tid));
  const int w = tid >> 6, lane = tid & 63, wr = w >> 2, wc = w & 3, fr = lane & 15, fq = lane >> 4;
  const bool loader = w < 4;
  f32x4 acc[8][4];
#pragma unroll
  for (int m = 0; m < 8; ++m)
#pragma unroll
    for (int n = 0; n < 4; ++n) acc[m][n] = f32x4{0.f, 0.f, 0.f, 0.f};
  const int ns = K >> 5;
  __syncthreads();
  if (loader) {
    gemm_stage(ap, bp, 0, lds, tid);
    gemm_stage(ap, bp, 32, lds + 32768, tid);
    gemm_stage(ap, bp, 64, lds + 65536, tid);
  }
  asm volatile("s_waitcnt vmcnt(16)" ::: "memory");
  __builtin_amdgcn_s_barrier();
  asm volatile("" ::: "memory");
  const int aoff = (wr * 128 + fr) * 64 + (fq ^ swz4(fr >> 2)) * 16;
  const int boff = 16384 + (wc * 64 + fr) * 64 + (fq ^ swz4(fr >> 2)) * 16;
  const int t = tid & 255;
#pragma unroll 1
  for (int j = 0; j < ns; ++j) {
    const char* st = lds + (j & 3) * 32768;
    bf16x8 bfr[4], af[8];
#pragma unroll
    for (int n = 0; n < 4; ++n) bfr[n] = *(const bf16x8*)(st + boff + n * 1024);
#pragma unroll
    for (int m = 0; m < 8; ++m) af[m] = *(const bf16x8*)(st + aoff + m * 1024);
    if (j + 1 < ns) {
      if (j + 2 < ns) asm volatile("s_waitcnt vmcnt(8)" ::: "memory");
      else asm volatile("s_waitcnt vmcnt(0)" ::: "memory");
      __builtin_amdgcn_s_barrier();
      asm volatile("" ::: "memory");
    }
    const bool issue = loader && (j + 3 < ns);
    char* nst = lds + ((j + 3) & 3) * 32768;
    const int nk0 = (j + 3) * 32;
#pragma unroll
    for (int c = 0; c < 4; ++c) {
#pragma unroll
      for (int m = 2 * c; m < 2 * c + 2; ++m)
#pragma unroll
        for (int n = 0; n < 4; ++n) acc[m][n] = SWAP ? mfma16(bfr[n], af[m], acc[m][n]) : mfma16(af[m], bfr[n], acc[m][n]);
      __builtin_amdgcn_sched_barrier(0);
      if (issue) {
        glds16(ap[c] + nk0, nst + (c * 256 + t) * 16);
        glds16(bp[c] + nk0, nst + 16384 + (c * 256 + t) * 16);
      }
      __builtin_amdgcn_sched_barrier(0);
    }
  }
  epi(acc, wr, wc, fr, fq);
}

DI void attn_stage(const bfraw* Kp, const bfraw* VTp, int ldv, int tile, char* st, int tid) {
  const int slot0 = tile * 64;
  const int h = tid >> 8, r = (tid & 255) >> 2;
  const int ck = ((tid & 3) ^ swz4(r >> 3)) * 8;
  const int cv = ((tid & 3) ^ swz4(r >> 2)) * 8;
  glds16(Kp + (long)(slot0 + r) * 64 + h * 32 + ck, st + tid * 16);
  glds16(VTp + (long)r * ldv + slot0 + h * 32 + cv, st + 8192 + tid * 16);
}

template <bool WINDOW>
DI void attn_item(const bfraw* Qp, int qstride, const bfraw* Kp, const bfraw* VTp, int ldv, int n1, int tlo, int n2,
                  int qpos0, bool has_sink, float sink_l2, bfraw* Op, int ostride, char* lds, int tid) {
  asm volatile("" : "+v"(tid));
  const int w = tid >> 6, lane = tid & 63, fr = lane & 15, fq = lane >> 4;
  const float scale_l2 = 0.125f * LOG2E;
  bf16x8 qf[2][2];
#pragma unroll
  for (int n = 0; n < 2; ++n)
#pragma unroll
    for (int sd = 0; sd < 2; ++sd)
      qf[n][sd] = *(const bf16x8*)(Qp + (long)(w * 32 + n * 16 + fr) * qstride + sd * 32 + fq * 8);
  float m_run[2];
  f32x4 o[4][2], ol[2];
#pragma unroll
  for (int n = 0; n < 2; ++n) {
    m_run[n] = has_sink ? sink_l2 : -1e30f;
    const float l0 = has_sink ? 1.f : 0.f;
    ol[n] = f32x4{l0, l0, l0, l0};
#pragma unroll
    for (int md = 0; md < 4; ++md) o[md][n] = f32x4{0.f, 0.f, 0.f, 0.f};
  }
  const bf16x8 ones = bf16x8{(short)0x3F80, (short)0x3F80, (short)0x3F80, (short)0x3F80, (short)0x3F80, (short)0x3F80, (short)0x3F80, (short)0x3F80};
  const int nt = n1 + n2;
  __syncthreads();
  attn_stage(Kp, VTp, ldv, (0 < n1) ? 0 : tlo, lds, tid);
#pragma unroll 1
  for (int it = 0; it < nt; ++it) {
    wait_vm0();
    __syncthreads();
    const bool dma_next = it + 1 < nt;
    const int nx_tile = (it + 1 < n1) ? it + 1 : tlo + (it + 1 - n1);
    if (dma_next && w < 4) attn_stage(Kp, VTp, ldv, nx_tile, lds + ((it + 1) & 1) * 16384, tid);
    const char* sK = lds + (it & 1) * 16384;
    const char* sV = sK + 8192;
    f32x4 s[4][2];
#pragma unroll
    for (int m = 0; m < 4; ++m)
#pragma unroll
      for (int n = 0; n < 2; ++n) s[m][n] = f32x4{0.f, 0.f, 0.f, 0.f};
#pragma unroll
    for (int sd = 0; sd < 2; ++sd) {
#pragma unroll
      for (int m = 0; m < 4; ++m) {
        const int krow = (m >> 1) * 32 + (fr >> 2) * 8 + (m & 1) * 4 + (fr & 3);
        bf16x8 kf = *(const bf16x8*)(sK + sd * 4096 + krow * 64 + (fq ^ swz4(fr >> 2)) * 16);
#pragma unroll
        for (int n = 0; n < 2; ++n) s[m][n] = mfma16(kf, qf[n][sd], s[m][n]);
      }
    }
    if (dma_next && w >= 4) attn_stage(Kp, VTp, ldv, nx_tile, lds + ((it + 1) & 1) * 16384, tid);
    const int tile = (it < n1) ? it : tlo + (it - n1);
    const bool domask = WINDOW && (it >= n1);
    float mxs2[2];
#pragma unroll
    for (int n = 0; n < 2; ++n) {
      if (domask) {
        const int qpos = qpos0 + w * 32 + n * 16 + fr;
#pragma unroll
        for (int m = 0; m < 4; ++m)
#pragma unroll
          for (int j = 0; j < 4; ++j) {
            const int kpos = tile * 64 - CTX + (m >> 1) * 32 + fq * 8 + (m & 1) * 4 + j;
            const int d = qpos - kpos;
            if (d > 128 || d < -128) s[m][n][j] = -1e30f;
          }
      }
      float mx = -1e30f;
#pragma unroll
      for (int m = 0; m < 4; ++m) {
        mx = fmaxf(mx, fmaxf(s[m][n][0], s[m][n][1]));
        mx = fmaxf(mx, fmaxf(s[m][n][2], s[m][n][3]));
      }
      mxs2[n] = mx;
    }
    {
      const float t0 = __shfl_xor(mxs2[0], 16), t1 = __shfl_xor(mxs2[1], 16);
      mxs2[0] = fmaxf(mxs2[0], t0); mxs2[1] = fmaxf(mxs2[1], t1);
      const float u0 = __shfl_xor(mxs2[0], 32), u1 = __shfl_xor(mxs2[1], 32);
      mxs2[0] = fmaxf(mxs2[0], u0) * scale_l2; mxs2[1] = fmaxf(mxs2[1], u1) * scale_l2;
    }
    if (__any((mxs2[0] > m_run[0] + 8.f) || (mxs2[1] > m_run[1] + 8.f))) {
#pragma unroll
      for (int n = 0; n < 2; ++n) {
        const bool need = mxs2[n] > m_run[n] + 8.f;
        const float m_new = need ? mxs2[n] : m_run[n];
        const float alpha = __builtin_amdgcn_exp2f(m_run[n] - m_new);
        m_run[n] = m_new;
        ol[n][0] *= alpha; ol[n][1] *= alpha; ol[n][2] *= alpha; ol[n][3] *= alpha;
#pragma unroll
        for (int md = 0; md < 4; ++md) {
          o[md][n][0] *= alpha; o[md][n][1] *= alpha; o[md][n][2] *= alpha; o[md][n][3] *= alpha;
        }
      }
    }
#pragma unroll
    for (int n = 0; n < 2; ++n) {
      const float nm = -m_run[n];
#pragma unroll
      for (int m = 0; m < 4; ++m)
#pragma unroll
        for (int j = 0; j < 4; ++j) s[m][n][j] = __builtin_amdgcn_exp2f(__builtin_fmaf(s[m][n][j], scale_l2, nm));
    }
#pragma unroll
    for (int ks = 0; ks < 2; ++ks) {
      bf16x8 pf[2];
#pragma unroll
      for (int n = 0; n < 2; ++n) {
        const unsigned u0 = pack2(s[2 * ks][n][0], s[2 * ks][n][1]);
        const unsigned u1 = pack2(s[2 * ks][n][2], s[2 * ks][n][3]);
        const unsigned u2 = pack2(s[2 * ks + 1][n][0], s[2 * ks + 1][n][1]);
        const unsigned u3 = pack2(s[2 * ks + 1][n][2], s[2 * ks + 1][n][3]);
        const uint4 uu = make_uint4(u0, u1, u2, u3);
        pf[n] = __builtin_bit_cast(bf16x8, uu);
      }
#pragma unroll
      for (int md = 0; md < 4; ++md) {
        bf16x8 vf = *(const bf16x8*)(sV + ks * 4096 + (md * 16 + fr) * 64 + (fq ^ swz4(fr >> 2)) * 16);
#pragma unroll
        for (int n = 0; n < 2; ++n) o[md][n] = mfma16(vf, pf[n], o[md][n]);
      }
#pragma unroll
      for (int n = 0; n < 2; ++n) ol[n] = mfma16(ones, pf[n], ol[n]);
    }
  }
#pragma unroll
  for (int n = 0; n < 2; ++n) {
    const float inv = 1.f / ol[n][0];
    bfraw* orow = Op + (long)(w * 32 + n * 16 + fr) * ostride;
#pragma unroll
    for (int md = 0; md < 4; ++md) {
      uint2 st;
      st.x = pack2(o[md][n][0] * inv, o[md][n][1] * inv);
      st.y = pack2(o[md][n][2] * inv, o[md][n][3] * inv);
      *(uint2*)(orow + md * 16 + fq * 4) = st;
    }
  }
}

DI void xpose_tile(const float* src, long ld_src, bfraw* dst, long ld_dst, int mode, char* lds, int tid) {
  float(*t)[65] = (float(*)[65])lds;
  __syncthreads();
  {
    const int c = tid & 63, r0 = tid >> 6;
#pragma unroll 4
    for (int rr = r0; rr < 64; rr += NWAVE) t[rr][c] = src[(long)rr * ld_src + c];
  }
  __syncthreads();
  {
    const int k8 = (tid & 7) * 8, nn = tid >> 3;
    uint4 v;
    v.x = pack2(t[k8 + 0][nn], t[k8 + 1][nn]);
    v.y = pack2(t[k8 + 2][nn], t[k8 + 3][nn]);
    v.z = pack2(t[k8 + 4][nn], t[k8 + 5][nn]);
    v.w = pack2(t[k8 + 6][nn], t[k8 + 7][nn]);
    const int row = (mode == 0) ? nn : ((nn >> 4) * 32 + (mode == 2 ? 16 : 0) + (nn & 15));
    *(uint4*)(dst + (long)row * ld_dst + k8) = v;
  }
}

DI void xpose256x2(const float* s0, long ls0, bfraw* d0, long ld0, int m0,
                   const float* s1, long ls1, bfraw* d1, long ld1, int m1, bool two, char* lds, int tid) {
  const int w = tid >> 6, lane = tid & 63;
  float4 vA[8], vB[8];
#pragma unroll
  for (int i = 0; i < 8; ++i) {
    const int k = 2 * (w + 8 * (i >> 1)) + (i & 1);
    vA[i] = *(const float4*)(s0 + (long)k * ls0 + lane * 4);
  }
#pragma unroll
  for (int i = 0; i < 8; ++i) {
    const int k = 2 * (w + 8 * (i >> 1)) + (i & 1);
    vB[i] = *(const float4*)(s1 + (long)k * ls1 + lane * 4);
  }
#pragma unroll
  for (int half = 0; half < 2; ++half) {
    if (half == 1 && !two) break;
    __syncthreads();
#pragma unroll
    for (int i2 = 0; i2 < 4; ++i2) {
      const int k = 2 * (w + 8 * i2);
      char* base = lds + (lane * 4) * 136 + k * 2;
      const float4 e0 = half ? vB[2 * i2] : vA[2 * i2], e1 = half ? vB[2 * i2 + 1] : vA[2 * i2 + 1];
      *(unsigned*)(base + 0 * 136) = pack2(e0.x, e1.x);
      *(unsigned*)(base + 1 * 136) = pack2(e0.y, e1.y);
      *(unsigned*)(base + 2 * 136) = pack2(e0.z, e1.z);
      *(unsigned*)(base + 3 * 136) = pack2(e0.w, e1.w);
    }
    __syncthreads();
    bfraw* dst = half ? d1 : d0;
    const long ld_dst = half ? ld1 : ld0;
    const int mode = half ? m1 : m0;
#pragma unroll
    for (int q = 0; q < 4; ++q) {
      const int c = tid + NTHR * q;
      const int n = c >> 3, k8 = (c & 7) * 8;
      const uint2 lo = *(const uint2*)(lds + n * 136 + k8 * 2);
      const uint2 hi = *(const uint2*)(lds + n * 136 + k8 * 2 + 8);
      const int row = (mode == 0) ? n : ((n >> 4) * 32 + (mode == 2 ? 16 : 0) + (n & 15));
      *(uint4*)(dst + (long)row * ld_dst + k8) = make_uint4(lo.x, lo.y, hi.x, hi.y);
    }
  }
}

constexpr int N_EXPCONV = 4096 + 2048;
DI void expconv_decode(const Params& p, int layer, int item, const float*& src, long& ld_src, bfraw*& dst, long& ld_dst, int& mode) {
  bfraw* WGU = (bfraw*)(p.ws + O_WGU);
  bfraw* WD = (bfraw*)(p.ws + O_WD);
  if (item < 4096) {
    const int type = item & 1;
    int r = item >> 1;
    const int nt = r & 7; r >>= 3;
    const int kt = r & 15; const int e = r >> 4;
    src = (type ? p.w_up : p.w_gate) + ((long)(layer * NE + e) * DM + kt * 64) * FF + nt * 256;
    ld_src = FF;
    dst = WGU + ((long)e * 4096 + nt * 512) * DM + kt * 64;
    ld_dst = DM; mode = 1 + type;
  } else {
    int r = item - 4096;
    const int nt = r & 3; r >>= 2;
    const int kt = r & 31; const int e = r >> 5;
    src = p.w_down + ((long)(layer * NE + e) * FF + kt * 64) * DM + nt * 256;
    ld_src = DM;
    dst = WD + ((long)e * DM + nt * 256) * FF + kt * 64;
    ld_dst = FF; mode = 0;
  }
}
DI void expconv_pair(const Params& p, int layer, int i0, int i1, char* lds, int tid) {
  const float *s0, *s1; long ls0, ls1, ld0, ld1; bfraw *d0, *d1; int m0, m1;
  expconv_decode(p, layer, i0, s0, ls0, d0, ld0, m0);
  expconv_decode(p, layer, (i1 >= 0) ? i1 : i0, s1, ls1, d1, ld1, m1);
  xpose256x2(s0, ls0, d0, ld0, m0, s1, ls1, d1, ld1, m1, i1 >= 0, lds, tid);
}

DI void prep_mod_item(const Params& p, int item, char* lds, int tid) {
  const int layer = item / 96, chunk = item % 96;
  float* sc = (float*)lds;
  float* red = (float*)(lds + 36864);
  __syncthreads();
  for (int idx = tid; idx < 9 * 1024; idx += NTHR) {
    const int r = idx >> 10, k = idx & 1023;
    const float v = (r < 8) ? p.c[r * 1024 + k] : p.c_ctx[k];
    sc[idx] = v / (1.f + __expf(-v));
  }
  __syncthreads();
  const int w = tid >> 6, lane = tid & 63;
  const int col = chunk * 64 + lane;
  float acc[9];
#pragma unroll
  for (int r = 0; r < 9; ++r) acc[r] = 0.f;
  const float* wp = p.w_mod + ((long)layer * 1024 + w * 128) * 6144 + col;
#pragma unroll 4
  for (int k = 0; k < 128; ++k) {
    const float wv = wp[(long)k * 6144];
#pragma unroll
    for (int r = 0; r < 9; ++r) acc[r] += sc[r * 1024 + w * 128 + k] * wv;
  }
#pragma unroll
  for (int r = 0; r < 9; ++r) red[(w * 9 + r) * 64 + lane] = acc[r];
  __syncthreads();
  float* MOD = (float*)(p.ws + O_MOD);
  for (int idx = tid; idx < 9 * 64; idx += NTHR) {
    const int r = idx >> 6, l = idx & 63;
    float s = p.b_mod[layer * 6144 + chunk * 64 + l];
#pragma unroll
    for (int ww = 0; ww < NWAVE; ++ww) s += red[(ww * 9 + r) * 64 + l];
    MOD[(layer * 9 + r) * 6144 + chunk * 64 + l] = s;
  }
}

DI void prep_four_item(const Params& p, int item, char* lds, int tid) {
  const int layer = item >> 6, g = (item >> 4) & 3, kt = item & 15;
  float* G = (float*)lds;
  float(*Wt)[65] = (float(*)[65])(lds + 32768);
  float* ctab = (float*)(lds + 32768 + 64 * 65 * 4);
  __syncthreads();
  const float* wg = p.w_four + (long)(layer * 4 + g) * 4096;
  for (int idx = tid; idx < 4096; idx += NTHR) Wt[idx >> 6][idx & 63] = wg[idx];
  if (tid < 64) {
    float sn, cs;
    sincospif((float)tid / 32.f, &sn, &cs);
    ctab[tid] = cs;
    ctab[64 + tid] = sn;
  }
  __syncthreads();
  for (int o = tid; o < 4096; o += NTHR) {
    const int c = o >> 6, d = o & 63;
    float s1 = 0.f, s2 = 0.f;
#pragma unroll 4
    for (int c2 = 0; c2 < 64; ++c2) {
      const int a = (c * c2) & 63;
      const float wv = Wt[c2][d];
      s1 += ctab[a] * wv;
      s2 += ctab[64 + a] * wv;
    }
    G[o] = s1;
    G[4096 + o] = s2;
  }
  __syncthreads();
  const float* wi = p.w_in + ((long)layer * 1024 + kt * 64) * 1536 + 768 + g * 64;
  for (int idx = tid; idx < 4096; idx += NTHR) Wt[idx >> 6][idx & 63] = wi[(long)(idx >> 6) * 1536 + (idx & 63)];
  __syncthreads();
  bfraw* WINT = (bfraw*)(p.ws + O_WINT) + (long)layer * NPROJ * 1024;
  for (int o = tid; o < 64 * 128; o += NTHR) {
    const int kk = o & 63, dcol = o >> 6;
    const float* Gs = G + (dcol >> 6) * 4096 + (dcol & 63);
    float s = 0.f;
#pragma unroll 4
    for (int c = 0; c < 64; ++c) s += Wt[kk][c] * Gs[c * 64];
    const int row = (dcol < 64) ? (768 + g * 64 + dcol) : (1024 + g * 64 + (dcol - 64));
    WINT[(long)row * 1024 + kt * 64 + kk] = f2bf(s);
  }
}

constexpr int P0_MOD = 192, P0_FOUR = 128, P0_ROPE = 1, P0_DFTC = 256, P0_DFT = 4096, P0_WIN = 2 * 16 * 24, P0_WOUT = 2 * 16 * 16;
constexpr int P0_TOTAL = P0_MOD + P0_FOUR + P0_ROPE + P0_DFTC + P0_DFT + P0_WIN + P0_WOUT + N_EXPCONV;

DI void phase_prep(const Params& p, char* lds, int tid) {
  if (blockIdx.x == 0) { ((unsigned*)(p.ws + O_CTR))[tid] = 0u; ((unsigned*)(p.ws + O_CTR))[NTHR + tid] = 0u; }
  if (blockIdx.x == 0) { unsigned* bw = (unsigned*)(p.ws + O_BAR); for (int i = tid; i < XCD_BAR_WORDS; i += NTHR) bw[i] = 0u; }
  constexpr int P0_BASE = P0_TOTAL - N_EXPCONV;
  for (int item = blockIdx.x; item < P0_BASE; item += gridDim.x) {
    int it = item;
    if (it < P0_MOD) { prep_mod_item(p, it, lds, tid); continue; }
    it -= P0_MOD;
    if (it < P0_FOUR) { prep_four_item(p, it, lds, tid); continue; }
    it -= P0_FOUR;
    if (it < P0_ROPE) {
      float* rope = (float*)(p.ws + O_ROPE);
      for (int idx = tid; idx < 1024; idx += NTHR) {
        const int pos = idx >> 4, f = idx & 15;
        const float inv_freq = powf(10000.f, -(float)f / 16.f);
        const float ang = (float)pos * inv_freq;
        rope[idx] = cosf(ang);
        rope[1024 + idx] = sinf(ang);
      }
      continue;
    }
    it -= P0_ROPE;
    if (it < P0_DFTC) {
      bfraw* D = (bfraw*)(p.ws + O_DFTC) + (long)it * 512;
      for (int k = tid; k < 512; k += NTHR) {
        const int kk = k & 255;
        float sn, cs;
        sincospif((float)((it * kk) & 255) / 128.f, &sn, &cs);
        D[k] = f2bf(k < 256 ? cs : -sn);
      }
      continue;
    }
    it -= P0_DFTC;
    if (it < P0_DFT) {
      const int t = it & 2047;
      bfraw* D = (bfraw*)(p.ws + O_DFT) + (long)it * 4096;
      for (int ch = tid; ch < 2048; ch += NTHR) {
        const int k = ch * 2;
        float sn0, cs0, sn1, cs1;
        sincospif((float)((t * k) & 4095) / 2048.f, &sn0, &cs0);
        sincospif((float)((t * (k + 1)) & 4095) / 2048.f, &sn1, &cs1);
        *(unsigned*)(D + k) = (it < 2048) ? pack2(cs0, cs1) : pack2(sn0, sn1);
      }
      continue;
    }
    it -= P0_DFT;
    if (it < P0_WIN) {
      const int layer = it / 384, r = it % 384, kt = r / 24, nt = r % 24;
      if (nt >= 12 && nt < 16) continue;
      const int col = nt * 64;
      int drow;
      if (col < 768) drow = col;
      else if (col < 1152) drow = col + 256;
      else if (col < 1280) drow = col + 384;
      else if (col < 1408) drow = col + 128;
      else drow = col + 256;
      const float* src = p.w_in + ((long)layer * 1024 + kt * 64) * 1536 + col;
      bfraw* dst = (bfraw*)(p.ws + O_WINT) + ((long)layer * NPROJ + drow) * 1024 + kt * 64;
      xpose_tile(src, 1536, dst, 1024, 0, lds, tid);
      continue;
    }
    it -= P0_WIN;
    if (it < P0_WOUT) {
      const int layer = it >> 8, r = it & 255, kt = r >> 4, nt = r & 15;
      const float* src = p.w_out + ((long)layer * 1024 + kt * 64) * 1024 + nt * 64;
      bfraw* dst = (bfraw*)(p.ws + O_WOUTT) + ((long)layer * 1024 + nt * 64) * 1024 + kt * 64;
      xpose_tile(src, 1024, dst, 1024, 0, lds, tid);
      continue;
    }
  }
  for (int i0 = blockIdx.x; i0 < N_EXPCONV; i0 += 2 * gridDim.x) {
    const int i1 = i0 + gridDim.x;
    expconv_pair(p, 0, i0, (i1 < N_EXPCONV) ? i1 : -1, lds, tid);
  }
}

DI void ln_stats(const float v[16], float& mean, float& rstd) {
  float s = 0.f, q = 0.f;
#pragma unroll
  for (int i = 0; i < 16; ++i) { s += v[i]; q += v[i] * v[i]; }
#pragma unroll
  for (int o = 32; o; o >>= 1) {
    const float ts = __shfl_xor(s, o), tq = __shfl_xor(q, o);
    s += ts; q += tq;
  }
  mean = s * (1.f / 1024.f);
  const float var = fmaxf(q * (1.f / 1024.f) - mean * mean, 0.f);
  rstd = rsqrtf(var + 1e-5f);
}
DI void load_row16(const float* src, int lane, float v[16]) {
#pragma unroll
  for (int i = 0; i < 4; ++i) {
    const float4 t = *(const float4*)(src + i * 256 + lane * 4);
    v[i * 4 + 0] = t.x; v[i * 4 + 1] = t.y; v[i * 4 + 2] = t.z; v[i * 4 + 3] = t.w;
  }
}
DI void store_row16(float* dst, int lane, const float v[16]) {
#pragma unroll
  for (int i = 0; i < 4; ++i) *(float4*)(dst + i * 256 + lane * 4) = make_float4(v[i * 4], v[i * 4 + 1], v[i * 4 + 2], v[i * 4 + 3]);
}
DI void store_row16_bf(bfraw* dst, int lane, const float v[16]) {
#pragma unroll
  for (int i = 0; i < 4; ++i) {
    uint2 st;
    st.x = pack2(v[i * 4], v[i * 4 + 1]);
    st.y = pack2(v[i * 4 + 2], v[i * 4 + 3]);
    *(uint2*)(dst + i * 256 + lane * 4) = st;
  }
}
DI void modulate16(float v[16], const float* sh, const float* sc, int lane) {
  float mean, rstd;
  ln_stats(v, mean, rstd);
  float a[16], b[16];
  load_row16(sh, lane, a);
  load_row16(sc, lane, b);
#pragma unroll
  for (int i = 0; i < 16; ++i) v[i] = (v[i] - mean) * rstd * (1.f + b[i]) + a[i];
}
DI void postnorm16(float v[16], const float* g, const float* bb, int lane) {
  float mean, rstd;
  ln_stats(v, mean, rstd);
  float a[16], b[16];
  load_row16(g, lane, a);
  load_row16(bb, lane, b);
#pragma unroll
  for (int i = 0; i < 16; ++i) v[i] = (v[i] - mean) * rstd * a[i] + b[i];
}

DI void phase_lnmod0(const Params& p, int tid) {
  const int w = tid >> 6, lane = tid & 63;
  const float* MOD = (const float*)(p.ws + O_MOD);
  const int stride = gridDim.x * NWAVE;
  int row = blockIdx.x * NWAVE + w;
  float nv[16];
  if (row < NT + NCT) load_row16((row < NT) ? p.x + (long)row * 1024 : p.ctx + (long)(row - NT) * 1024, lane, nv);
#pragma unroll 1
  for (; row < NT + NCT; row += stride) {
    float v[16];
#pragma unroll
    for (int i = 0; i < 16; ++i) v[i] = nv[i];
    const int nrow = row + stride;
    if (nrow < NT + NCT) load_row16((nrow < NT) ? p.x + (long)nrow * 1024 : p.ctx + (long)(nrow - NT) * 1024, lane, nv);
    if (row < NT) {
      const float* mr = MOD + (0 * 9 + row / SEQ) * 6144;
      modulate16(v, mr, mr + 1024, lane);
      store_row16_bf((bfraw*)(p.ws + O_H) + (long)row * 1024, lane, v);
    } else {
      const int rc = row - NT;
      const float* mr = MOD + (0 * 9 + 8) * 6144;
      modulate16(v, mr, mr + 1024, lane);
      store_row16_bf((bfraw*)(p.ws + O_HC) + (long)rc * 1024, lane, v);
    }
  }
}

DI void proj_item(const Params& p, int layer, bool is_ctx, int rt, int ct, char* lds, int tid) {
  const int T = is_ctx ? CTX : SEQ;
  const bfraw* Hs = (const bfraw*)(p.ws + (is_ctx ? O_HC : O_H));
  const bfraw* W = (const bfraw*)(p.ws + O_WINT) + (long)layer * NPROJ * 1024;
  const bfraw *ap[4], *bp[4];
  rows4(Hs, 1024, rt * 256, tid, ap);
  rows4(W, 1024, ct * 256, tid, bp);
  char* ws = p.ws;
  if (ct <= 2 || ct == 5) {
    const float* rope = (const float*)(ws + O_ROPE);
    gemm_tile<true>(ap, bp, 1024, lds, tid, [&](f32x4 (&acc)[8][4], int wr, int wc, int fr, int fq) {
      const int rowbase = rt * 256 + wr * 128;
      const int b = rowbase / T;
      const int tbase = rowbase - b * T;
      const bool donorm = (ct < 2) || (ct == 5 && wc < 2);
      const float* gn = ((ct < 2) ? p.q_norm : p.k_norm) + layer * 64;
      bfraw* dst;
      long rstride;
      if (ct < 2) { dst = (bfraw*)(ws + (is_ctx ? O_QAC : O_QA)) + ((long)rowbase * 8 + (ct * 4 + wc)) * 64; rstride = 512; }
      else if (ct == 2) { dst = (bfraw*)(ws + (is_ctx ? O_QCC : O_QC)) + ((long)rowbase * 4 + wc) * 64; rstride = 256; }
      else {
        const int slot0 = is_ctx ? tbase : CTX + tbase;
        dst = (bfraw*)(ws + (wc < 2 ? O_KA : O_KC)) + ((long)(b * 2 + (wc & 1)) * KS + slot0) * 64; rstride = 64;
      }
#pragma unroll
      for (int m = 0; m < 8; ++m) {
        const int rl = m * 16 + fr;
        float rs = 1.f;
        if (donorm) {
          float ss = 0.f;
#pragma unroll
          for (int n = 0; n < 4; ++n)
#pragma unroll
            for (int j = 0; j < 4; ++j) ss += acc[m][n][j] * acc[m][n][j];
          ss += __shfl_xor(ss, 16);
          ss += __shfl_xor(ss, 32);
          rs = rsqrtf(ss * (1.f / 64.f) + 1e-6f);
        }
        float xv[4][4];
        const float* gp = gn;
        asm volatile("" : "+s"(gp));
#pragma unroll
        for (int n = 0; n < 4; ++n) {
          if (donorm) {
            const float4 t = *(const float4*)(gp + n * 16 + fq * 4);
            xv[n][0] = acc[m][n][0] * rs * t.x; xv[n][1] = acc[m][n][1] * rs * t.y;
            xv[n][2] = acc[m][n][2] * rs * t.z; xv[n][3] = acc[m][n][3] * rs * t.w;
          } else {
            xv[n][0] = acc[m][n][0]; xv[n][1] = acc[m][n][1]; xv[n][2] = acc[m][n][2]; xv[n][3] = acc[m][n][3];
          }
        }
        if (!is_ctx) {
          const int t = tbase + rl;
          const int pr = t >> 6, pc = t & 63;
          const float4 c0 = *(const float4*)(rope + pr * 16 + fq * 4), s0 = *(const float4*)(rope + 1024 + pr * 16 + fq * 4);
          const float4 c1 = *(const float4*)(rope + pc * 16 + fq * 4), s1 = *(const float4*)(rope + 1024 + pc * 16 + fq * 4);
          const float c0a[4] = {c0.x, c0.y, c0.z, c0.w}, s0a[4] = {s0.x, s0.y, s0.z, s0.w};
          const float c1a[4] = {c1.x, c1.y, c1.z, c1.w}, s1a[4] = {s1.x, s1.y, s1.z, s1.w};
#pragma unroll
          for (int j = 0; j < 4; ++j) {
            const float y0 = xv[0][j] * c0a[j] - xv[1][j] * s0a[j], y1 = xv[1][j] * c0a[j] + xv[0][j] * s0a[j];
            const float y2 = xv[2][j] * c1a[j] - xv[3][j] * s1a[j], y3 = xv[3][j] * c1a[j] + xv[2][j] * s1a[j];
            xv[0][j] = y0; xv[1][j] = y1; xv[2][j] = y2; xv[3][j] = y3;
          }
        }
        bfraw* d = dst + (long)rl * rstride + fq * 4;
#pragma unroll
        for (int n = 0; n < 4; ++n) {
          uint2 st;
          st.x = pack2(xv[n][0], xv[n][1]);
          st.y = pack2(xv[n][2], xv[n][3]);
          *(uint2*)(d + n * 16) = st;
        }
      }
    });
  } else {
    gemm_tile<false>(ap, bp, 1024, lds, tid, [&](f32x4 (&acc)[8][4], int wr, int wc, int fr, int fq) {
      const int rowbase = rt * 256 + wr * 128;
      const int b = rowbase / T;
      const int tbase = rowbase - b * T;
      bfraw* dst;
      long cstride;
      if (ct == 6) {
        const int slot0 = is_ctx ? tbase : CTX + tbase;
        dst = (bfraw*)(ws + (wc < 2 ? O_VAT : O_VCT)) + (long)(b * 2 + (wc & 1)) * 64 * KS + slot0;
        cstride = KS;
      } else {
        const int ncol0 = wc * 64;
        const int koff = (ct == 4) ? T : 0;
        if (is_ctx) { dst = (bfraw*)(ws + O_VTFC) + ((long)b * 256 + ncol0) * 512 + koff + tbase; cstride = 512; }
        else { dst = (bfraw*)(ws + O_VTF) + ((long)b * 256 + ncol0) * 8192 + koff + tbase; cstride = 8192; }
      }
#pragma unroll
      for (int m = 0; m < 8; ++m)
#pragma unroll
        for (int n = 0; n < 4; ++n) {
          uint2 st;
          st.x = pack2(acc[m][n][0], acc[m][n][1]);
          st.y = pack2(acc[m][n][2], acc[m][n][3]);
          *(uint2*)(dst + (long)(n * 16 + fr) * cstride + m * 16 + fq * 4) = st;
        }
    });
  }
}

DI void phase_proj(const Params& p, int layer, unsigned* ctr, int* s_item, char* lds, int tid) {
  const int nct_ctx = (layer == 0) ? 7 : 2;
  const int n_per = 112 + nct_ctx;
  XQ q{0, 0, 0, -1};
  while (next_item_s(n_per, tid, q)) {
    const int x = q.list, i = q.idx;
    if (i < 112) proj_item(p, layer, false, 16 * x + i / 7, i % 7, lds, tid);
    else proj_item(p, layer, true, x, (layer == 0) ? (i - 112) : (5 + i - 112), lds, tid);
  }
}

DI void four_item(const Params& p, int layer, bool is_ctx, int b, int rt, char* lds, int tid) {
  const int T = is_ctx ? CTX : SEQ;
  const int K = 2 * T;
  const bfraw* A = (const bfraw*)(p.ws + (is_ctx ? O_DFTC : O_DFT));
  const bfraw* Bt = (const bfraw*)(p.ws + (is_ctx ? O_VTFC : O_VTF)) + (long)b * 256 * K;
  const bfraw *ap[4], *bp[4];
  rows4(A, K, rt * 256, tid, ap);
  rows4(Bt, K, 0, tid, bp);
  bfraw* MIX = (bfraw*)(p.ws + (is_ctx ? O_MIXC : O_MIX)) + (long)b * T * 1024;
  const float scale = is_ctx ? (1.f / 128.f) : (1.f / 512.f);
  const float* bias = p.b_four + layer * 256;
  gemm_tile<true>(ap, bp, K, lds, tid, [&](f32x4 (&acc)[8][4], int wr, int wc, int fr, int fq) {
#pragma unroll
    for (int n = 0; n < 4; ++n) {
      const int ncol = wc * 64 + n * 16 + fq * 4;
      const float4 bv = *(const float4*)(bias + ncol);
#pragma unroll
      for (int m = 0; m < 8; ++m) {
        const int t = rt * 256 + wr * 128 + m * 16 + fr;
        uint2 st;
        st.x = pack2(acc[m][n][0] * scale + bv.x, acc[m][n][1] * scale + bv.y);
        st.y = pack2(acc[m][n][2] * scale + bv.z, acc[m][n][3] * scale + bv.w);
        *(uint2*)(MIX + (long)t * 1024 + 512 + ncol) = st;
      }
    }
  });
}

DI void four_lat_item(const Params& p, int layer, int b, int rt, char* lds, int tid) {
  const bfraw* Cm = (const bfraw*)(p.ws + O_DFT);
  const bfraw* Sm = Cm + 2048l * 4096;
  const bfraw* Bt = (const bfraw*)(p.ws + O_VTF) + (long)b * 256 * 8192;
  float4* scr = (float4*)(p.ws + O_PSCR) + (long)(b * 8 + rt) * 16384;
  bfraw* MIX = (bfraw*)(p.ws + O_MIX) + (long)b * SEQ * 1024;
  const float scale = 1.f / 512.f;
  const float* bias = p.b_four + layer * 256;
  {
    const bfraw *ap[4], *bp[4];
    rows4(Cm, 4096, rt * 256, tid, ap);
    rows4(Bt, 8192, 0, tid, bp);
    gemm_tile<true>(ap, bp, 4096, lds, tid, [&](f32x4 (&acc)[8][4], int wr, int wc, int fr, int fq) {
      const int t_ = (wr * 4 + wc) * 64 + fq * 16 + fr;
#pragma unroll
      for (int m = 0; m < 8; ++m)
#pragma unroll
        for (int n = 0; n < 4; ++n)
          scr[(m * 4 + n) * NTHR + t_] = make_float4(acc[m][n][0], acc[m][n][1], acc[m][n][2], acc[m][n][3]);
    });
  }
  {
    const bfraw *ap[4], *bp[4];
    rows4(Sm, 4096, rt * 256, tid, ap);
    rows4(Bt + 4096, 8192, 0, tid, bp);
    gemm_tile<true>(ap, bp, 4096, lds, tid, [&](f32x4 (&acc)[8][4], int wr, int wc, int fr, int fq) {
      const int t_ = (wr * 4 + wc) * 64 + fq * 16 + fr;
#pragma unroll
      for (int n = 0; n < 4; ++n) {
        const int ncol = wc * 64 + n * 16 + fq * 4;
        const float4 bv = *(const float4*)(bias + ncol);
#pragma unroll
        for (int m = 0; m < 8; ++m) {
          const int t = rt * 256 + wr * 128 + m * 16 + fr;
          const float4 P = scr[(m * 4 + n) * NTHR + t_];
          uint2 st;
          st.x = pack2((P.x - acc[m][n][0]) * scale + bv.x, (P.y - acc[m][n][1]) * scale + bv.y);
          st.y = pack2((P.z - acc[m][n][2]) * scale + bv.z, (P.w - acc[m][n][3]) * scale + bv.w);
          *(uint2*)(MIX + (long)t * 1024 + 512 + ncol) = st;
          if (t > 0) {
            st.x = pack2((P.x + acc[m][n][0]) * scale + bv.x, (P.y + acc[m][n][1]) * scale + bv.y);
            st.y = pack2((P.z + acc[m][n][2]) * scale + bv.z, (P.w + acc[m][n][3]) * scale + bv.w);
            *(uint2*)(MIX + (long)(SEQ - t) * 1024 + 512 + ncol) = st;
          }
        }
      }
    });
  }
}

DI void four_mid_item(const Params& p, int layer, int b, int tid) {
  const int n = tid >> 1, half = tid & 1;
  const bfraw* v = (const bfraw*)(p.ws + O_VTF) + ((long)b * 256 + n) * 8192 + half * 2048;
  float s = 0.f;
#pragma unroll 4
  for (int k = 0; k < 2048; k += 8) {
    const uint4 u = *(const uint4*)(v + k);
    s += (bflo(u.x) - bfhi(u.x)) + (bflo(u.y) - bfhi(u.y)) + (bflo(u.z) - bfhi(u.z)) + (bflo(u.w) - bfhi(u.w));
  }
  s += __shfl_xor(s, 1);
  if (half == 0) {
    bfraw* MIX = (bfraw*)(p.ws + O_MIX) + ((long)b * SEQ + SEQ / 2) * 1024;
    MIX[512 + n] = f2bf(s * (1.f / 512.f) + p.b_four[layer * 256 + n]);
  }
}

DI void phase_mix(const Params& p, int layer, unsigned* ctr, int* s_item, char* lds, int tid) {
  char* ws = p.ws;
  const int nF = 9, nA = 128, nC = 64;
  const int nFc = (layer == 0) ? 1 : 0, nAc = (layer == 0) ? 8 : 0, nCc = (layer == 0) ? 4 : 0;
  const int n_per = nF + nA + nC + nFc + nAc + nCc;
  XQ q{0, 0, 0, -1};
  while (next_item_x(ctr, n_per, s_item, tid, q)) {
    const int b = q.list;
    int it = q.idx;
    if (it < 8) { four_lat_item(p, layer, b, it, lds, tid); continue; }
    if (it == 8) { four_mid_item(p, layer, b, tid); continue; }
    it -= nF;
    if (it >= nA + nC && it < nA + nC + nFc) { four_item(p, layer, true, b, 0, lds, tid); continue; }
    int kind, h, qb;
    if (it < nA) { kind = 0; h = it >> 4; qb = it & 15; }
    else if (it < nA + nC) { it -= nA; kind = 1; h = it >> 4; qb = it & 15; }
    else {
      it -= nA + nC + nFc;
      if (it < nAc) { kind = 2; h = it; qb = 0; }
      else { it -= nAc; kind = 3; h = it; qb = 0; }
    }
    const bool isA = (kind == 0 || kind == 2), isctx = (kind >= 2);
    const int nh = isA ? 8 : 4;
    const int kvh = isA ? (h >> 2) : (h >> 1);
    const int T = isctx ? CTX : SEQ;
    const long tok0 = (long)b * T + qb * 256;
    const bfraw* Qp = (const bfraw*)(ws + (isA ? (isctx ? O_QAC : O_QA) : (isctx ? O_QCC : O_QC))) + (tok0 * nh + h) * 64;
    const bfraw* Kp = (const bfraw*)(ws + (isA ? O_KA : O_KC)) + (long)(b * 2 + kvh) * KS * 64;
    const bfraw* Vp = (const bfraw*)(ws + (isA ? O_VAT : O_VCT)) + (long)(b * 2 + kvh) * 64 * KS;
    bfraw* Op = (bfraw*)(ws + (isctx ? O_MIXC : O_MIX)) + tok0 * 1024 + (isA ? 0 : 768) + h * 64;
    const float sk = isA ? 0.f : p.sink[layer * 4 + h] * LOG2E;
    if (kind == 1) {
      const int q0 = qb * 256;
      const int lo = (q0 - 128 < 0) ? 0 : q0 - 128;
      const int hi = (q0 + 384 > SEQ) ? SEQ : q0 + 384;
      attn_item<true>(Qp, 256, Kp, Vp, KS, CTX / 64, (CTX + lo) / 64, (hi - lo) / 64, q0, true, sk, Op, 1024, lds, tid);
    } else {
      attn_item<false>(Qp, nh * 64, Kp, Vp, KS, (kind == 0) ? KS / 64 : CTX / 64, 0, 0, 0, !isA, sk, Op, 1024, lds, tid);
    }
  }
}

DI void phase_outproj(const Params& p, int layer, unsigned* ctr, int* s_item, char* lds, int tid) {
  const int n_lat = 128 * 4, n_ctx = (layer == 0) ? 8 * 4 : 0;
  const bfraw* W = (const bfraw*)(p.ws + O_WOUTT) + (long)layer * 1024 * 1024;
  const float* MOD = (const float*)(p.ws + O_MOD);
  (void)n_lat; (void)n_ctx;
  const int n_per = 64 + ((layer == 0) ? 4 : 0);
  XQ q{0, 0, 0, -1};
  while (next_item_s(n_per, tid, q)) {
    const bool is_ctx = q.idx >= 64;
    const int rt = is_ctx ? q.list : (16 * q.list + (q.idx >> 2));
    const int ct = is_ctx ? (q.idx - 64) : (q.idx & 3);
    const int T = is_ctx ? CTX : SEQ;
    const bfraw* A = (const bfraw*)(p.ws + (is_ctx ? O_MIXC : O_MIX));
    const float* xin = is_ctx ? p.ctx : (layer == 0 ? p.x : p.out);
    float* X1 = (float*)(p.ws + (is_ctx ? O_X1C : O_X1));
    const bfraw *ap[4], *bp[4];
    rows4(A, 1024, rt * 256, tid, ap);
    rows4(W, 1024, ct * 256, tid, bp);
    gemm_tile<true>(ap, bp, 1024, lds, tid, [&](f32x4 (&acc)[8][4], int wr, int wc, int fr, int fq) {
      const int rowbase = rt * 256 + wr * 128;
      const int b = is_ctx ? 8 : rowbase / T;
      const float* g1 = MOD + (layer * 9 + b) * 6144 + 2048;
#pragma unroll
      for (int n = 0; n < 4; ++n) {
        const int col = ct * 256 + wc * 64 + n * 16 + fq * 4;
        const float4 gv = *(const float4*)(g1 + col);
#pragma unroll
        for (int m = 0; m < 8; ++m) {
          const long idx = (long)(rowbase + m * 16 + fr) * 1024 + col;
          const float4 xv = *(const float4*)(xin + idx);
          float4 o;
          o.x = ALPHA * xv.x + gv.x * acc[m][n][0];
          o.y = ALPHA * xv.y + gv.y * acc[m][n][1];
          o.z = ALPHA * xv.z + gv.z * acc[m][n][2];
          o.w = ALPHA * xv.w + gv.w * acc[m][n][3];
          *(float4*)(X1 + idx) = o;
        }
      }
    });
  }
}

DI void phase_row(const Params& p, int layer, char* lds, int tid) {
  const int w = tid >> 6, lane = tid & 63;
  float* wrl = (float*)lds;
  __syncthreads();
  {
    const float* wr = p.w_router + (long)layer * 1024 * 16;
    for (int idx = tid; idx < 16384; idx += NTHR) wrl[(idx & 15) * 1024 + (idx >> 4)] = wr[idx];
  }
  __syncthreads();
  const float* MOD = (const float*)(p.ws + O_MOD);
  const int nrows = NT + ((layer == 0) ? NCT : 0);
  const int stride = gridDim.x * NWAVE;
  int row = blockIdx.x * NWAVE + w;
  float nv[16];
  if (row < nrows) {
    const bool c = row >= NT;
    load_row16((const float*)(p.ws + (c ? O_X1C : O_X1)) + (long)(c ? row - NT : row) * 1024, lane, nv);
  }
#pragma unroll 1
  for (; row < nrows; row += stride) {
    const bool is_ctx = row >= NT;
    const int rr = is_ctx ? row - NT : row;
    float* X1 = (float*)(p.ws + (is_ctx ? O_X1C : O_X1)) + (long)rr * 1024;
    bfraw* Hd = (bfraw*)(p.ws + (is_ctx ? O_HC : O_H)) + (long)rr * 1024;
    const int T = is_ctx ? CTX : SEQ;
    const int b = rr / T, t = rr - b * T;
    const float* mr = MOD + (layer * 9 + (is_ctx ? 8 : b)) * 6144;
    float v[16];
#pragma unroll
    for (int i = 0; i < 16; ++i) v[i] = nv[i];
    if (row + stride < nrows) {
      const int nrow = row + stride;
      const bool c = nrow >= NT;
      load_row16((const float*)(p.ws + (c ? O_X1C : O_X1)) + (long)(c ? nrow - NT : nrow) * 1024, lane, nv);
    }
    postnorm16(v, p.ln1_g + layer * 1024, p.ln1_b + layer * 1024, lane);
    store_row16(X1, lane, v);
    modulate16(v, mr + 3072, mr + 4096, lane);
    store_row16_bf(Hd, lane, v);
    float pr[16];
#pragma unroll
    for (int e = 0; e < 16; ++e) {
      float s = 0.f;
#pragma unroll
      for (int i = 0; i < 4; ++i) {
        const float4 wv = *(const float4*)(wrl + e * 1024 + i * 256 + lane * 4);
        s += v[i * 4] * wv.x + v[i * 4 + 1] * wv.y + v[i * 4 + 2] * wv.z + v[i * 4 + 3] * wv.w;
      }
      pr[e] = s;
      asm volatile("" ::: "memory");
    }
    float r8[8], r4[4], r2[2];
    {
      const bool hi = (lane & 32) != 0;
#pragma unroll
      for (int i = 0; i < 8; ++i) { const float a = pr[i], c = pr[i + 8]; r8[i] = (hi ? c : a) + __shfl_xor(hi ? a : c, 32); }
    }
    {
      const bool hi = (lane & 16) != 0;
#pragma unroll
      for (int i = 0; i < 4; ++i) { const float a = r8[i], c = r8[i + 4]; r4[i] = (hi ? c : a) + __shfl_xor(hi ? a : c, 16); }
    }
    {
      const bool hi = (lane & 8) != 0;
#pragma unroll
      for (int i = 0; i < 2; ++i) { const float a = r4[i], c = r4[i + 2]; r2[i] = (hi ? c : a) + __shfl_xor(hi ? a : c, 8); }
    }
    float lg;
    {
      const bool hi = (lane & 4) != 0;
      lg = (hi ? r2[1] : r2[0]) + __shfl_xor(hi ? r2[0] : r2[1], 4);
    }
    lg += __shfl_xor(lg, 2);
    lg += __shfl_xor(lg, 1);
    const int elane = ((lane >> 5) & 1) * 8 + ((lane >> 4) & 1) * 4 + ((lane >> 3) & 1) * 2 + ((lane >> 2) & 1);
    float mx = lg;
    mx = fmaxf(mx, __shfl_xor(mx, 4)); mx = fmaxf(mx, __shfl_xor(mx, 8));
    mx = fmaxf(mx, __shfl_xor(mx, 16)); mx = fmaxf(mx, __shfl_xor(mx, 32));
    const float ex = __expf(lg - mx);
    float den = ex;
    den += __shfl_xor(den, 4); den += __shfl_xor(den, 8); den += __shfl_xor(den, 16); den += __shfl_xor(den, 32);
    const float mine = ex / den;
    if ((lane & 3) == 0) {
      float* AFF = (float*)(p.ws + (is_ctx ? O_AFFC : O_AFF));
      AFF[((long)b * 16 + elane) * T + t] = mine;
    }
  }
}

DI void topk_item(const Params& p, bool is_ctx, int b, int e, char* lds, int tid) {
  const int T = is_ctx ? CTX : SEQ, cap = is_ctx ? CAPC : CAP;
  unsigned* hist = (unsigned*)lds;
  unsigned* sel = hist + 256;
  unsigned* wtot = hist + 264;
  const unsigned* AFF = (const unsigned*)(p.ws + (is_ctx ? O_AFFC : O_AFF)) + ((long)b * 16 + e) * T;
  const int lane = tid & 63, w = tid >> 6;
  const bool have = tid * 8 < T;
  unsigned v[8];
  if (have) {
    const uint4 t0 = *(const uint4*)(AFF + tid * 8), t1 = *(const uint4*)(AFF + tid * 8 + 4);
    v[0] = t0.x; v[1] = t0.y; v[2] = t0.z; v[3] = t0.w; v[4] = t1.x; v[5] = t1.y; v[6] = t1.z; v[7] = t1.w;
  } else {
#pragma unroll
    for (int i = 0; i < 8; ++i) v[i] = 0u;
  }
  unsigned prefix = 0u, kk = (unsigned)cap;
#pragma unroll 1
  for (int pass = 3; pass >= 0; --pass) {
    __syncthreads();
    if (tid < 256) hist[tid] = 0u;
    __syncthreads();
    if (have) {
#pragma unroll
      for (int i = 0; i < 8; ++i) {
        const bool match = (pass == 3) ? true : ((v[i] >> (8 * (pass + 1))) == prefix);
        if (match) atomicAdd(&hist[(v[i] >> (8 * pass)) & 255u], 1u);
      }
    }
    __syncthreads();
    if (tid < 256) {
      unsigned sfx = 0u;
      for (int d = tid + 1; d < 256; ++d) sfx += hist[d];
      const unsigned me = hist[tid];
      if (sfx < kk && sfx + me >= kk) { sel[0] = (unsigned)tid; sel[1] = kk - sfx; }
    }
    __syncthreads();
    prefix = (prefix << 8) | sel[0];
    kk = sel[1];
  }
  const unsigned thr = prefix;
  unsigned cg = 0u, ce = 0u;
  if (have) {
#pragma unroll
    for (int i = 0; i < 8; ++i) { cg += (v[i] > thr); ce += (v[i] == thr); }
  }
  unsigned pk = cg | (ce << 16);
  unsigned inc = pk;
#pragma unroll
  for (int o = 1; o < 64; o <<= 1) {
    const unsigned t = __shfl_up(inc, o);
    if (lane >= o) inc += t;
  }
  __syncthreads();
  if (lane == 63) wtot[w] = inc;
  __syncthreads();
  unsigned base = 0u, total = 0u;
#pragma unroll
  for (int ww = 0; ww < NWAVE; ++ww) { const unsigned t = wtot[ww]; if (ww < w) base += t; total += t; }
  const unsigned excl = base + inc - pk;
  unsigned pos_g = excl & 0xffffu, pos_e = excl >> 16;
  const unsigned n_gt = total & 0xffffu;
  if (have) {
    short* SLOT = (short*)(p.ws + (is_ctx ? O_SLOTC : O_SLOT));
    int* IDX = (int*)(p.ws + (is_ctx ? O_IDXC : O_IDX));
    float* GATE = (float*)(p.ws + (is_ctx ? O_GATEC : O_GATE));
#pragma unroll
    for (int i = 0; i < 8; ++i) {
      const int idx = tid * 8 + i;
      int slot = -1;
      if (v[i] > thr) { slot = (int)pos_g; ++pos_g; }
      else if (v[i] == thr) { if (pos_e < kk) slot = (int)(n_gt + pos_e); ++pos_e; }
      if (slot >= 0) {
        const int prow = (e * 8 + b) * cap + slot;
        IDX[prow] = idx;
        GATE[prow] = __uint_as_float(v[i]);
      }
      SLOT[((long)b * T + idx) * 16 + e] = (short)slot;
    }
  }
}

DI void phase_topk(const Params& p, int layer, char* lds, int tid) {
  const int n_lat = 128, n_ctx = (layer == 0) ? 128 : 0;
  for (int item = blockIdx.x; item < n_lat + n_ctx; item += gridDim.x) {
    int it = item;
    if (it < n_lat) { topk_item(p, false, it >> 4, it & 15, lds, tid); continue; }
    it -= n_lat;
    topk_item(p, true, it >> 4, it & 15, lds, tid);
  }
  if (layer == 1) {
    const int g = gridDim.x;
    for (int i0 = ((int)blockIdx.x + g - 128 % g) % g; i0 < N_EXPCONV; i0 += 2 * g) {
      const int i1 = i0 + g;
      expconv_pair(p, 1, i0, (i1 < N_EXPCONV) ? i1 : -1, lds, tid);
    }
  }
}

template <int VAR = 0>
DI void phase_moe1(const Params& p, int layer, unsigned* ctr, int* s_item, char* lds, int tid) {
  const bfraw* WGU = (const bfraw*)(p.ws + O_WGU);
  const int n_per = 512 + ((layer == 0) ? 32 : 0);
  XQ q{0, 0, 0, -1};
  auto decode = [&](int x, int i, int& e, int& ct, int& rt, bool& is_ctx) {
    is_ctx = i >= 512;
    if (!is_ctx) { e = i >> 5; const int loc = i & 31; rt = 4 * (x & 3) + (loc & 3); ct = 8 * (x >> 2) + (loc >> 2); }
    else { const int g = x * 32 + (i - 512); e = g >> 4; ct = g & 15; rt = 0; }
  };
  auto load_tok = [&](int x, int i, int (&tok)[4]) {
    int e, ct, rt; bool c;
    decode(x, i, e, ct, rt, c);
    const int cap = c ? CAPC : CAP;
    const int* IDX = (const int*)(p.ws + (c ? O_IDXC : O_IDX));
    const int r0 = (tid & 255) >> 2;
#pragma unroll
    for (int k = 0; k < 4; ++k) tok[k] = IDX[e * 8 * cap + rt * 256 + k * 64 + r0];
  };
  int tokn[4] = {0, 0, 0, 0};
  bool have = next_item_s(n_per, tid, q);
  if (have) load_tok(q.list, q.idx, tokn);
  while (have) {
    const int x = q.list, ci = q.idx;
    int e, ct, rt; bool is_ctx;
    decode(x, ci, e, ct, rt, is_ctx);
    const int cap = is_ctx ? CAPC : CAP, T = is_ctx ? CTX : SEQ;
    const bfraw* Hs = (const bfraw*)(p.ws + (is_ctx ? O_HC : O_H));
    bfraw* ACT = (bfraw*)(p.ws + (is_ctx ? O_ACTC : O_ACT));
    const bfraw *ap[4], *bp[4];
    {
      const int r0 = (tid & 255) >> 2, c8 = ((tid & 3) ^ swz4(tid >> 4)) * 8;
#pragma unroll
      for (int i = 0; i < 4; ++i) {
        const int l = rt * 256 + i * 64 + r0;
        ap[i] = Hs + ((long)(l / cap) * T + tokn[i]) * 1024 + c8;
      }
    }
    have = next_item_s(n_per, tid, q);
    if (have) load_tok(q.list, q.idx, tokn);
    rows4(WGU, 1024, e * 4096 + ct * 256, tid, bp);
    const long prow0 = (long)e * 8 * cap + rt * 256;
    gemm_tile<true>(ap, bp, 1024, lds, tid, [&](f32x4 (&acc)[8][4], int wr, int wc, int fr, int fq) {
#pragma unroll
      for (int m = 0; m < 8; ++m)
#pragma unroll
        for (int q = 0; q < 2; ++q) {
          const int f = ct * 128 + wc * 32 + q * 16 + fq * 4;
          if (VAR != 0) {
            if (is_ctx || ct >= 8) continue;
            bfraw* Yd = (bfraw*)(p.ws + O_Y);
            uint2 st;
            st.x = pack2(acc[m][2 * q][0] + acc[m][2 * q + 1][0], acc[m][2 * q][1] + acc[m][2 * q + 1][1]);
            st.y = pack2(acc[m][2 * q][2] + acc[m][2 * q + 1][2], acc[m][2 * q][3] + acc[m][2 * q + 1][3]);
            *(uint2*)(Yd + (prow0 + wr * 128 + m * 16 + fr) * 1024 + f) = st;
            continue;
          }
          float sv[4];
#pragma unroll
          for (int j = 0; j < 4; ++j) {
            const float g = acc[m][2 * q][j], u = acc[m][2 * q + 1][j];
            sv[j] = g * u * __builtin_amdgcn_rcpf(1.f + __builtin_amdgcn_exp2f(-LOG2E * g));
          }
          uint2 st;
          st.x = pack2(sv[0], sv[1]);
          st.y = pack2(sv[2], sv[3]);
          *(uint2*)(ACT + (prow0 + wr * 128 + m * 16 + fr) * FF + f) = st;
        }
    });
  }
}

DI void phase_moe2(const Params& p, int layer, unsigned* ctr, int* s_item, char* lds, int tid) {
  const bfraw* WD = (const bfraw*)(p.ws + O_WD);
  const int n_per = 128 + ((layer == 0) ? 8 : 0);
  XQ q{0, 0, 0, -1};
  while (next_item_s(n_per, tid, q)) {
    const int x = q.list;
    const bool is_ctx = q.idx >= 128;
    const int cap = is_ctx ? CAPC : CAP;
    int e, ct, rt;
    if (!is_ctx) { e = (x >> 2) + 2 * (q.idx >> 4); const int loc = q.idx & 15; rt = 4 * (x & 3) + (loc & 3); ct = loc >> 2; }
    else { const int g = x * 8 + (q.idx - 128); e = g >> 2; ct = g & 3; rt = 0; }
    const bfraw* ACT = (const bfraw*)(p.ws + (is_ctx ? O_ACTC : O_ACT));
    bfraw* Y = (bfraw*)(p.ws + (is_ctx ? O_YC : O_Y));
    const long prow0 = (long)e * 8 * cap + rt * 256;
    const bfraw *ap[4], *bp[4];
    rows4(ACT + prow0 * FF, FF, 0, tid, ap);
    rows4(WD, FF, e * 1024 + ct * 256, tid, bp);
    gemm_tile<true>(ap, bp, FF, lds, tid, [&](f32x4 (&acc)[8][4], int wr, int wc, int fr, int fq) {
#pragma unroll
      for (int m = 0; m < 8; ++m)
#pragma unroll
        for (int n = 0; n < 4; ++n) {
          const int col = ct * 256 + wc * 64 + n * 16 + fq * 4;
          uint2 st;
          st.x = pack2(acc[m][n][0], acc[m][n][1]);
          st.y = pack2(acc[m][n][2], acc[m][n][3]);
          *(uint2*)(Y + (prow0 + wr * 128 + m * 16 + fr) * 1024 + col) = st;
        }
    });
  }
}

DI void phase_combine(const Params& p, int layer, int tid) {
  const int w = tid >> 6, lane = tid & 63;
  const float* MOD = (const float*)(p.ws + O_MOD);
  const int nrows = NT + ((layer == 0) ? NCT : 0);
  const int stride = gridDim.x * NWAVE;
  int row = blockIdx.x * NWAVE + w;
  if (row >= nrows) return;
  uint4 nsl0, nsl1;
  float nv[16];
  {
    const bool c = row >= NT;
    const int r = c ? row - NT : row;
    const short* SL = (const short*)(p.ws + (c ? O_SLOTC : O_SLOT)) + (long)r * 16;
    nsl0 = *(const uint4*)SL; nsl1 = *(const uint4*)(SL + 8);
    load_row16((const float*)(p.ws + (c ? O_X1C : O_X1)) + (long)r * 1024, lane, nv);
  }
#pragma unroll 1
  for (; row < nrows; row += stride) {
    const bool is_ctx = row >= NT;
    const int rr = is_ctx ? row - NT : row;
    const int T = is_ctx ? CTX : SEQ, cap = is_ctx ? CAPC : CAP;
    const int b = rr / T;
    const float* GATE = (const float*)(p.ws + (is_ctx ? O_GATEC : O_GATE));
    const bfraw* Y = (const bfraw*)(p.ws + (is_ctx ? O_YC : O_Y));
    const float* mr = MOD + (layer * 9 + (is_ctx ? 8 : b)) * 6144;
    const uint4 sl0 = nsl0, sl1 = nsl1;
    float v[16];
#pragma unroll
    for (int i = 0; i < 16; ++i) v[i] = nv[i];
    {
      const int nrow = row + stride;
      if (nrow < nrows) {
        const bool c = nrow >= NT;
        const int r = c ? nrow - NT : nrow;
        const short* SL = (const short*)(p.ws + (c ? O_SLOTC : O_SLOT)) + (long)r * 16;
        nsl0 = *(const uint4*)SL; nsl1 = *(const uint4*)(SL + 8);
        load_row16((const float*)(p.ws + (c ? O_X1C : O_X1)) + (long)r * 1024, lane, nv);
      }
    }
    const unsigned slw[8] = {sl0.x, sl0.y, sl0.z, sl0.w, sl1.x, sl1.y, sl1.z, sl1.w};
    float y[16];
#pragma unroll
    for (int i = 0; i < 16; ++i) y[i] = 0.f;
#pragma unroll
    for (int e = 0; e < 16; ++e) {
      const unsigned wd = slw[e >> 1];
      const int sv = (int)(short)((e & 1) ? (wd >> 16) : (wd & 0xffffu));
      if (sv >= 0) {
        const long prow = (long)(e * 8 + b) * cap + sv;
        const float g = GATE[prow];
        const bfraw* yr = Y + prow * 1024;
#pragma unroll
        for (int i = 0; i < 4; ++i) {
          const uint2 u = *(const uint2*)(yr + i * 256 + lane * 4);
          y[i * 4 + 0] += g * bflo(u.x); y[i * 4 + 1] += g * bfhi(u.x);
          y[i * 4 + 2] += g * bflo(u.y); y[i * 4 + 3] += g * bfhi(u.y);
        }
      }
    }
    float g2[16];
    load_row16(mr + 5120, lane, g2);
#pragma unroll
    for (int i = 0; i < 16; ++i) v[i] = ALPHA * v[i] + g2[i] * y[i];
    postnorm16(v, p.ln2_g + layer * 1024, p.ln2_b + layer * 1024, lane);
    if (!is_ctx) store_row16(p.out + (long)rr * 1024, lane, v);
    if (layer == 0) {
      const float* mn = MOD + (1 * 9 + (is_ctx ? 8 : b)) * 6144;
      modulate16(v, mn, mn + 1024, lane);
      store_row16_bf((bfraw*)(p.ws + (is_ctx ? O_HC : O_H)) + (long)rr * 1024, lane, v);
    }
  }
}

#ifndef DUP_MASK
#define DUP_MASK 0
#endif
DI void run_phase(const Params& p, int ph, unsigned* ctr, int* s_item, char* smem, int tid) {
  if (ph == 0) phase_prep(p, smem, tid);
  else if (ph == 1) phase_lnmod0(p, tid);
  else {
    const int layer = (ph - 2) >> 3, sub = (ph - 2) & 7;
    switch (sub) {
      case 0: phase_proj(p, layer, ctr, s_item, smem, tid); break;
      case 1: phase_mix(p, layer, ctr, s_item, smem, tid); break;
      case 2: phase_outproj(p, layer, ctr, s_item, smem, tid); break;
      case 3: phase_row(p, layer, smem, tid); break;
      case 4: phase_topk(p, layer, smem, tid); break;
      case 5: phase_moe1(p, layer, ctr, s_item, smem, tid); break;
      case 6: phase_moe2(p, layer, ctr, s_item, smem, tid); break;
      default: phase_combine(p, layer, tid); break;
    }
  }
}

__global__ void __launch_bounds__(NTHR) fwd_kernel(Params p) {
  extern __shared__ __attribute__((aligned(16))) char smem[];
  __shared__ int s_item;
  __shared__ uint4 xb_words;
  const int wave_id = __builtin_amdgcn_readfirstlane((int)(threadIdx.x >> 6));
  if (threadIdx.x == 0) xb_words = make_uint4(0u, 0u, 0u, 0u);
  __syncthreads();
  unsigned* barw = (unsigned*)(p.ws + O_BAR);
  for (int ph = p.ph_lo; ph < p.ph_hi; ++ph) {
    if (ph > p.ph_lo) {
      if (ph == 1) {
        cg::this_grid().sync();
        int t0;
        asm volatile("v_mbcnt_lo_u32_b32 %0, -1, 0\n\tv_mbcnt_hi_u32_b32 %0, -1, %0" : "=v"(t0));
        xcd_barrier_post(barw, t0 + wave_id * 64);
      } else {
        int t0;
        asm volatile("v_mbcnt_lo_u32_b32 %0, -1, 0\n\tv_mbcnt_hi_u32_b32 %0, -1, %0" : "=v"(t0));
        xcd_barrier(barw, (volatile unsigned*)&xb_words, t0 + wave_id * 64);
      }
    }
    int tid;
    asm volatile("v_mbcnt_lo_u32_b32 %0, -1, 0\n\tv_mbcnt_hi_u32_b32 %0, -1, %0" : "=v"(tid));
    tid += wave_id * 64;
    unsigned* ctr = (unsigned*)(p.ws + O_CTR) + ph * 8;
    run_phase(p, ph, ctr, &s_item, smem, tid);
#ifdef PROBE_VAR
    if (ph >= 2 && ((ph - 2) & 7) == 5) {
      cg::this_grid().sync();
      asm volatile("" : "+v"(tid));
      phase_moe1<PROBE_VAR>(p, (ph - 2) >> 3, ctr + 32 * 8, &s_item, smem, tid);
    }
#endif
#if DUP_MASK
    {
      const int bit = (ph == 0) ? 8 : (ph == 1) ? 9 : ((ph - 2) & 7);
      if ((DUP_MASK >> bit) & 1) {
        cg::this_grid().sync();
        asm volatile("" : "+v"(tid));
        run_phase(p, ph, ctr + 32 * 8, &s_item, smem, tid);
      }
    }
#endif
  }
}

extern "C" void kernel_launch(void* const* d_in, const int* in_sizes, int n_in, void* d_out, int out_size, void* d_ws,
                              size_t ws_size, hipStream_t stream) {
  (void)in_sizes; (void)n_in; (void)out_size;
  if (ws_size < O_END) { fprintf(stderr, "kernel_launch: workspace too small (%zu < %zu)\n", ws_size, (size_t)O_END); return; }
  Params p{};
  const float** pp = (const float**)&p;
  for (int i = 0; i < 21; ++i) pp[i] = (const float*)d_in[i];
  p.out = (float*)d_out;
  p.ws = (char*)d_ws;
  static int grid_blocks = 0;
  if (!grid_blocks) {
    int dev = 0, cus = 0, per_cu = 0;
    hipGetDevice(&dev);
    hipDeviceGetAttribute(&cus, hipDeviceAttributeMultiprocessorCount, dev);
    hipFuncSetAttribute((const void*)fwd_kernel, hipFuncAttributeMaxDynamicSharedMemorySize, LDS_BYTES);
    hipOccupancyMaxActiveBlocksPerMultiprocessor(&per_cu, fwd_kernel, NTHR, LDS_BYTES);
    if (per_cu < 1) per_cu = 1;
    if (per_cu > 1) per_cu = 1;
    grid_blocks = cus * per_cu;
  }
#if ONE_LAUNCH
  p.ph_lo = 0; p.ph_hi = NPHASE;
  void* args[] = {&p};
  hipError_t e = hipLaunchCooperativeKernel((void*)fwd_kernel, dim3(grid_blocks), dim3(NTHR), args, LDS_BYTES, stream);
  if (e != hipSuccess) fprintf(stderr, "cooperative launch failed: %s (grid %d)\n", hipGetErrorString(e), grid_blocks);
#else
  for (int ph = 0; ph < NPHASE; ++ph) {
    p.ph_lo = ph; p.ph_hi = ph + 1;
    hipLaunchKernelGGL(fwd_kernel, dim3(grid_blocks), dim3(NTHR), LDS_BYTES, stream, p);
  }
#endif
}
```

```cpp
#include <hip/hip_runtime.h>
#include <hip/hip_cooperative_groups.h>
#include <cstdio>
namespace cg = cooperative_groups;

#ifndef ONE_LAUNCH
#define ONE_LAUNCH 1
#endif

#define DI __device__ __forceinline__
typedef unsigned short bfraw;
using bf16x8 = __attribute__((ext_vector_type(8))) short;
using f32x4 = __attribute__((ext_vector_type(4))) float;

constexpr int NB = 8, SEQ = 4096, DM = 1024, CTX = 256;
constexpr int NT = NB * SEQ, NCT = NB * CTX;
constexpr int NPROJ = 1792;
constexpr int KS = CTX + SEQ;
constexpr int NE = 16, FF = 2048;
constexpr int CAP = 512, CAPC = 32;
constexpr float ALPHA = 1.41421356237f;
constexpr float LOG2E = 1.44269504089f;
constexpr int NPHASE = 18;
constexpr int NTHR = 512;
constexpr int NWAVE = NTHR / 64;
constexpr int LDS_BYTES = 131072;

constexpr size_t al(size_t x) { return (x + 255) & ~size_t(255); }
constexpr size_t O_MOD = 0;
constexpr size_t O_ROPE = al(O_MOD + 2 * 9 * 6144 * 4);
constexpr size_t O_CTR = al(O_ROPE + 2 * 1024 * 4);
constexpr size_t O_BAR = al(O_CTR + 1024 * 4);
constexpr size_t O_WINT = al(O_BAR + 3456 * 4);
constexpr size_t O_WOUTT = al(O_WINT + 2ull * NPROJ * 1024 * 2);
constexpr size_t O_DFT = al(O_WOUTT + 2ull * 1024 * 1024 * 2);
constexpr size_t O_PSCR = O_DFT + 2ull * 2048 * 4096 * 2;
constexpr size_t O_DFTC = al(O_DFT + 4096ull * 8192 * 2);
constexpr size_t O_WGU = al(O_DFTC + 256ull * 512 * 2);
constexpr size_t O_WD = al(O_WGU + 16ull * 4096 * 1024 * 2);
constexpr size_t O_X1 = al(O_WD + 16ull * 1024 * 2048 * 2);
constexpr size_t O_X1C = al(O_X1 + (size_t)NT * 1024 * 4);
constexpr size_t O_H = al(O_X1C + (size_t)NCT * 1024 * 4);
constexpr size_t O_HC = al(O_H + (size_t)NT * 1024 * 2);
constexpr size_t O_AFF = al(O_HC + (size_t)NCT * 1024 * 2);
constexpr size_t O_AFFC = al(O_AFF + 8ull * 16 * 4096 * 4);
constexpr size_t O_IDX = al(O_AFFC + 8ull * 16 * 256 * 4);
constexpr size_t O_GATE = al(O_IDX + 16ull * 8 * 512 * 4);
constexpr size_t O_SLOT = al(O_GATE + 16ull * 8 * 512 * 4);
constexpr size_t O_IDXC = al(O_SLOT + 8ull * 4096 * 16 * 2);
constexpr size_t O_GATEC = al(O_IDXC + 16ull * 8 * 32 * 4);
constexpr size_t O_SLOTC = al(O_GATEC + 16ull * 8 * 32 * 4);
constexpr size_t O_Y = al(O_SLOTC + 8ull * 256 * 16 * 2);
constexpr size_t O_YC = al(O_Y + 65536ull * 1024 * 2);
constexpr size_t O_ACTC = al(O_YC + 4096ull * 1024 * 2);
constexpr size_t O_R = al(O_ACTC + 4096ull * 2048 * 2);
constexpr size_t O_ACT = O_R;
constexpr size_t O_QA = O_R;
constexpr size_t O_QC = al(O_QA + (size_t)NT * 512 * 2);
constexpr size_t O_KA = al(O_QC + (size_t)NT * 256 * 2);
constexpr size_t O_VAT = al(O_KA + 8ull * 2 * KS * 64 * 2);
constexpr size_t O_KC = al(O_VAT + 8ull * 2 * KS * 64 * 2);
constexpr size_t O_VCT = al(O_KC + 8ull * 2 * KS * 64 * 2);
constexpr size_t O_VTF = al(O_VCT + 8ull * 2 * KS * 64 * 2);
constexpr size_t O_MIX = al(O_VTF + 8ull * 256 * 8192 * 2);
constexpr size_t O_QAC = al(O_MIX + (size_t)NT * 1024 * 2);
constexpr size_t O_QCC = al(O_QAC + (size_t)NCT * 512 * 2);
constexpr size_t O_VTFC = al(O_QCC + (size_t)NCT * 256 * 2);
constexpr size_t O_MIXC = al(O_VTFC + 8ull * 256 * 512 * 2);
constexpr size_t O_REND = al(O_MIXC + (size_t)NCT * 1024 * 2);
constexpr size_t O_END = O_R + 65536ull * 2048 * 2;
static_assert(O_REND <= O_END, "mixer buffers must fit in the ACT region");
static_assert(O_END <= 1073741824ull, "workspace too large");

struct Params {
  const float *x, *c, *ctx, *c_ctx, *w_mod, *b_mod, *w_in, *q_norm, *k_norm, *w_four, *b_four, *sink, *w_out,
      *ln1_g, *ln1_b, *w_router, *w_gate, *w_up, *w_down, *ln2_g, *ln2_b;
  float* out;
  char* ws;
  int ph_lo, ph_hi;
};

typedef __bf16 hwbf2 __attribute__((ext_vector_type(2)));
typedef float hwf2 __attribute__((ext_vector_type(2)));
DI unsigned pack2(float a, float b) {
  hwf2 f = {a, b};
  return __builtin_bit_cast(unsigned, __builtin_convertvector(f, hwbf2));
}
DI bfraw f2bf(float x) { return (bfraw)(pack2(x, 0.f) & 0xffffu); }
DI float bflo(unsigned u) { return __uint_as_float(u << 16); }
DI float bfhi(unsigned u) { return __uint_as_float(u & 0xffff0000u); }
DI float wsum(float v) {
#pragma unroll
  for (int o = 32; o; o >>= 1) v += __shfl_xor(v, o);
  return v;
}
DI void glds16(const void* g, char* l) {
  __builtin_amdgcn_global_load_lds((const unsigned*)g, (unsigned*)l, 16, 0, 0);
}
DI void wait_vm0() { asm volatile("s_waitcnt vmcnt(0)" ::: "memory"); }
DI f32x4 mfma16(bf16x8 a, bf16x8 b, f32x4 c) { return __builtin_amdgcn_mfma_f32_16x16x32_bf16(a, b, c, 0, 0, 0); }

DI int swz4(int q) { return (-q) & 3; }

struct XQ { int kk; int list; int idx; int wv; };
DI bool next_item_s(int n_per, int& tid, XQ& q) {
  if (q.wv < 0) { q.wv = __builtin_amdgcn_readfirstlane(tid >> 6); q.idx = (int)(blockIdx.x >> 3); q.list = (int)(blockIdx.x & 7); }
  else q.idx += (int)((gridDim.x + 7 - (blockIdx.x & 7)) >> 3);
  asm volatile("v_mbcnt_lo_u32_b32 %0, -1, 0\n\tv_mbcnt_hi_u32_b32 %0, -1, %0" : "=v"(tid));
  tid += q.wv * 64;
  return q.idx < n_per;
}
DI bool next_item_x(unsigned* ctr, int n_per, int* s_item, int& tid, XQ& q) {
  if (q.wv < 0) q.wv = __builtin_amdgcn_readfirstlane(tid >> 6);
  asm volatile("v_mbcnt_lo_u32_b32 %0, -1, 0\n\tv_mbcnt_hi_u32_b32 %0, -1, %0" : "=v"(tid));
  tid += q.wv * 64;
  for (;;) {
    if (q.kk >= 8) return false;
    q.list = ((int)(__builtin_amdgcn_s_getreg(20 | (3 << 11)) & 7) + q.kk) & 7;
    __syncthreads();
    if (tid == 0) *s_item = (int)atomicAdd(ctr + q.list, 1u);
    __syncthreads();
    q.idx = *s_item;
    if (q.idx < n_per) return true;
    ++q.kk;
  }
}

#define XB_TMO      128
#define XB_XCNT(j)  (256  + 64 * (j))
#define XB_XSUB(j)  (1280 + 64 * (j))
#define XB_XGEN(j)  (2304 + 64 * (j))
#define XB_TOP      3328
#define XB_TOPGEN   3392
#define XCD_BAR_WORDS 3456
#define XB_SPIN_CAP (1u << 18)
DI unsigned xb_ld(unsigned* p) { return __hip_atomic_load(p, __ATOMIC_RELAXED, __HIP_MEMORY_SCOPE_AGENT); }
DI unsigned xb_add(unsigned* p, unsigned v) { return __hip_atomic_fetch_add(p, v, __ATOMIC_RELAXED, __HIP_MEMORY_SCOPE_AGENT); }
DI unsigned xb_xcc_id() { return (unsigned)__builtin_amdgcn_s_getreg((3 << 11) | 20) & 0xFu; }
#define XB_SPIN(cond, bar) do { unsigned _sp = 0; while (cond) { __builtin_amdgcn_s_sleep(1); \
    if ((++_sp & 255u) == 0u) { if (xb_ld(&(bar)[XB_TMO])) break; if (_sp > XB_SPIN_CAP) { atomicAdd(&(bar)[XB_TMO], 1u); break; } } } } while (0)

DI void xcd_barrier_post(unsigned* bar, int tid) {
  if (tid == 0) (void)xb_add(&bar[XB_XCNT(xb_xcc_id())], 1u);
}
DI void xcd_barrier_complete(unsigned* bar, unsigned x, unsigned& nloc, unsigned& nx) {
  const unsigned G = gridDim.x;
  unsigned sum, cnt, mine, sp = 0u;
  for (;;) {
    sum = 0u; cnt = 0u; mine = 0u;
#pragma unroll
    for (unsigned j = 0; j < 16; ++j) { const unsigned c = xb_ld(&bar[XB_XCNT(j)]); sum += c; cnt += (c > 0u) ? 1u : 0u; mine = (j == x) ? c : mine; }
    if (sum == G) break;
    __builtin_amdgcn_s_sleep(1);
    if ((++sp & 255u) == 0u) { if (xb_ld(&bar[XB_TMO])) break; if (sp > XB_SPIN_CAP) { atomicAdd(&bar[XB_TMO], 1u); break; } }
  }
  nloc = mine > 0u ? mine : 1u; nx = cnt > 0u ? cnt : 1u;
}
DI void xcd_barrier(unsigned* bar, volatile unsigned* st, int tid) {
  asm volatile("s_waitcnt vmcnt(0)" ::: "memory");
  __syncthreads();
  if (tid == 0) {
    const unsigned x = xb_xcc_id();
    __builtin_amdgcn_s_waitcnt(0);
    unsigned nloc = st[0], nx = st[1];
    if (nloc == 0u) { xcd_barrier_complete(bar, x, nloc, nx); st[0] = nloc; st[1] = nx; }
    const unsigned old = xb_add(&bar[XB_XSUB(x)], 1u);
    const unsigned gen = old / nloc;
    if (old + 1u == (gen + 1u) * nloc) {
      __builtin_amdgcn_fence(__ATOMIC_RELEASE, "agent");
      asm volatile("s_waitcnt vmcnt(0)" ::: "memory");
      const unsigned og = xb_add(&bar[XB_TOP], 1u);
      const unsigned tg = og / nx;
      if (og + 1u == (tg + 1u) * nx) xb_add(&bar[XB_TOPGEN], 1u);
      else XB_SPIN(xb_ld(&bar[XB_TOPGEN]) == tg, bar);
      __builtin_amdgcn_fence(__ATOMIC_ACQUIRE, "agent");
      xb_add(&bar[XB_XGEN(x)], 1u);
      asm volatile("s_waitcnt vmcnt(0)" ::: "memory");
    } else {
      XB_SPIN(xb_ld(&bar[XB_XGEN(x)]) == gen, bar);
      __builtin_amdgcn_fence(__ATOMIC_ACQUIRE, "agent");
      asm volatile("s_waitcnt vmcnt(0)" ::: "memory");
    }
  }
  __syncthreads();
}

DI void rows4(const bfraw* base, long ld, int row0, int tid, const bfraw* (&out)[4]) {
  const int r0 = (tid & 255) >> 2, c8 = ((tid & 3) ^ swz4(tid >> 4)) * 8;
#pragma unroll
  for (int i = 0; i < 4; ++i) out[i] = base + (long)(row0 + i * 64 + r0) * ld + c8;
}
DI void gemm_stage(const bfraw* const (&ap)[4], const bfraw* const (&bp)[4], int k0, char* st, int tid) {
  const int t = tid & 255;
#pragma unroll
  for (int i = 0; i < 4; ++i) {
    glds16(ap[i] + k0, st + (i * 256 + t) * 16);
    glds16(bp[i] + k0, st + 16384 + (i * 256 + t) * 16);
  }
}

template <bool SWAP, int VAR = 0, class Epi>
DI void gemm_tile(const bfraw* const (&ap)[4], const bfraw* const (&bp)[4], int K, char* lds, int tid, Epi epi) {
  asm volatile("" : "+v"(tid));
  const int w = tid >> 6, lane = tid & 63, wr = w >> 2, wc = w & 3, fr = lane & 15, fq = lane >> 4;
  const bool loader = w < 4;
  f32x4 acc[8][4];
#pragma unroll
  for (int m = 0; m < 8; ++m)
#pragma unroll
    for (int n = 0; n < 4; ++n) acc[m][n] = f32x4{0.f, 0.f, 0.f, 0.f};
  const int ns = K >> 5;
  __syncthreads();
  if (loader) {
    gemm_stage(ap, bp, 0, lds, tid);
    gemm_stage(ap, bp, 32, lds + 32768, tid);
    gemm_stage(ap, bp, 64, lds + 65536, tid);
  }
  asm volatile("s_waitcnt vmcnt(16)" ::: "memory");
  __builtin_amdgcn_s_barrier();
  asm volatile("" ::: "memory");
  const int aoff = (wr * 128 + fr) * 64 + (fq ^ swz4(fr >> 2)) * 16;
  const int boff = 16384 + (wc * 64 + fr) * 64 + (fq ^ swz4(fr >> 2)) * 16;
  const int t = tid & 255;
#pragma unroll 1
  for (int j = 0; j < ns; ++j) {
    const char* st = lds + (j & 3) * 32768;
    bf16x8 bfr[4], af[8];
#pragma unroll
    for (int n = 0; n < 4; ++n) bfr[n] = *(const bf16x8*)(st + boff + n * 1024);
#pragma unroll
    for (int m = 0; m < 8; ++m) af[m] = *(const bf16x8*)(st + aoff + m * 1024);
    if (j + 1 < ns) {
      if (j + 2 < ns) asm volatile("s_waitcnt vmcnt(8)" ::: "memory");
      else asm volatile("s_waitcnt vmcnt(0)" ::: "memory");
      __builtin_amdgcn_s_barrier();
      asm volatile("" ::: "memory");
    }
    const bool issue = loader && (j + 3 < ns);
    char* nst = lds + ((j + 3) & 3) * 32768;
    const int nk0 = (j + 3) * 32;
#pragma unroll
    for (int c = 0; c < 4; ++c) {
#pragma unroll
      for (int m = 2 * c; m < 2 * c + 2; ++m)
#pragma unroll
        for (int n = 0; n < 4; ++n) acc[m][n] = SWAP ? mfma16(bfr[n], af[m], acc[m][n]) : mfma16(af[m], bfr[n], acc[m][n]);
      __builtin_amdgcn_sched_barrier(0);
      if (issue) {
        glds16(ap[c] + nk0, nst + (c * 256 + t) * 16);
        glds16(bp[c] + nk0, nst + 16384 + (c * 256 + t) * 16);
      }
      __builtin_amdgcn_sched_barrier(0);
    }
  }
  epi(acc, wr, wc, fr, fq);
}

DI void attn_stage(const bfraw* Kp, const bfraw* VTp, int ldv, int tile, char* st, int tid) {
  const int slot0 = tile * 64;
  const int h = tid >> 8, r = (tid & 255) >> 2;
  const int ck = ((tid & 3) ^ swz4(r >> 3)) * 8;
  const int cv = ((tid & 3) ^ swz4(r >> 2)) * 8;
  glds16(Kp + (long)(slot0 + r) * 64 + h * 32 + ck, st + tid * 16);
  glds16(VTp + (long)r * ldv + slot0 + h * 32 + cv, st + 8192 + tid * 16);
}

template <bool WINDOW>
DI void attn_item(const bfraw* Qp, int qstride, const bfraw* Kp, const bfraw* VTp, int ldv, int n1, int tlo, int n2,
                  int qpos0, bool has_sink, float sink_l2, bfraw* Op, int ostride, char* lds, int tid) {
  asm volatile("" : "+v"(tid));
  const int w = tid >> 6, lane = tid & 63, fr = lane & 15, fq = lane >> 4;
  const float scale_l2 = 0.125f * LOG2E;
  bf16x8 qf[2][2];
#pragma unroll
  for (int n = 0; n < 2; ++n)
#pragma unroll
    for (int sd = 0; sd < 2; ++sd)
      qf[n][sd] = *(const bf16x8*)(Qp + (long)(w * 32 + n * 16 + fr) * qstride + sd * 32 + fq * 8);
  float m_run[2];
  f32x4 o[4][2], ol[2];
#pragma unroll
  for (int n = 0; n < 2; ++n) {
    m_run[n] = has_sink ? sink_l2 : -1e30f;
    const float l0 = has_sink ? 1.f : 0.f;
    ol[n] = f32x4{l0, l0, l0, l0};
#pragma unroll
    for (int md = 0; md < 4; ++md) o[md][n] = f32x4{0.f, 0.f, 0.f, 0.f};
  }
  const bf16x8 ones = bf16x8{(short)0x3F80, (short)0x3F80, (short)0x3F80, (short)0x3F80, (short)0x3F80, (short)0x3F80, (short)0x3F80, (short)0x3F80};
  const int nt = n1 + n2;
  __syncthreads();
  attn_stage(Kp, VTp, ldv, (0 < n1) ? 0 : tlo, lds, tid);
#pragma unroll 1
  for (int it = 0; it < nt; ++it) {
    wait_vm0();
    __syncthreads();
    const bool dma_next = it + 1 < nt;
    const int nx_tile = (it + 1 < n1) ? it + 1 : tlo + (it + 1 - n1);
    if (dma_next && w < 4) attn_stage(Kp, VTp, ldv, nx_tile, lds + ((it + 1) & 1) * 16384, tid);
    const char* sK = lds + (it & 1) * 16384;
    const char* sV = sK + 8192;
    f32x4 s[4][2];
#pragma unroll
    for (int m = 0; m < 4; ++m)
#pragma unroll
      for (int n = 0; n < 2; ++n) s[m][n] = f32x4{0.f, 0.f, 0.f, 0.f};
#pragma unroll
    for (int sd = 0; sd < 2; ++sd) {
#pragma unroll
      for (int m = 0; m < 4; ++m) {
        const int krow = (m >> 1) * 32 + (fr >> 2) * 8 + (m & 1) * 4 + (fr & 3);
        bf16x8 kf = *(const bf16x8*)(sK + sd * 4096 + krow * 64 + (fq ^ swz4(fr >> 2)) * 16);
#pragma unroll
        for (int n = 0; n < 2; ++n) s[m][n] = mfma16(kf, qf[n][sd], s[m][n]);
      }
    }
    if (dma_next && w >= 4) attn_stage(Kp, VTp, ldv, nx_tile, lds + ((it + 1) & 1) * 16384, tid);
    const int tile = (it < n1) ? it : tlo + (it - n1);
    const bool domask = WINDOW && (it >= n1);
    float mxs2[2];
#pragma unroll
    for (int n = 0; n < 2; ++n) {
      if (domask) {
        const int qpos = qpos0 + w * 32 + n * 16 + fr;
#pragma unroll
        for (int m = 0; m < 4; ++m)
#pragma unroll
          for (int j = 0; j < 4; ++j) {
            const int kpos = tile * 64 - CTX + (m >> 1) * 32 + fq * 8 + (m & 1) * 4 + j;
            const int d = qpos - kpos;
            if (d > 128 || d < -128) s[m][n][j] = -1e30f;
          }
      }
      float mx = -1e30f;
#pragma unroll
      for (int m = 0; m < 4; ++m) {
        mx = fmaxf(mx, fmaxf(s[m][n][0], s[m][n][1]));
        mx = fmaxf(mx, fmaxf(s[m][n][2], s[m][n][3]));
      }
      mxs2[n] = mx;
    }
    {
      const float t0 = __shfl_xor(mxs2[0], 16), t1 = __shfl_xor(mxs2[1], 16);
      mxs2[0] = fmaxf(mxs2[0], t0); mxs2[1] = fmaxf(mxs2[1], t1);
      const float u0 = __shfl_xor(mxs2[0], 32), u1 = __shfl_xor(mxs2[1], 32);
      mxs2[0] = fmaxf(mxs2[0], u0) * scale_l2; mxs2[1] = fmaxf(mxs2[1], u1) * scale_l2;
    }
    if (__any((mxs2[0] > m_run[0] + 8.f) || (mxs2[1] > m_run[1] + 8.f))) {
#pragma unroll
      for (int n = 0; n < 2; ++n) {
        const bool need = mxs2[n] > m_run[n] + 8.f;
        const float m_new = need ? mxs2[n] : m_run[n];
        const float alpha = __builtin_amdgcn_exp2f(m_run[n] - m_new);
        m_run[n] = m_new;
        ol[n][0] *= alpha; ol[n][1] *= alpha; ol[n][2] *= alpha; ol[n][3] *= alpha;
#pragma unroll
        for (int md = 0; md < 4; ++md) {
          o[md][n][0] *= alpha; o[md][n][1] *= alpha; o[md][n][2] *= alpha; o[md][n][3] *= alpha;
        }
      }
    }
#pragma unroll
    for (int n = 0; n < 2; ++n) {
      const float nm = -m_run[n];
#pragma unroll
      for (int m = 0; m < 4; ++m)
#pragma unroll
        for (int j = 0; j < 4; ++j) s[m][n][j] = __builtin_amdgcn_exp2f(__builtin_fmaf(s[m][n][j], scale_l2, nm));
    }
#pragma unroll
    for (int ks = 0; ks < 2; ++ks) {
      bf16x8 pf[2];
#pragma unroll
      for (int n = 0; n < 2; ++n) {
        const unsigned u0 = pack2(s[2 * ks][n][0], s[2 * ks][n][1]);
        const unsigned u1 = pack2(s[2 * ks][n][2], s[2 * ks][n][3]);
        const unsigned u2 = pack2(s[2 * ks + 1][n][0], s[2 * ks + 1][n][1]);
        const unsigned u3 = pack2(s[2 * ks + 1][n][2], s[2 * ks + 1][n][3]);
        const uint4 uu = make_uint4(u0, u1, u2, u3);
        pf[n] = __builtin_bit_cast(bf16x8, uu);
      }
#pragma unroll
      for (int md = 0; md < 4; ++md) {
        bf16x8 vf = *(const bf16x8*)(sV + ks * 4096 + (md * 16 + fr) * 64 + (fq ^ swz4(fr >> 2)) * 16);
#pragma unroll
        for (int n = 0; n < 2; ++n) o[md][n] = mfma16(vf, pf[n], o[md][n]);
      }
#pragma unroll
      for (int n = 0; n < 2; ++n) ol[n] = mfma16(ones, pf[n], ol[n]);
    }
  }
#pragma unroll
  for (int n = 0; n < 2; ++n) {
    const float inv = 1.f / ol[n][0];
    bfraw* orow = Op + (long)(w * 32 + n * 16 + fr) * ostride;
#pragma unroll
    for (int md = 0; md < 4; ++md) {
      uint2 st;
      st.x = pack2(o[md][n][0] * inv, o[md][n][1] * inv);
      st.y = pack2(o[md][n][2] * inv, o[md][n][3] * inv);
      *(uint2*)(orow + md * 16 + fq * 4) = st;
    }
  }
}

DI void xpose_tile(const float* src, long ld_src, bfraw* dst, long ld_dst, int mode, char* lds, int tid) {
  float(*t)[65] = (float(*)[65])lds;
  __syncthreads();
  {
    const int c = tid & 63, r0 = tid >> 6;
#pragma unroll 4
    for (int rr = r0; rr < 64; rr += NWAVE) t[rr][c] = src[(long)rr * ld_src + c];
  }
  __syncthreads();
  {
    const int k8 = (tid & 7) * 8, nn = tid >> 3;
    uint4 v;
    v.x = pack2(t[k8 + 0][nn], t[k8 + 1][nn]);
    v.y = pack2(t[k8 + 2][nn], t[k8 + 3][nn]);
    v.z = pack2(t[k8 + 4][nn], t[k8 + 5][nn]);
    v.w = pack2(t[k8 + 6][nn], t[k8 + 7][nn]);
    const int row = (mode == 0) ? nn : ((nn >> 4) * 32 + (mode == 2 ? 16 : 0) + (nn & 15));
    *(uint4*)(dst + (long)row * ld_dst + k8) = v;
  }
}

DI void xpose256x2(const float* s0, long ls0, bfraw* d0, long ld0, int m0,
                   const float* s1, long ls1, bfraw* d1, long ld1, int m1, bool two, char* lds, int tid) {
  const int w = tid >> 6, lane = tid & 63;
  float4 vA[8], vB[8];
#pragma unroll
  for (int i = 0; i < 8; ++i) {
    const int k = 2 * (w + 8 * (i >> 1)) + (i & 1);
    vA[i] = *(const float4*)(s0 + (long)k * ls0 + lane * 4);
  }
#pragma unroll
  for (int i = 0; i < 8; ++i) {
    const int k = 2 * (w + 8 * (i >> 1)) + (i & 1);
    vB[i] = *(const float4*)(s1 + (long)k * ls1 + lane * 4);
  }
#pragma unroll
  for (int half = 0; half < 2; ++half) {
    if (half == 1 && !two) break;
    __syncthreads();
#pragma unroll
    for (int i2 = 0; i2 < 4; ++i2) {
      const int k = 2 * (w + 8 * i2);
      char* base = lds + (lane * 4) * 136 + k * 2;
      const float4 e0 = half ? vB[2 * i2] : vA[2 * i2], e1 = half ? vB[2 * i2 + 1] : vA[2 * i2 + 1];
      *(unsigned*)(base + 0 * 136) = pack2(e0.x, e1.x);
      *(unsigned*)(base + 1 * 136) = pack2(e0.y, e1.y);
      *(unsigned*)(base + 2 * 136) = pack2(e0.z, e1.z);
      *(unsigned*)(base + 3 * 136) = pack2(e0.w, e1.w);
    }
    __syncthreads();
    bfraw* dst = half ? d1 : d0;
    const long ld_dst = half ? ld1 : ld0;
    const int mode = half ? m1 : m0;
#pragma unroll
    for (int q = 0; q < 4; ++q) {
      const int c = tid + NTHR * q;
      const int n = c >> 3, k8 = (c & 7) * 8;
      const uint2 lo = *(const uint2*)(lds + n * 136 + k8 * 2);
      const uint2 hi = *(const uint2*)(lds + n * 136 + k8 * 2 + 8);
      const int row = (mode == 0) ? n : ((n >> 4) * 32 + (mode == 2 ? 16 : 0) + (n & 15));
      *(uint4*)(dst + (long)row * ld_dst + k8) = make_uint4(lo.x, lo.y, hi.x, hi.y);
    }
  }
}

constexpr int N_EXPCONV = 4096 + 2048;
DI void expconv_decode(const Params& p, int layer, int item, const float*& src, long& ld_src, bfraw*& dst, long& ld_dst, int& mode) {
  bfraw* WGU = (bfraw*)(p.ws + O_WGU);
  bfraw* WD = (bfraw*)(p.ws + O_WD);
  if (item < 4096) {
    const int type = item & 1;
    int r = item >> 1;
    const int nt = r & 7; r >>= 3;
    const int kt = r & 15; const int e = r >> 4;
    src = (type ? p.w_up : p.w_gate) + ((long)(layer * NE + e) * DM + kt * 64) * FF + nt * 256;
    ld_src = FF;
    dst = WGU + ((long)e * 4096 + nt * 512) * DM + kt * 64;
    ld_dst = DM; mode = 1 + type;
  } else {
    int r = item - 4096;
    const int nt = r & 3; r >>= 2;
    const int kt = r & 31; const int e = r >> 5;
    src = p.w_down + ((long)(layer * NE + e) * FF + kt * 64) * DM + nt * 256;
    ld_src = DM;
    dst = WD + ((long)e * DM + nt * 256) * FF + kt * 64;
    ld_dst = FF; mode = 0;
  }
}
DI void expconv_pair(const Params& p, int layer, int i0, int i1, char* lds, int tid) {
  const float *s0, *s1; long ls0, ls1, ld0, ld1; bfraw *d0, *d1; int m0, m1;
  expconv_decode(p, layer, i0, s0, ls0, d0, ld0, m0);
  expconv_decode(p, layer, (i1 >= 0) ? i1 : i0, s1, ls1, d1, ld1, m1);
  xpose256x2(s0, ls0, d0, ld0, m0, s1, ls1, d1, ld1, m1, i1 >= 0, lds, tid);
}

DI void prep_mod_item(const Params& p, int item, char* lds, int tid) {
  const int layer = item / 96, chunk = item % 96;
  float* sc = (float*)lds;
  float* red = (float*)(lds + 36864);
  __syncthreads();
  for (int idx = tid; idx < 9 * 1024; idx += NTHR) {
    const int r = idx >> 10, k = idx & 1023;
    const float v = (r < 8) ? p.c[r * 1024 + k] : p.c_ctx[k];
    sc[idx] = v / (1.f + __expf(-v));
  }
  __syncthreads();
  const int w = tid >> 6, lane = tid & 63;
  const int col = chunk * 64 + lane;
  float acc[9];
#pragma unroll
  for (int r = 0; r < 9; ++r) acc[r] = 0.f;
  const float* wp = p.w_mod + ((long)layer * 1024 + w * 128) * 6144 + col;
#pragma unroll 16
  for (int k = 0; k < 128; ++k) {
    const float wv = wp[(long)k * 6144];
#pragma unroll
    for (int r = 0; r < 9; ++r) acc[r] += sc[r * 1024 + w * 128 + k] * wv;
  }
#pragma unroll
  for (int r = 0; r < 9; ++r) red[(w * 9 + r) * 64 + lane] = acc[r];
  __syncthreads();
  float* MOD = (float*)(p.ws + O_MOD);
  for (int idx = tid; idx < 9 * 64; idx += NTHR) {
    const int r = idx >> 6, l = idx & 63;
    float s = p.b_mod[layer * 6144 + chunk * 64 + l];
#pragma unroll
    for (int ww = 0; ww < NWAVE; ++ww) s += red[(ww * 9 + r) * 64 + l];
    MOD[(layer * 9 + r) * 6144 + chunk * 64 + l] = s;
  }
}

DI void prep_four_item(const Params& p, int item, char* lds, int tid) {
  const int layer = item >> 6, g = (item >> 4) & 3, kt = item & 15;
  float* G = (float*)lds;
  float(*Wt)[65] = (float(*)[65])(lds + 32768);
  float* ctab = (float*)(lds + 32768 + 64 * 65 * 4);
  __syncthreads();
  const float* wg = p.w_four + (long)(layer * 4 + g) * 4096;
  for (int idx = tid; idx < 4096; idx += NTHR) Wt[idx >> 6][idx & 63] = wg[idx];
  if (tid < 64) {
    float sn, cs;
    sincospif((float)tid / 32.f, &sn, &cs);
    ctab[tid] = cs;
    ctab[64 + tid] = sn;
  }
  __syncthreads();
  for (int o = tid; o < 4096; o += NTHR) {
    const int c = o >> 6, d = o & 63;
    float s1 = 0.f, s2 = 0.f;
#pragma unroll 4
    for (int c2 = 0; c2 < 64; ++c2) {
      const int a = (c * c2) & 63;
      const float wv = Wt[c2][d];
      s1 += ctab[a] * wv;
      s2 += ctab[64 + a] * wv;
    }
    G[o] = s1;
    G[4096 + o] = s2;
  }
  __syncthreads();
  const float* wi = p.w_in + ((long)layer * 1024 + kt * 64) * 1536 + 768 + g * 64;
  for (int idx = tid; idx < 4096; idx += NTHR) Wt[idx >> 6][idx & 63] = wi[(long)(idx >> 6) * 1536 + (idx & 63)];
  __syncthreads();
  bfraw* WINT = (bfraw*)(p.ws + O_WINT) + (long)layer * NPROJ * 1024;
  for (int o = tid; o < 64 * 128; o += NTHR) {
    const int kk = o & 63, dcol = o >> 6;
    const float* Gs = G + (dcol >> 6) * 4096 + (dcol & 63);
    float s = 0.f;
#pragma unroll 4
    for (int c = 0; c < 64; ++c) s += Wt[kk][c] * Gs[c * 64];
    const int row = (dcol < 64) ? (768 + g * 64 + dcol) : (1024 + g * 64 + (dcol - 64));
    WINT[(long)row * 1024 + kt * 64 + kk] = f2bf(s);
  }
}

constexpr int P0_MOD = 192, P0_FOUR = 128, P0_ROPE = 1, P0_DFTC = 256, P0_DFT = 4096, P0_WIN = 2 * 16 * 24, P0_WOUT = 2 * 16 * 16;
constexpr int P0_TOTAL = P0_MOD + P0_FOUR + P0_ROPE + P0_DFTC + P0_DFT + P0_WIN + P0_WOUT + N_EXPCONV;

DI void phase_prep(const Params& p, char* lds, int tid) {
  if (blockIdx.x == 0) { ((unsigned*)(p.ws + O_CTR))[tid] = 0u; ((unsigned*)(p.ws + O_CTR))[NTHR + tid] = 0u; }
  if (blockIdx.x == 0) { unsigned* bw = (unsigned*)(p.ws + O_BAR); for (int i = tid; i < XCD_BAR_WORDS; i += NTHR) bw[i] = 0u; }
  constexpr int P0_BASE = P0_TOTAL - N_EXPCONV;
  for (int item = blockIdx.x; item < P0_BASE; item += gridDim.x) {
    int it = item;
    if (it < P0_MOD) { prep_mod_item(p, it, lds, tid); continue; }
    it -= P0_MOD;
    if (it < P0_FOUR) { prep_four_item(p, it, lds, tid); continue; }
    it -= P0_FOUR;
    if (it < P0_ROPE) {
      float* rope = (float*)(p.ws + O_ROPE);
      for (int idx = tid; idx < 1024; idx += NTHR) {
        const int pos = idx >> 4, f = idx & 15;
        const float inv_freq = powf(10000.f, -(float)f / 16.f);
        const float ang = (float)pos * inv_freq;
        rope[idx] = cosf(ang);
        rope[1024 + idx] = sinf(ang);
      }
      continue;
    }
    it -= P0_ROPE;
    if (it < P0_DFTC) {
      bfraw* D = (bfraw*)(p.ws + O_DFTC) + (long)it * 512;
      for (int k = tid; k < 512; k += NTHR) {
        const int kk = k & 255;
        float sn, cs;
        sincospif((float)((it * kk) & 255) / 128.f, &sn, &cs);
        D[k] = f2bf(k < 256 ? cs : -sn);
      }
      continue;
    }
    it -= P0_DFTC;
    if (it < P0_DFT) {
      const int t = it & 2047;
      bfraw* D = (bfraw*)(p.ws + O_DFT) + (long)it * 4096;
      for (int ch = tid; ch < 2048; ch += NTHR) {
        const int k = ch * 2;
        float sn0, cs0, sn1, cs1;
        sincospif((float)((t * k) & 4095) / 2048.f, &sn0, &cs0);
        sincospif((float)((t * (k + 1)) & 4095) / 2048.f, &sn1, &cs1);
        *(unsigned*)(D + k) = (it < 2048) ? pack2(cs0, cs1) : pack2(sn0, sn1);
      }
      continue;
    }
    it -= P0_DFT;
    if (it < P0_WIN) {
      const int layer = it / 384, r = it % 384, kt = r / 24, nt = r % 24;
      if (nt >= 12 && nt < 16) continue;
      const int col = nt * 64;
      int drow;
      if (col < 768) drow = col;
      else if (col < 1152) drow = col + 256;
      else if (col < 1280) drow = col + 384;
      else if (col < 1408) drow = col + 128;
      else drow = col + 256;
      const float* src = p.w_in + ((long)layer * 1024 + kt * 64) * 1536 + col;
      bfraw* dst = (bfraw*)(p.ws + O_WINT) + ((long)layer * NPROJ + drow) * 1024 + kt * 64;
      xpose_tile(src, 1536, dst, 1024, 0, lds, tid);
      continue;
    }
    it -= P0_WIN;
    if (it < P0_WOUT) {
      const int layer = it >> 8, r = it & 255, kt = r >> 4, nt = r & 15;
      const float* src = p.w_out + ((long)layer * 1024 + kt * 64) * 1024 + nt * 64;
      bfraw* dst = (bfraw*)(p.ws + O_WOUTT) + ((long)layer * 1024 + nt * 64) * 1024 + kt * 64;
      xpose_tile(src, 1024, dst, 1024, 0, lds, tid);
      continue;
    }
  }
  for (int i0 = blockIdx.x; i0 < N_EXPCONV; i0 += 2 * gridDim.x) {
    const int i1 = i0 + gridDim.x;
    expconv_pair(p, 0, i0, (i1 < N_EXPCONV) ? i1 : -1, lds, tid);
  }
}

DI void ln_stats(const float v[16], float& mean, float& rstd) {
  float s = 0.f;
#pragma unroll
  for (int i = 0; i < 16; ++i) s += v[i];
  mean = wsum(s) * (1.f / 1024.f);
  float q = 0.f;
#pragma unroll
  for (int i = 0; i < 16; ++i) { const float d = v[i] - mean; q += d * d; }
  rstd = rsqrtf(wsum(q) * (1.f / 1024.f) + 1e-5f);
}
DI void load_row16(const float* src, int lane, float v[16]) {
#pragma unroll
  for (int i = 0; i < 4; ++i) {
    const float4 t = *(const float4*)(src + i * 256 + lane * 4);
    v[i * 4 + 0] = t.x; v[i * 4 + 1] = t.y; v[i * 4 + 2] = t.z; v[i * 4 + 3] = t.w;
  }
}
DI void store_row16(float* dst, int lane, const float v[16]) {
#pragma unroll
  for (int i = 0; i < 4; ++i) *(float4*)(dst + i * 256 + lane * 4) = make_float4(v[i * 4], v[i * 4 + 1], v[i * 4 + 2], v[i * 4 + 3]);
}
DI void store_row16_bf(bfraw* dst, int lane, const float v[16]) {
#pragma unroll
  for (int i = 0; i < 4; ++i) {
    uint2 st;
    st.x = pack2(v[i * 4], v[i * 4 + 1]);
    st.y = pack2(v[i * 4 + 2], v[i * 4 + 3]);
    *(uint2*)(dst + i * 256 + lane * 4) = st;
  }
}
DI void modulate16(float v[16], const float* sh, const float* sc, int lane) {
  float mean, rstd;
  ln_stats(v, mean, rstd);
  float a[16], b[16];
  load_row16(sh, lane, a);
  load_row16(sc, lane, b);
#pragma unroll
  for (int i = 0; i < 16; ++i) v[i] = (v[i] - mean) * rstd * (1.f + b[i]) + a[i];
}
DI void postnorm16(float v[16], const float* g, const float* bb, int lane) {
  float mean, rstd;
  ln_stats(v, mean, rstd);
  float a[16], b[16];
  load_row16(g, lane, a);
  load_row16(bb, lane, b);
#pragma unroll
  for (int i = 0; i < 16; ++i) v[i] = (v[i] - mean) * rstd * a[i] + b[i];
}

DI void phase_lnmod0(const Params& p, int tid) {
  const int w = tid >> 6, lane = tid & 63;
  const float* MOD = (const float*)(p.ws + O_MOD);
  const int stride = gridDim.x * NWAVE;
  int row = blockIdx.x * NWAVE + w;
  float nv[16];
  if (row < NT + NCT) load_row16((row < NT) ? p.x + (long)row * 1024 : p.ctx + (long)(row - NT) * 1024, lane, nv);
#pragma unroll 1
  for (; row < NT + NCT; row += stride) {
    float v[16];
#pragma unroll
    for (int i = 0; i < 16; ++i) v[i] = nv[i];
    const int nrow = row + stride;
    if (nrow < NT + NCT) load_row16((nrow < NT) ? p.x + (long)nrow * 1024 : p.ctx + (long)(nrow - NT) * 1024, lane, nv);
    if (row < NT) {
      const float* mr = MOD + (0 * 9 + row / SEQ) * 6144;
      modulate16(v, mr, mr + 1024, lane);
      store_row16_bf((bfraw*)(p.ws + O_H) + (long)row * 1024, lane, v);
    } else {
      const int rc = row - NT;
      const float* mr = MOD + (0 * 9 + 8) * 6144;
      modulate16(v, mr, mr + 1024, lane);
      store_row16_bf((bfraw*)(p.ws + O_HC) + (long)rc * 1024, lane, v);
    }
  }
}

DI void proj_item(const Params& p, int layer, bool is_ctx, int rt, int ct, char* lds, int tid) {
  const int T = is_ctx ? CTX : SEQ;
  const bfraw* Hs = (const bfraw*)(p.ws + (is_ctx ? O_HC : O_H));
  const bfraw* W = (const bfraw*)(p.ws + O_WINT) + (long)layer * NPROJ * 1024;
  const bfraw *ap[4], *bp[4];
  rows4(Hs, 1024, rt * 256, tid, ap);
  rows4(W, 1024, ct * 256, tid, bp);
  char* ws = p.ws;
  if (ct <= 2 || ct == 5) {
    const float* rope = (const float*)(ws + O_ROPE);
    gemm_tile<true>(ap, bp, 1024, lds, tid, [&](f32x4 (&acc)[8][4], int wr, int wc, int fr, int fq) {
      const int rowbase = rt * 256 + wr * 128;
      const int b = rowbase / T;
      const int tbase = rowbase - b * T;
      const bool donorm = (ct < 2) || (ct == 5 && wc < 2);
      const float* gn = ((ct < 2) ? p.q_norm : p.k_norm) + layer * 64;
      bfraw* dst;
      long rstride;
      if (ct < 2) { dst = (bfraw*)(ws + (is_ctx ? O_QAC : O_QA)) + ((long)rowbase * 8 + (ct * 4 + wc)) * 64; rstride = 512; }
      else if (ct == 2) { dst = (bfraw*)(ws + (is_ctx ? O_QCC : O_QC)) + ((long)rowbase * 4 + wc) * 64; rstride = 256; }
      else {
        const int slot0 = is_ctx ? tbase : CTX + tbase;
        dst = (bfraw*)(ws + (wc < 2 ? O_KA : O_KC)) + ((long)(b * 2 + (wc & 1)) * KS + slot0) * 64; rstride = 64;
      }
#pragma unroll
      for (int m = 0; m < 8; ++m) {
        const int rl = m * 16 + fr;
        float rs = 1.f;
        if (donorm) {
          float ss = 0.f;
#pragma unroll
          for (int n = 0; n < 4; ++n)
#pragma unroll
            for (int j = 0; j < 4; ++j) ss += acc[m][n][j] * acc[m][n][j];
          ss += __shfl_xor(ss, 16);
          ss += __shfl_xor(ss, 32);
          rs = rsqrtf(ss * (1.f / 64.f) + 1e-6f);
        }
        float xv[4][4];
        const float* gp = gn;
        asm volatile("" : "+s"(gp));
#pragma unroll
        for (int n = 0; n < 4; ++n) {
          if (donorm) {
            const float4 t = *(const float4*)(gp + n * 16 + fq * 4);
            xv[n][0] = acc[m][n][0] * rs * t.x; xv[n][1] = acc[m][n][1] * rs * t.y;
            xv[n][2] = acc[m][n][2] * rs * t.z; xv[n][3] = acc[m][n][3] * rs * t.w;
          } else {
            xv[n][0] = acc[m][n][0]; xv[n][1] = acc[m][n][1]; xv[n][2] = acc[m][n][2]; xv[n][3] = acc[m][n][3];
          }
        }
        if (!is_ctx) {
          const int t = tbase + rl;
          const int pr = t >> 6, pc = t & 63;
          const float4 c0 = *(const float4*)(rope + pr * 16 + fq * 4), s0 = *(const float4*)(rope + 1024 + pr * 16 + fq * 4);
          const float4 c1 = *(const float4*)(rope + pc * 16 + fq * 4), s1 = *(const float4*)(rope + 1024 + pc * 16 + fq * 4);
          const float c0a[4] = {c0.x, c0.y, c0.z, c0.w}, s0a[4] = {s0.x, s0.y, s0.z, s0.w};
          const float c1a[4] = {c1.x, c1.y, c1.z, c1.w}, s1a[4] = {s1.x, s1.y, s1.z, s1.w};
#pragma unroll
          for (int j = 0; j < 4; ++j) {
            const float y0 = xv[0][j] * c0a[j] - xv[1][j] * s0a[j], y1 = xv[1][j] * c0a[j] + xv[0][j] * s0a[j];
            const float y2 = xv[2][j] * c1a[j] - xv[3][j] * s1a[j], y3 = xv[3][j] * c1a[j] + xv[2][j] * s1a[j];
            xv[0][j] = y0; xv[1][j] = y1; xv[2][j] = y2; xv[3][j] = y3;
          }
        }
        bfraw* d = dst + (long)rl * rstride + fq * 4;
#pragma unroll
        for (int n = 0; n < 4; ++n) {
          uint2 st;
          st.x = pack2(xv[n][0], xv[n][1]);
          st.y = pack2(xv[n][2], xv[n][3]);
          *(uint2*)(d + n * 16) = st;
        }
      }
    });
  } else {
    gemm_tile<false>(ap, bp, 1024, lds, tid, [&](f32x4 (&acc)[8][4], int wr, int wc, int fr, int fq) {
      const int rowbase = rt * 256 + wr * 128;
      const int b = rowbase / T;
      const int tbase = rowbase - b * T;
      bfraw* dst;
      long cstride;
      if (ct == 6) {
        const int slot0 = is_ctx ? tbase : CTX + tbase;
        dst = (bfraw*)(ws + (wc < 2 ? O_VAT : O_VCT)) + (long)(b * 2 + (wc & 1)) * 64 * KS + slot0;
        cstride = KS;
      } else {
        const int ncol0 = wc * 64;
        const int koff = (ct == 4) ? T : 0;
        if (is_ctx) { dst = (bfraw*)(ws + O_VTFC) + ((long)b * 256 + ncol0) * 512 + koff + tbase; cstride = 512; }
        else { dst = (bfraw*)(ws + O_VTF) + ((long)b * 256 + ncol0) * 8192 + koff + tbase; cstride = 8192; }
      }
#pragma unroll
      for (int m = 0; m < 8; ++m)
#pragma unroll
        for (int n = 0; n < 4; ++n) {
          uint2 st;
          st.x = pack2(acc[m][n][0], acc[m][n][1]);
          st.y = pack2(acc[m][n][2], acc[m][n][3]);
          *(uint2*)(dst + (long)(n * 16 + fr) * cstride + m * 16 + fq * 4) = st;
        }
    });
  }
}

DI void phase_proj(const Params& p, int layer, unsigned* ctr, int* s_item, char* lds, int tid) {
  const int nct_ctx = (layer == 0) ? 7 : 2;
  const int n_per = 112 + nct_ctx;
  XQ q{0, 0, 0, -1};
  while (next_item_s(n_per, tid, q)) {
    const int x = q.list, i = q.idx;
    if (i < 112) proj_item(p, layer, false, 16 * x + i / 7, i % 7, lds, tid);
    else proj_item(p, layer, true, x, (layer == 0) ? (i - 112) : (5 + i - 112), lds, tid);
  }
}

DI void four_item(const Params& p, int layer, bool is_ctx, int b, int rt, char* lds, int tid) {
  const int T = is_ctx ? CTX : SEQ;
  const int K = 2 * T;
  const bfraw* A = (const bfraw*)(p.ws + (is_ctx ? O_DFTC : O_DFT));
  const bfraw* Bt = (const bfraw*)(p.ws + (is_ctx ? O_VTFC : O_VTF)) + (long)b * 256 * K;
  const bfraw *ap[4], *bp[4];
  rows4(A, K, rt * 256, tid, ap);
  rows4(Bt, K, 0, tid, bp);
  bfraw* MIX = (bfraw*)(p.ws + (is_ctx ? O_MIXC : O_MIX)) + (long)b * T * 1024;
  const float scale = is_ctx ? (1.f / 128.f) : (1.f / 512.f);
  const float* bias = p.b_four + layer * 256;
  gemm_tile<true>(ap, bp, K, lds, tid, [&](f32x4 (&acc)[8][4], int wr, int wc, int fr, int fq) {
#pragma unroll
    for (int n = 0; n < 4; ++n) {
      const int ncol = wc * 64 + n * 16 + fq * 4;
      const float4 bv = *(const float4*)(bias + ncol);
#pragma unroll
      for (int m = 0; m < 8; ++m) {
        const int t = rt * 256 + wr * 128 + m * 16 + fr;
        uint2 st;
        st.x = pack2(acc[m][n][0] * scale + bv.x, acc[m][n][1] * scale + bv.y);
        st.y = pack2(acc[m][n][2] * scale + bv.z, acc[m][n][3] * scale + bv.w);
        *(uint2*)(MIX + (long)t * 1024 + 512 + ncol) = st;
      }
    }
  });
}

DI void four_lat_item(const Params& p, int layer, int b, int rt, char* lds, int tid) {
  const bfraw* Cm = (const bfraw*)(p.ws + O_DFT);
  const bfraw* Sm = Cm + 2048l * 4096;
  const bfraw* Bt = (const bfraw*)(p.ws + O_VTF) + (long)b * 256 * 8192;
  float4* scr = (float4*)(p.ws + O_PSCR) + (long)(b * 8 + rt) * 16384;
  bfraw* MIX = (bfraw*)(p.ws + O_MIX) + (long)b * SEQ * 1024;
  const float scale = 1.f / 512.f;
  const float* bias = p.b_four + layer * 256;
  {
    const bfraw *ap[4], *bp[4];
    rows4(Cm, 4096, rt * 256, tid, ap);
    rows4(Bt, 8192, 0, tid, bp);
    gemm_tile<true>(ap, bp, 4096, lds, tid, [&](f32x4 (&acc)[8][4], int wr, int wc, int fr, int fq) {
      const int t_ = (wr * 4 + wc) * 64 + fq * 16 + fr;
#pragma unroll
      for (int m = 0; m < 8; ++m)
#pragma unroll
        for (int n = 0; n < 4; ++n)
          scr[(m * 4 + n) * NTHR + t_] = make_float4(acc[m][n][0], acc[m][n][1], acc[m][n][2], acc[m][n][3]);
    });
  }
  {
    const bfraw *ap[4], *bp[4];
    rows4(Sm, 4096, rt * 256, tid, ap);
    rows4(Bt + 4096, 8192, 0, tid, bp);
    gemm_tile<true>(ap, bp, 4096, lds, tid, [&](f32x4 (&acc)[8][4], int wr, int wc, int fr, int fq) {
      const int t_ = (wr * 4 + wc) * 64 + fq * 16 + fr;
#pragma unroll
      for (int n = 0; n < 4; ++n) {
        const int ncol = wc * 64 + n * 16 + fq * 4;
        const float4 bv = *(const float4*)(bias + ncol);
#pragma unroll
        for (int m = 0; m < 8; ++m) {
          const int t = rt * 256 + wr * 128 + m * 16 + fr;
          const float4 P = scr[(m * 4 + n) * NTHR + t_];
          uint2 st;
          st.x = pack2((P.x - acc[m][n][0]) * scale + bv.x, (P.y - acc[m][n][1]) * scale + bv.y);
          st.y = pack2((P.z - acc[m][n][2]) * scale + bv.z, (P.w - acc[m][n][3]) * scale + bv.w);
          *(uint2*)(MIX + (long)t * 1024 + 512 + ncol) = st;
          if (t > 0) {
            st.x = pack2((P.x + acc[m][n][0]) * scale + bv.x, (P.y + acc[m][n][1]) * scale + bv.y);
            st.y = pack2((P.z + acc[m][n][2]) * scale + bv.z, (P.w + acc[m][n][3]) * scale + bv.w);
            *(uint2*)(MIX + (long)(SEQ - t) * 1024 + 512 + ncol) = st;
          }
        }
      }
    });
  }
}

DI void four_mid_item(const Params& p, int layer, int b, int tid) {
  const int n = tid >> 1, half = tid & 1;
  const bfraw* v = (const bfraw*)(p.ws + O_VTF) + ((long)b * 256 + n) * 8192 + half * 2048;
  float s = 0.f;
#pragma unroll 4
  for (int k = 0; k < 2048; k += 8) {
    const uint4 u = *(const uint4*)(v + k);
    s += (bflo(u.x) - bfhi(u.x)) + (bflo(u.y) - bfhi(u.y)) + (bflo(u.z) - bfhi(u.z)) + (bflo(u.w) - bfhi(u.w));
  }
  s += __shfl_xor(s, 1);
  if (half == 0) {
    bfraw* MIX = (bfraw*)(p.ws + O_MIX) + ((long)b * SEQ + SEQ / 2) * 1024;
    MIX[512 + n] = f2bf(s * (1.f / 512.f) + p.b_four[layer * 256 + n]);
  }
}

DI void phase_mix(const Params& p, int layer, unsigned* ctr, int* s_item, char* lds, int tid) {
  char* ws = p.ws;
  const int nF = 9, nA = 128, nC = 64;
  const int nFc = (layer == 0) ? 1 : 0, nAc = (layer == 0) ? 8 : 0, nCc = (layer == 0) ? 4 : 0;
  const int n_per = nF + nA + nC + nFc + nAc + nCc;
  XQ q{0, 0, 0, -1};
  while (next_item_x(ctr, n_per, s_item, tid, q)) {
    const int b = q.list;
    int it = q.idx;
    if (it < 8) { four_lat_item(p, layer, b, it, lds, tid); continue; }
    if (it == 8) { four_mid_item(p, layer, b, tid); continue; }
    it -= nF;
    if (it >= nA + nC && it < nA + nC + nFc) { four_item(p, layer, true, b, 0, lds, tid); continue; }
    int kind, h, qb;
    if (it < nA) { kind = 0; h = it >> 4; qb = it & 15; }
    else if (it < nA + nC) { it -= nA; kind = 1; h = it >> 4; qb = it & 15; }
    else {
      it -= nA + nC + nFc;
      if (it < nAc) { kind = 2; h = it; qb = 0; }
      else { it -= nAc; kind = 3; h = it; qb = 0; }
    }
    const bool isA = (kind == 0 || kind == 2), isctx = (kind >= 2);
    const int nh = isA ? 8 : 4;
    const int kvh = isA ? (h >> 2) : (h >> 1);
    const int T = isctx ? CTX : SEQ;
    const long tok0 = (long)b * T + qb * 256;
    const bfraw* Qp = (const bfraw*)(ws + (isA ? (isctx ? O_QAC : O_QA) : (isctx ? O_QCC : O_QC))) + (tok0 * nh + h) * 64;
    const bfraw* Kp = (const bfraw*)(ws + (isA ? O_KA : O_KC)) + (long)(b * 2 + kvh) * KS * 64;
    const bfraw* Vp = (const bfraw*)(ws + (isA ? O_VAT : O_VCT)) + (long)(b * 2 + kvh) * 64 * KS;
    bfraw* Op = (bfraw*)(ws + (isctx ? O_MIXC : O_MIX)) + tok0 * 1024 + (isA ? 0 : 768) + h * 64;
    const float sk = isA ? 0.f : p.sink[layer * 4 + h] * LOG2E;
    if (kind == 1) {
      const int q0 = qb * 256;
      const int lo = (q0 - 128 < 0) ? 0 : q0 - 128;
      const int hi = (q0 + 384 > SEQ) ? SEQ : q0 + 384;
      attn_item<true>(Qp, 256, Kp, Vp, KS, CTX / 64, (CTX + lo) / 64, (hi - lo) / 64, q0, true, sk, Op, 1024, lds, tid);
    } else {
      attn_item<false>(Qp, nh * 64, Kp, Vp, KS, (kind == 0) ? KS / 64 : CTX / 64, 0, 0, 0, !isA, sk, Op, 1024, lds, tid);
    }
  }
}

DI void phase_outproj(const Params& p, int layer, unsigned* ctr, int* s_item, char* lds, int tid) {
  const int n_lat = 128 * 4, n_ctx = (layer == 0) ? 8 * 4 : 0;
  const bfraw* W = (const bfraw*)(p.ws + O_WOUTT) + (long)layer * 1024 * 1024;
  const float* MOD = (const float*)(p.ws + O_MOD);
  (void)n_lat; (void)n_ctx;
  const int n_per = 64 + ((layer == 0) ? 4 : 0);
  XQ q{0, 0, 0, -1};
  while (next_item_s(n_per, tid, q)) {
    const bool is_ctx = q.idx >= 64;
    const int rt = is_ctx ? q.list : (16 * q.list + (q.idx >> 2));
    const int ct = is_ctx ? (q.idx - 64) : (q.idx & 3);
    const int T = is_ctx ? CTX : SEQ;
    const bfraw* A = (const bfraw*)(p.ws + (is_ctx ? O_MIXC : O_MIX));
    const float* xin = is_ctx ? p.ctx : (layer == 0 ? p.x : p.out);
    float* X1 = (float*)(p.ws + (is_ctx ? O_X1C : O_X1));
    const bfraw *ap[4], *bp[4];
    rows4(A, 1024, rt * 256, tid, ap);
    rows4(W, 1024, ct * 256, tid, bp);
    gemm_tile<true>(ap, bp, 1024, lds, tid, [&](f32x4 (&acc)[8][4], int wr, int wc, int fr, int fq) {
      const int rowbase = rt * 256 + wr * 128;
      const int b = is_ctx ? 8 : rowbase / T;
      const float* g1 = MOD + (layer * 9 + b) * 6144 + 2048;
#pragma unroll
      for (int n = 0; n < 4; ++n) {
        const int col = ct * 256 + wc * 64 + n * 16 + fq * 4;
        const float4 gv = *(const float4*)(g1 + col);
#pragma unroll
        for (int m = 0; m < 8; ++m) {
          const long idx = (long)(rowbase + m * 16 + fr) * 1024 + col;
          const float4 xv = *(const float4*)(xin + idx);
          float4 o;
          o.x = ALPHA * xv.x + gv.x * acc[m][n][0];
          o.y = ALPHA * xv.y + gv.y * acc[m][n][1];
          o.z = ALPHA * xv.z + gv.z * acc[m][n][2];
          o.w = ALPHA * xv.w + gv.w * acc[m][n][3];
          *(float4*)(X1 + idx) = o;
        }
      }
    });
  }
}

DI void phase_row(const Params& p, int layer, char* lds, int tid) {
  const int w = tid >> 6, lane = tid & 63;
  float* wrl = (float*)lds;
  __syncthreads();
  {
    const float* wr = p.w_router + (long)layer * 1024 * 16;
    for (int idx = tid; idx < 16384; idx += NTHR) wrl[(idx & 15) * 1024 + (idx >> 4)] = wr[idx];
  }
  __syncthreads();
  const float* MOD = (const float*)(p.ws + O_MOD);
  const int nrows = NT + ((layer == 0) ? NCT : 0);
  const int stride = gridDim.x * NWAVE;
  int row = blockIdx.x * NWAVE + w;
  float nv[16];
  if (row < nrows) {
    const bool c = row >= NT;
    load_row16((const float*)(p.ws + (c ? O_X1C : O_X1)) + (long)(c ? row - NT : row) * 1024, lane, nv);
  }
#pragma unroll 1
  for (; row < nrows; row += stride) {
    const bool is_ctx = row >= NT;
    const int rr = is_ctx ? row - NT : row;
    float* X1 = (float*)(p.ws + (is_ctx ? O_X1C : O_X1)) + (long)rr * 1024;
    bfraw* Hd = (bfraw*)(p.ws + (is_ctx ? O_HC : O_H)) + (long)rr * 1024;
    const int T = is_ctx ? CTX : SEQ;
    const int b = rr / T, t = rr - b * T;
    const float* mr = MOD + (layer * 9 + (is_ctx ? 8 : b)) * 6144;
    float v[16];
#pragma unroll
    for (int i = 0; i < 16; ++i) v[i] = nv[i];
    if (row + stride < nrows) {
      const int nrow = row + stride;
      const bool c = nrow >= NT;
      load_row16((const float*)(p.ws + (c ? O_X1C : O_X1)) + (long)(c ? nrow - NT : nrow) * 1024, lane, nv);
    }
    postnorm16(v, p.ln1_g + layer * 1024, p.ln1_b + layer * 1024, lane);
    store_row16(X1, lane, v);
    modulate16(v, mr + 3072, mr + 4096, lane);
    store_row16_bf(Hd, lane, v);
    float pr[16];
#pragma unroll
    for (int e = 0; e < 16; ++e) {
      float s = 0.f;
#pragma unroll
      for (int i = 0; i < 4; ++i) {
        const float4 wv = *(const float4*)(wrl + e * 1024 + i * 256 + lane * 4);
        s += v[i * 4] * wv.x + v[i * 4 + 1] * wv.y + v[i * 4 + 2] * wv.z + v[i * 4 + 3] * wv.w;
      }
      pr[e] = s;
      asm volatile("" ::: "memory");
    }
    float r8[8], r4[4], r2[2];
    {
      const bool hi = (lane & 32) != 0;
#pragma unroll
      for (int i = 0; i < 8; ++i) { const float a = pr[i], c = pr[i + 8]; r8[i] = (hi ? c : a) + __shfl_xor(hi ? a : c, 32); }
    }
    {
      const bool hi = (lane & 16) != 0;
#pragma unroll
      for (int i = 0; i < 4; ++i) { const float a = r8[i], c = r8[i + 4]; r4[i] = (hi ? c : a) + __shfl_xor(hi ? a : c, 16); }
    }
    {
      const bool hi = (lane & 8) != 0;
#pragma unroll
      for (int i = 0; i < 2; ++i) { const float a = r4[i], c = r4[i + 2]; r2[i] = (hi ? c : a) + __shfl_xor(hi ? a : c, 8); }
    }
    float lg;
    {
      const bool hi = (lane & 4) != 0;
      lg = (hi ? r2[1] : r2[0]) + __shfl_xor(hi ? r2[0] : r2[1], 4);
    }
    lg += __shfl_xor(lg, 2);
    lg += __shfl_xor(lg, 1);
    const int elane = ((lane >> 5) & 1) * 8 + ((lane >> 4) & 1) * 4 + ((lane >> 3) & 1) * 2 + ((lane >> 2) & 1);
    float mx = lg;
    mx = fmaxf(mx, __shfl_xor(mx, 4)); mx = fmaxf(mx, __shfl_xor(mx, 8));
    mx = fmaxf(mx, __shfl_xor(mx, 16)); mx = fmaxf(mx, __shfl_xor(mx, 32));
    const float ex = __expf(lg - mx);
    float den = ex;
    den += __shfl_xor(den, 4); den += __shfl_xor(den, 8); den += __shfl_xor(den, 16); den += __shfl_xor(den, 32);
    const float mine = ex / den;
    if ((lane & 3) == 0) {
      float* AFF = (float*)(p.ws + (is_ctx ? O_AFFC : O_AFF));
      AFF[((long)b * 16 + elane) * T + t] = mine;
    }
  }
}

DI void topk_item(const Params& p, bool is_ctx, int b, int e, char* lds, int tid) {
  const int T = is_ctx ? CTX : SEQ, cap = is_ctx ? CAPC : CAP;
  unsigned* hist = (unsigned*)lds;
  unsigned* sel = hist + 256;
  unsigned* wtot = hist + 264;
  const unsigned* AFF = (const unsigned*)(p.ws + (is_ctx ? O_AFFC : O_AFF)) + ((long)b * 16 + e) * T;
  const int lane = tid & 63, w = tid >> 6;
  const bool have = tid * 8 < T;
  unsigned v[8];
  if (have) {
    const uint4 t0 = *(const uint4*)(AFF + tid * 8), t1 = *(const uint4*)(AFF + tid * 8 + 4);
    v[0] = t0.x; v[1] = t0.y; v[2] = t0.z; v[3] = t0.w; v[4] = t1.x; v[5] = t1.y; v[6] = t1.z; v[7] = t1.w;
  } else {
#pragma unroll
    for (int i = 0; i < 8; ++i) v[i] = 0u;
  }
  unsigned prefix = 0u, kk = (unsigned)cap;
#pragma unroll 1
  for (int pass = 3; pass >= 0; --pass) {
    __syncthreads();
    if (tid < 256) hist[tid] = 0u;
    __syncthreads();
    if (have) {
#pragma unroll
      for (int i = 0; i < 8; ++i) {
        const bool match = (pass == 3) ? true : ((v[i] >> (8 * (pass + 1))) == prefix);
        if (match) atomicAdd(&hist[(v[i] >> (8 * pass)) & 255u], 1u);
      }
    }
    __syncthreads();
    if (tid < 256) {
      unsigned sfx = 0u;
      for (int d = tid + 1; d < 256; ++d) sfx += hist[d];
      const unsigned me = hist[tid];
      if (sfx < kk && sfx + me >= kk) { sel[0] = (unsigned)tid; sel[1] = kk - sfx; }
    }
    __syncthreads();
    prefix = (prefix << 8) | sel[0];
    kk = sel[1];
  }
  const unsigned thr = prefix;
  unsigned cg = 0u, ce = 0u;
  if (have) {
#pragma unroll
    for (int i = 0; i < 8; ++i) { cg += (v[i] > thr); ce += (v[i] == thr); }
  }
  unsigned pk = cg | (ce << 16);
  unsigned inc = pk;
#pragma unroll
  for (int o = 1; o < 64; o <<= 1) {
    const unsigned t = __shfl_up(inc, o);
    if (lane >= o) inc += t;
  }
  __syncthreads();
  if (lane == 63) wtot[w] = inc;
  __syncthreads();
  unsigned base = 0u, total = 0u;
#pragma unroll
  for (int ww = 0; ww < NWAVE; ++ww) { const unsigned t = wtot[ww]; if (ww < w) base += t; total += t; }
  const unsigned excl = base + inc - pk;
  unsigned pos_g = excl & 0xffffu, pos_e = excl >> 16;
  const unsigned n_gt = total & 0xffffu;
  if (have) {
    short* SLOT = (short*)(p.ws + (is_ctx ? O_SLOTC : O_SLOT));
    int* IDX = (int*)(p.ws + (is_ctx ? O_IDXC : O_IDX));
    float* GATE = (float*)(p.ws + (is_ctx ? O_GATEC : O_GATE));
#pragma unroll
    for (int i = 0; i < 8; ++i) {
      const int idx = tid * 8 + i;
      int slot = -1;
      if (v[i] > thr) { slot = (int)pos_g; ++pos_g; }
      else if (v[i] == thr) { if (pos_e < kk) slot = (int)(n_gt + pos_e); ++pos_e; }
      if (slot >= 0) {
        const int prow = (e * 8 + b) * cap + slot;
        IDX[prow] = idx;
        GATE[prow] = __uint_as_float(v[i]);
      }
      SLOT[((long)b * T + idx) * 16 + e] = (short)slot;
    }
  }
}

DI void phase_topk(const Params& p, int layer, char* lds, int tid) {
  const int n_lat = 128, n_ctx = (layer == 0) ? 128 : 0;
  for (int item = blockIdx.x; item < n_lat + n_ctx; item += gridDim.x) {
    int it = item;
    if (it < n_lat) { topk_item(p, false, it >> 4, it & 15, lds, tid); continue; }
    it -= n_lat;
    topk_item(p, true, it >> 4, it & 15, lds, tid);
  }
  if (layer == 1) {
    const int g = gridDim.x;
    for (int i0 = ((int)blockIdx.x + g - 128 % g) % g; i0 < N_EXPCONV; i0 += 2 * g) {
      const int i1 = i0 + g;
      expconv_pair(p, 1, i0, (i1 < N_EXPCONV) ? i1 : -1, lds, tid);
    }
  }
}

template <int VAR = 0>
DI void phase_moe1(const Params& p, int layer, unsigned* ctr, int* s_item, char* lds, int tid) {
  const bfraw* WGU = (const bfraw*)(p.ws + O_WGU);
  const int n_per = 512 + ((layer == 0) ? 32 : 0);
  XQ q{0, 0, 0, -1};
  auto decode = [&](int x, int i, int& e, int& ct, int& rt, bool& is_ctx) {
    is_ctx = i >= 512;
    if (!is_ctx) { e = i >> 5; const int loc = i & 31; rt = 4 * (x & 3) + (loc & 3); ct = 8 * (x >> 2) + (loc >> 2); }
    else { const int g = x * 32 + (i - 512); e = g >> 4; ct = g & 15; rt = 0; }
  };
  auto load_tok = [&](int x, int i, int (&tok)[4]) {
    int e, ct, rt; bool c;
    decode(x, i, e, ct, rt, c);
    const int cap = c ? CAPC : CAP;
    const int* IDX = (const int*)(p.ws + (c ? O_IDXC : O_IDX));
    const int r0 = (tid & 255) >> 2;
#pragma unroll
    for (int k = 0; k < 4; ++k) tok[k] = IDX[e * 8 * cap + rt * 256 + k * 64 + r0];
  };
  int tokn[4] = {0, 0, 0, 0};
  bool have = next_item_s(n_per, tid, q);
  if (have) load_tok(q.list, q.idx, tokn);
  while (have) {
    const int x = q.list, ci = q.idx;
    int e, ct, rt; bool is_ctx;
    decode(x, ci, e, ct, rt, is_ctx);
    const int cap = is_ctx ? CAPC : CAP, T = is_ctx ? CTX : SEQ;
    const bfraw* Hs = (const bfraw*)(p.ws + (is_ctx ? O_HC : O_H));
    bfraw* ACT = (bfraw*)(p.ws + (is_ctx ? O_ACTC : O_ACT));
    const bfraw *ap[4], *bp[4];
    {
      const int r0 = (tid & 255) >> 2, c8 = ((tid & 3) ^ swz4(tid >> 4)) * 8;
#pragma unroll
      for (int i = 0; i < 4; ++i) {
        const int l = rt * 256 + i * 64 + r0;
        ap[i] = Hs + ((long)(l / cap) * T + tokn[i]) * 1024 + c8;
      }
    }
    have = next_item_s(n_per, tid, q);
    if (have) load_tok(q.list, q.idx, tokn);
    rows4(WGU, 1024, e * 4096 + ct * 256, tid, bp);
    const long prow0 = (long)e * 8 * cap + rt * 256;
    gemm_tile<true>(ap, bp, 1024, lds, tid, [&](f32x4 (&acc)[8][4], int wr, int wc, int fr, int fq) {
#pragma unroll
      for (int m = 0; m < 8; ++m)
#pragma unroll
        for (int q = 0; q < 2; ++q) {
          const int f = ct * 128 + wc * 32 + q * 16 + fq * 4;
          if (VAR != 0) {
            if (is_ctx || ct >= 8) continue;
            bfraw* Yd = (bfraw*)(p.ws + O_Y);
            uint2 st;
            st.x = pack2(acc[m][2 * q][0] + acc[m][2 * q + 1][0], acc[m][2 * q][1] + acc[m][2 * q + 1][1]);
            st.y = pack2(acc[m][2 * q][2] + acc[m][2 * q + 1][2], acc[m][2 * q][3] + acc[m][2 * q + 1][3]);
            *(uint2*)(Yd + (prow0 + wr * 128 + m * 16 + fr) * 1024 + f) = st;
            continue;
          }
          float sv[4];
#pragma unroll
          for (int j = 0; j < 4; ++j) {
            const float g = acc[m][2 * q][j], u = acc[m][2 * q + 1][j];
            sv[j] = g * u * __builtin_amdgcn_rcpf(1.f + __builtin_amdgcn_exp2f(-LOG2E * g));
          }
          uint2 st;
          st.x = pack2(sv[0], sv[1]);
          st.y = pack2(sv[2], sv[3]);
          *(uint2*)(ACT + (prow0 + wr * 128 + m * 16 + fr) * FF + f) = st;
        }
    });
  }
}

DI void phase_moe2(const Params& p, int layer, unsigned* ctr, int* s_item, char* lds, int tid) {
  const bfraw* WD = (const bfraw*)(p.ws + O_WD);
  const int n_per = 128 + ((layer == 0) ? 8 : 0);
  XQ q{0, 0, 0, -1};
  while (next_item_s(n_per, tid, q)) {
    const int x = q.list;
    const bool is_ctx = q.idx >= 128;
    const int cap = is_ctx ? CAPC : CAP;
    int e, ct, rt;
    if (!is_ctx) { e = (x >> 2) + 2 * (q.idx >> 4); const int loc = q.idx & 15; rt = 4 * (x & 3) + (loc & 3); ct = loc >> 2; }
    else { const int g = x * 8 + (q.idx - 128); e = g >> 2; ct = g & 3; rt = 0; }
    const bfraw* ACT = (const bfraw*)(p.ws + (is_ctx ? O_ACTC : O_ACT));
    bfraw* Y = (bfraw*)(p.ws + (is_ctx ? O_YC : O_Y));
    const long prow0 = (long)e * 8 * cap + rt * 256;
    const bfraw *ap[4], *bp[4];
    rows4(ACT + prow0 * FF, FF, 0, tid, ap);
    rows4(WD, FF, e * 1024 + ct * 256, tid, bp);
    gemm_tile<true>(ap, bp, FF, lds, tid, [&](f32x4 (&acc)[8][4], int wr, int wc, int fr, int fq) {
#pragma unroll
      for (int m = 0; m < 8; ++m)
#pragma unroll
        for (int n = 0; n < 4; ++n) {
          const int col = ct * 256 + wc * 64 + n * 16 + fq * 4;
          uint2 st;
          st.x = pack2(acc[m][n][0], acc[m][n][1]);
          st.y = pack2(acc[m][n][2], acc[m][n][3]);
          *(uint2*)(Y + (prow0 + wr * 128 + m * 16 + fr) * 1024 + col) = st;
        }
    });
  }
}

DI void phase_combine(const Params& p, int layer, int tid) {
  const int w = tid >> 6, lane = tid & 63;
  const float* MOD = (const float*)(p.ws + O_MOD);
  const int nrows = NT + ((layer == 0) ? NCT : 0);
  const int stride = gridDim.x * NWAVE;
  int row = blockIdx.x * NWAVE + w;
  if (row >= nrows) return;
  uint4 nsl0, nsl1;
  float nv[16];
  {
    const bool c = row >= NT;
    const int r = c ? row - NT : row;
    const short* SL = (const short*)(p.ws + (c ? O_SLOTC : O_SLOT)) + (long)r * 16;
    nsl0 = *(const uint4*)SL; nsl1 = *(const uint4*)(SL + 8);
    load_row16((const float*)(p.ws + (c ? O_X1C : O_X1)) + (long)r * 1024, lane, nv);
  }
#pragma unroll 1
  for (; row < nrows; row += stride) {
    const bool is_ctx = row >= NT;
    const int rr = is_ctx ? row - NT : row;
    const int T = is_ctx ? CTX : SEQ, cap = is_ctx ? CAPC : CAP;
    const int b = rr / T;
    const float* GATE = (const float*)(p.ws + (is_ctx ? O_GATEC : O_GATE));
    const bfraw* Y = (const bfraw*)(p.ws + (is_ctx ? O_YC : O_Y));
    const float* mr = MOD + (layer * 9 + (is_ctx ? 8 : b)) * 6144;
    const uint4 sl0 = nsl0, sl1 = nsl1;
    float v[16];
#pragma unroll
    for (int i = 0; i < 16; ++i) v[i] = nv[i];
    {
      const int nrow = row + stride;
      if (nrow < nrows) {
        const bool c = nrow >= NT;
        const int r = c ? nrow - NT : nrow;
        const short* SL = (const short*)(p.ws + (c ? O_SLOTC : O_SLOT)) + (long)r * 16;
        nsl0 = *(const uint4*)SL; nsl1 = *(const uint4*)(SL + 8);
        load_row16((const float*)(p.ws + (c ? O_X1C : O_X1)) + (long)r * 1024, lane, nv);
      }
    }
    const unsigned slw[8] = {sl0.x, sl0.y, sl0.z, sl0.w, sl1.x, sl1.y, sl1.z, sl1.w};
    float y[16];
#pragma unroll
    for (int i = 0; i < 16; ++i) y[i] = 0.f;
#pragma unroll
    for (int e = 0; e < 16; ++e) {
      const unsigned wd = slw[e >> 1];
      const int sv = (int)(short)((e & 1) ? (wd >> 16) : (wd & 0xffffu));
      if (sv >= 0) {
        const long prow = (long)(e * 8 + b) * cap + sv;
        const float g = GATE[prow];
        const bfraw* yr = Y + prow * 1024;
#pragma unroll
        for (int i = 0; i < 4; ++i) {
          const uint2 u = *(const uint2*)(yr + i * 256 + lane * 4);
          y[i * 4 + 0] += g * bflo(u.x); y[i * 4 + 1] += g * bfhi(u.x);
          y[i * 4 + 2] += g * bflo(u.y); y[i * 4 + 3] += g * bfhi(u.y);
        }
      }
    }
    float g2[16];
    load_row16(mr + 5120, lane, g2);
#pragma unroll
    for (int i = 0; i < 16; ++i) v[i] = ALPHA * v[i] + g2[i] * y[i];
    postnorm16(v, p.ln2_g + layer * 1024, p.ln2_b + layer * 1024, lane);
    if (!is_ctx) store_row16(p.out + (long)rr * 1024, lane, v);
    if (layer == 0) {
      const float* mn = MOD + (1 * 9 + (is_ctx ? 8 : b)) * 6144;
      modulate16(v, mn, mn + 1024, lane);
      store_row16_bf((bfraw*)(p.ws + (is_ctx ? O_HC : O_H)) + (long)rr * 1024, lane, v);
    }
  }
}

#ifndef DUP_MASK
#define DUP_MASK 0
#endif
DI void run_phase(const Params& p, int ph, unsigned* ctr, int* s_item, char* smem, int tid) {
  if (ph == 0) phase_prep(p, smem, tid);
  else if (ph == 1) phase_lnmod0(p, tid);
  else {
    const int layer = (ph - 2) >> 3, sub = (ph - 2) & 7;
    switch (sub) {
      case 0: phase_proj(p, layer, ctr, s_item, smem, tid); break;
      case 1: phase_mix(p, layer, ctr, s_item, smem, tid); break;
      case 2: phase_outproj(p, layer, ctr, s_item, smem, tid); break;
      case 3: phase_row(p, layer, smem, tid); break;
      case 4: phase_topk(p, layer, smem, tid); break;
      case 5: phase_moe1(p, layer, ctr, s_item, smem, tid); break;
      case 6: phase_moe2(p, layer, ctr, s_item, smem, tid); break;
      default: phase_combine(p, layer, tid); break;
    }
  }
}

__global__ void __launch_bounds__(NTHR) fwd_kernel(Params p) {
  extern __shared__ __attribute__((aligned(16))) char smem[];
  __shared__ int s_item;
  __shared__ uint4 xb_words;
  const int wave_id = __builtin_amdgcn_readfirstlane((int)(threadIdx.x >> 6));
  if (threadIdx.x == 0) xb_words = make_uint4(0u, 0u, 0u, 0u);
  __syncthreads();
  unsigned* barw = (unsigned*)(p.ws + O_BAR);
  for (int ph = p.ph_lo; ph < p.ph_hi; ++ph) {
    if (ph > p.ph_lo) {
      if (ph == 1) {
        cg::this_grid().sync();
        int t0;
        asm volatile("v_mbcnt_lo_u32_b32 %0, -1, 0\n\tv_mbcnt_hi_u32_b32 %0, -1, %0" : "=v"(t0));
        xcd_barrier_post(barw, t0 + wave_id * 64);
      } else {
        int t0;
        asm volatile("v_mbcnt_lo_u32_b32 %0, -1, 0\n\tv_mbcnt_hi_u32_b32 %0, -1, %0" : "=v"(t0));
        xcd_barrier(barw, (volatile unsigned*)&xb_words, t0 + wave_id * 64);
      }
    }
    int tid;
    asm volatile("v_mbcnt_lo_u32_b32 %0, -1, 0\n\tv_mbcnt_hi_u32_b32 %0, -1, %0" : "=v"(tid));
    tid += wave_id * 64;
    unsigned* ctr = (unsigned*)(p.ws + O_CTR) + ph * 8;
    run_phase(p, ph, ctr, &s_item, smem, tid);
#ifdef PROBE_VAR
    if (ph >= 2 && ((ph - 2) & 7) == 5) {
      cg::this_grid().sync();
      asm volatile("" : "+v"(tid));
      phase_moe1<PROBE_VAR>(p, (ph - 2) >> 3, ctr + 32 * 8, &s_item, smem, tid);
    }
#endif
#if DUP_MASK
    {
      const int bit = (ph == 0) ? 8 : (ph == 1) ? 9 : ((ph - 2) & 7);
      if ((DUP_MASK >> bit) & 1) {
        cg::this_grid().sync();
        asm volatile("" : "+v"(tid));
        run_phase(p, ph, ctr + 32 * 8, &s_item, smem, tid);
      }
    }
#endif
  }
}

extern "C" void kernel_launch(void* const* d_in, const int* in_sizes, int n_in, void* d_out, int out_size, void* d_ws,
                              size_t ws_size, hipStream_t stream) {
  (void)in_sizes; (void)n_in; (void)out_size;
  if (ws_size < O_END) { fprintf(stderr, "kernel_launch: workspace too small (%zu < %zu)\n", ws_size, (size_t)O_END); return; }
  Params p{};
  const float** pp = (const float**)&p;
  for (int i = 0; i < 21; ++i) pp[i] = (const float*)d_in[i];
  p.out = (float*)d_out;
  p.ws = (char*)d_ws;
  static int grid_blocks = 0;
  if (!grid_blocks) {
    int dev = 0, cus = 0, per_cu = 0;
    hipGetDevice(&dev);
    hipDeviceGetAttribute(&cus, hipDeviceAttributeMultiprocessorCount, dev);
    hipFuncSetAttribute((const void*)fwd_kernel, hipFuncAttributeMaxDynamicSharedMemorySize, LDS_BYTES);
    hipOccupancyMaxActiveBlocksPerMultiprocessor(&per_cu, fwd_kernel, NTHR, LDS_BYTES);
    if (per_cu < 1) per_cu = 1;
    if (per_cu > 1) per_cu = 1;
    grid_blocks = cus * per_cu;
  }
#if ONE_LAUNCH
  p.ph_lo = 0; p.ph_hi = NPHASE;
  void* args[] = {&p};
  hipError_t e = hipLaunchCooperativeKernel((void*)fwd_kernel, dim3(grid_blocks), dim3(NTHR), args, LDS_BYTES, stream);
  if (e != hipSuccess) fprintf(stderr, "cooperative launch failed: %s (grid %d)\n", hipGetErrorString(e), grid_blocks);
#else
  for (int ph = 0; ph < NPHASE; ++ph) {
    p.ph_lo = ph; p.ph_hi = ph + 1;
    hipLaunchKernelGGL(fwd_kernel, dim3(grid_blocks), dim3(NTHR), LDS_BYTES, stream, p);
  }
#endif
}
```

```cpp
#include <hip/hip_runtime.h>
#include <hip/hip_cooperative_groups.h>
#include <cstdio>
namespace cg = cooperative_groups;

#ifndef ONE_LAUNCH
#define ONE_LAUNCH 1
#endif

#define DI __device__ __forceinline__
typedef unsigned short bfraw;
using bf16x8 = __attribute__((ext_vector_type(8))) short;
using f32x4 = __attribute__((ext_vector_type(4))) float;

constexpr int NB = 8, SEQ = 4096, DM = 1024, CTX = 256;
constexpr int NT = NB * SEQ, NCT = NB * CTX;
constexpr int NPROJ = 1792;
constexpr int KS = CTX + SEQ;
constexpr int NE = 16, FF = 2048;
constexpr int CAP = 512, CAPC = 32;
constexpr float ALPHA = 1.41421356237f;
constexpr float LOG2E = 1.44269504089f;
constexpr int NPHASE = 18;
constexpr int NTHR = 512;
constexpr int NWAVE = NTHR / 64;
constexpr int LDS_BYTES = 131072;

constexpr size_t al(size_t x) { return (x + 255) & ~size_t(255); }
constexpr size_t O_MOD = 0;
constexpr size_t O_ROPE = al(O_MOD + 2 * 9 * 6144 * 4);
constexpr size_t O_CTR = al(O_ROPE + 2 * 1024 * 4);
constexpr size_t O_BAR = al(O_CTR + 1024 * 4);
constexpr size_t O_WINT = al(O_BAR + 3456 * 4);
constexpr size_t O_WOUTT = al(O_WINT + 2ull * NPROJ * 1024 * 2);
constexpr size_t O_DFT = al(O_WOUTT + 2ull * 1024 * 1024 * 2);
constexpr size_t O_PSCR = O_DFT + 2ull * 2048 * 4096 * 2;
constexpr size_t O_DFTC = al(O_DFT + 4096ull * 8192 * 2);
constexpr size_t O_WGU = al(O_DFTC + 256ull * 512 * 2);
constexpr size_t O_WD = al(O_WGU + 16ull * 4096 * 1024 * 2);
constexpr size_t O_X1 = al(O_WD + 16ull * 1024 * 2048 * 2);
constexpr size_t O_X1C = al(O_X1 + (size_t)NT * 1024 * 4);
constexpr size_t O_H = al(O_X1C + (size_t)NCT * 1024 * 4);
constexpr size_t O_HC = al(O_H + (size_t)NT * 1024 * 2);
constexpr size_t O_AFF = al(O_HC + (size_t)NCT * 1024 * 2);
constexpr size_t O_AFFC = al(O_AFF + 8ull * 16 * 4096 * 4);
constexpr size_t O_IDX = al(O_AFFC + 8ull * 16 * 256 * 4);
constexpr size_t O_GATE = al(O_IDX + 16ull * 8 * 512 * 4);
constexpr size_t O_SLOT = al(O_GATE + 16ull * 8 * 512 * 4);
constexpr size_t O_IDXC = al(O_SLOT + 8ull * 4096 * 16 * 2);
constexpr size_t O_GATEC = al(O_IDXC + 16ull * 8 * 32 * 4);
constexpr size_t O_SLOTC = al(O_GATEC + 16ull * 8 * 32 * 4);
constexpr size_t O_Y = al(O_SLOTC + 8ull * 256 * 16 * 2);
constexpr size_t O_YC = al(O_Y + 65536ull * 1024 * 2);
constexpr size_t O_ACTC = al(O_YC + 4096ull * 1024 * 2);
constexpr size_t O_R = al(O_ACTC + 4096ull * 2048 * 2);
constexpr size_t O_ACT = O_R;
constexpr size_t O_QA = O_R;
constexpr size_t O_QC = al(O_QA + (size_t)NT * 512 * 2);
constexpr size_t O_KA = al(O_QC + (size_t)NT * 256 * 2);
constexpr size_t O_VAT = al(O_KA + 8ull * 2 * KS * 64 * 2);
constexpr size_t O_KC = al(O_VAT + 8ull * 2 * KS * 64 * 2);
constexpr size_t O_VCT = al(O_KC + 8ull * 2 * KS * 64 * 2);
constexpr size_t O_VTF = al(O_VCT + 8ull * 2 * KS * 64 * 2);
constexpr size_t O_MIX = al(O_VTF + 8ull * 256 * 8192 * 2);
constexpr size_t O_QAC = al(O_MIX + (size_t)NT * 1024 * 2);
constexpr size_t O_QCC = al(O_QAC + (size_t)NCT * 512 * 2);
constexpr size_t O_VTFC = al(O_QCC + (size_t)NCT * 256 * 2);
constexpr size_t O_MIXC = al(O_VTFC + 8ull * 256 * 512 * 2);
constexpr size_t O_REND = al(O_MIXC + (size_t)NCT * 1024 * 2);
constexpr size_t O_END = O_R + 65536ull * 2048 * 2;
static_assert(O_REND <= O_END, "mixer buffers must fit in the ACT region");
static_assert(O_END <= 1073741824ull, "workspace too large");

struct Params {
  const float *x, *c, *ctx, *c_ctx, *w_mod, *b_mod, *w_in, *q_norm, *k_norm, *w_four, *b_four, *sink, *w_out,
      *ln1_g, *ln1_b, *w_router, *w_gate, *w_up, *w_down, *ln2_g, *ln2_b;
  float* out;
  char* ws;
  int ph_lo, ph_hi;
};

typedef __bf16 hwbf2 __attribute__((ext_vector_type(2)));
typedef float hwf2 __attribute__((ext_vector_type(2)));
DI unsigned pack2(float a, float b) {
  hwf2 f = {a, b};
  return __builtin_bit_cast(unsigned, __builtin_convertvector(f, hwbf2));
}
DI bfraw f2bf(float x) { return (bfraw)(pack2(x, 0.f) & 0xffffu); }
DI float bflo(unsigned u) { return __uint_as_float(u << 16); }
DI float bfhi(unsigned u) { return __uint_as_float(u & 0xffff0000u); }
DI float wsum(float v) {
#pragma unroll
  for (int o = 32; o; o >>= 1) v += __shfl_xor(v, o);
  return v;
}
DI void glds16(const void* g, char* l) {
  __builtin_amdgcn_global_load_lds((const unsigned*)g, (unsigned*)l, 16, 0, 0);
}
DI void wait_vm0() { asm volatile("s_waitcnt vmcnt(0)" ::: "memory"); }
DI f32x4 mfma16(bf16x8 a, bf16x8 b, f32x4 c) { return __builtin_amdgcn_mfma_f32_16x16x32_bf16(a, b, c, 0, 0, 0); }

DI int swz4(int q) { return (-q) & 3; }

struct XQ { int kk; int list; int idx; int wv; };
DI bool next_item_s(int n_per, int& tid, XQ& q) {
  if (q.wv < 0) { q.wv = __builtin_amdgcn_readfirstlane(tid >> 6); q.idx = (int)(blockIdx.x >> 3); q.list = (int)(blockIdx.x & 7); }
  else q.idx += (int)((gridDim.x + 7 - (blockIdx.x & 7)) >> 3);
  asm volatile("v_mbcnt_lo_u32_b32 %0, -1, 0\n\tv_mbcnt_hi_u32_b32 %0, -1, %0" : "=v"(tid));
  tid += q.wv * 64;
  return q.idx < n_per;
}
DI bool next_item_x(unsigned* ctr, int n_per, int* s_item, int& tid, XQ& q) {
  if (q.wv < 0) q.wv = __builtin_amdgcn_readfirstlane(tid >> 6);
  asm volatile("v_mbcnt_lo_u32_b32 %0, -1, 0\n\tv_mbcnt_hi_u32_b32 %0, -1, %0" : "=v"(tid));
  tid += q.wv * 64;
  for (;;) {
    if (q.kk >= 8) return false;
    q.list = ((int)(__builtin_amdgcn_s_getreg(20 | (3 << 11)) & 7) + q.kk) & 7;
    __syncthreads();
    if (tid == 0) *s_item = (int)atomicAdd(ctr + q.list, 1u);
    __syncthreads();
    q.idx = *s_item;
    if (q.idx < n_per) return true;
    ++q.kk;
  }
}

#define XB_TMO      128
#define XB_XCNT(j)  (256  + 64 * (j))
#define XB_XSUB(j)  (1280 + 64 * (j))
#define XB_XGEN(j)  (2304 + 64 * (j))
#define XB_TOP      3328
#define XB_TOPGEN   3392
#define XCD_BAR_WORDS 3456
#define XB_SPIN_CAP (1u << 18)
DI unsigned xb_ld(unsigned* p) { return __hip_atomic_load(p, __ATOMIC_RELAXED, __HIP_MEMORY_SCOPE_AGENT); }
DI unsigned xb_add(unsigned* p, unsigned v) { return __hip_atomic_fetch_add(p, v, __ATOMIC_RELAXED, __HIP_MEMORY_SCOPE_AGENT); }
DI unsigned xb_xcc_id() { return (unsigned)__builtin_amdgcn_s_getreg((3 << 11) | 20) & 0xFu; }
#define XB_SPIN(cond, bar) do { unsigned _sp = 0; while (cond) { __builtin_amdgcn_s_sleep(1); \
    if ((++_sp & 255u) == 0u) { if (xb_ld(&(bar)[XB_TMO])) break; if (_sp > XB_SPIN_CAP) { atomicAdd(&(bar)[XB_TMO], 1u); break; } } } } while (0)

DI void xcd_barrier_post(unsigned* bar, int tid) {
  if (tid == 0) (void)xb_add(&bar[XB_XCNT(xb_xcc_id())], 1u);
}
DI void xcd_barrier_complete(unsigned* bar, unsigned x, unsigned& nloc, unsigned& nx) {
  const unsigned G = gridDim.x;
  unsigned sum, cnt, mine, sp = 0u;
  for (;;) {
    sum = 0u; cnt = 0u; mine = 0u;
#pragma unroll
    for (unsigned j = 0; j < 16; ++j) { const unsigned c = xb_ld(&bar[XB_XCNT(j)]); sum += c; cnt += (c > 0u) ? 1u : 0u; mine = (j == x) ? c : mine; }
    if (sum == G) break;
    __builtin_amdgcn_s_sleep(1);
    if ((++sp & 255u) == 0u) { if (xb_ld(&bar[XB_TMO])) break; if (sp > XB_SPIN_CAP) { atomicAdd(&bar[XB_TMO], 1u); break; } }
  }
  nloc = mine > 0u ? mine : 1u; nx = cnt > 0u ? cnt : 1u;
}
DI void xcd_barrier(unsigned* bar, volatile unsigned* st, int tid) {
  asm volatile("s_waitcnt vmcnt(0)" ::: "memory");
  __syncthreads();
  if (tid == 0) {
    const unsigned x = xb_xcc_id();
    __builtin_amdgcn_s_waitcnt(0);
    unsigned nloc = st[0], nx = st[1];
    if (nloc == 0u) { xcd_barrier_complete(bar, x, nloc, nx); st[0] = nloc; st[1] = nx; }
    const unsigned old = xb_add(&bar[XB_XSUB(x)], 1u);
    const unsigned gen = old / nloc;
    if (old + 1u == (gen + 1u) * nloc) {
      __builtin_amdgcn_fence(__ATOMIC_RELEASE, "agent");
      asm volatile("s_waitcnt vmcnt(0)" ::: "memory");
      const unsigned og = xb_add(&bar[XB_TOP], 1u);
      const unsigned tg = og / nx;
      if (og + 1u == (tg + 1u) * nx) xb_add(&bar[XB_TOPGEN], 1u);
      else XB_SPIN(xb_ld(&bar[XB_TOPGEN]) == tg, bar);
      __builtin_amdgcn_fence(__ATOMIC_ACQUIRE, "agent");
      xb_add(&bar[XB_XGEN(x)], 1u);
      asm volatile("s_waitcnt vmcnt(0)" ::: "memory");
    } else {
      XB_SPIN(xb_ld(&bar[XB_XGEN(x)]) == gen, bar);
      __builtin_amdgcn_fence(__ATOMIC_ACQUIRE, "agent");
      asm volatile("s_waitcnt vmcnt(0)" ::: "memory");
    }
  }
  __syncthreads();
}

DI void rows4(const bfraw* base, long ld, int row0, int tid, const bfraw* (&out)[4]) {
  const int r0 = (tid & 255) >> 2, c8 = ((tid & 3) ^ swz4(tid >> 4)) * 8;
#pragma unroll
  for (int i = 0; i < 4; ++i) out[i] = base + (long)(row0 + i * 64 + r0) * ld + c8;
}
DI void gemm_stage(const bfraw* const (&ap)[4], const bfraw* const (&bp)[4], int k0, char* st, int tid) {
  const int t = tid & 255;
#pragma unroll
  for (int i = 0; i < 4; ++i) {
    glds16(ap[i] + k0, st + (i * 256 + t) * 16);
    glds16(bp[i] + k0, st + 16384 + (i * 256 + t) * 16);
  }
}

template <bool SWAP, int VAR = 0, class Epi>
DI void gemm_tile(const bfraw* const (&ap)[4], const bfraw* const (&bp)[4], int K, char* lds, int tid, Epi epi) {
  asm volatile("" : "+v"(tid));
  const int w = tid >> 6, lane = tid & 63, wr = w >> 2, wc = w & 3, fr = lane & 15, fq = lane >> 4;
  const bool loader = w < 4;
  f32x4 acc[8][4];
#pragma unroll
  for (int m = 0; m < 8; ++m)
#pragma unroll
    for (int n = 0; n < 4; ++n) acc[m][n] = f32x4{0.f, 0.f, 0.f, 0.f};
  const int ns = K >> 5;
  __syncthreads();
  if (loader) {
    gemm_stage(ap, bp, 0, lds, tid);
    gemm_stage(ap, bp, 32, lds + 32768, tid);
    gemm_stage(ap, bp, 64, lds + 65536, tid);
  }
  asm volatile("s_waitcnt vmcnt(16)" ::: "memory");
  __builtin_amdgcn_s_barrier();
  asm volatile("" ::: "memory");
  const int aoff = (wr * 128 + fr) * 64 + (fq ^ swz4(fr >> 2)) * 16;
  const int boff = 16384 + (wc * 64 + fr) * 64 + (fq ^ swz4(fr >> 2)) * 16;
  const int t = tid & 255;
#pragma unroll 1
  for (int j = 0; j < ns; ++j) {
    const char* st = lds + (j & 3) * 32768;
    bf16x8 bfr[4], af[8];
#pragma unroll
    for (int n = 0; n < 4; ++n) bfr[n] = *(const bf16x8*)(st + boff + n * 1024);
#pragma unroll
    for (int m = 0; m < 8; ++m) af[m] = *(const bf16x8*)(st + aoff + m * 1024);
    if (j + 1 < ns) {
      if (j + 2 < ns) asm volatile("s_waitcnt vmcnt(8)" ::: "memory");
      else asm volatile("s_waitcnt vmcnt(0)" ::: "memory");
      __builtin_amdgcn_s_barrier();
      asm volatile("" ::: "memory");
    }
    const bool issue = loader && (j + 3 < ns);
    char* nst = lds + ((j + 3) & 3) * 32768;
    const int nk0 = (j + 3) * 32;
#pragma unroll
    for (int c = 0; c < 4; ++c) {
#pragma unroll
      for (int m = 2 * c; m < 2 * c + 2; ++m)
#pragma unroll
        for (int n = 0; n < 4; ++n) acc[m][n] = SWAP ? mfma16(bfr[n], af[m], acc[m][n]) : mfma16(af[m], bfr[n], acc[m][n]);
      __builtin_amdgcn_sched_barrier(0);
      if (issue) {
        glds16(ap[c] + nk0, nst + (c * 256 + t) * 16);
        glds16(bp[c] + nk0, nst + 16384 + (c * 256 + t) * 16);
      }
      __builtin_amdgcn_sched_barrier(0);
    }
  }
  epi(acc, wr, wc, fr, fq);
}

DI void attn_stage(const bfraw* Kp, const bfraw* VTp, int ldv, int tile, char* st, int tid) {
  const int slot0 = tile * 64;
  const int h = tid >> 8, r = (tid & 255) >> 2;
  const int ck = ((tid & 3) ^ swz4(r >> 3)) * 8;
  const int cv = ((tid & 3) ^ swz4(r >> 2)) * 8;
  glds16(Kp + (long)(slot0 + r) * 64 + h * 32 + ck, st + tid * 16);
  glds16(VTp + (long)r * ldv + slot0 + h * 32 + cv, st + 8192 + tid * 16);
}

template <bool WINDOW>
DI void attn_item(const bfraw* Qp, int qstride, const bfraw* Kp, const bfraw* VTp, int ldv, int n1, int tlo, int n2,
                  int qpos0, bool has_sink, float sink_l2, bfraw* Op, int ostride, char* lds, int tid) {
  asm volatile("" : "+v"(tid));
  const int w = tid >> 6, lane = tid & 63, fr = lane & 15, fq = lane >> 4;
  const float scale_l2 = 0.125f * LOG2E;
  bf16x8 qf[2][2];
#pragma unroll
  for (int n = 0; n < 2; ++n)
#pragma unroll
    for (int sd = 0; sd < 2; ++sd)
      qf[n][sd] = *(const bf16x8*)(Qp + (long)(w * 32 + n * 16 + fr) * qstride + sd * 32 + fq * 8);
  float m_run[2];
  f32x4 o[4][2], ol[2];
#pragma unroll
  for (int n = 0; n < 2; ++n) {
    m_run[n] = has_sink ? sink_l2 : -1e30f;
    const float l0 = has_sink ? 1.f : 0.f;
    ol[n] = f32x4{l0, l0, l0, l0};
#pragma unroll
    for (int md = 0; md < 4; ++md) o[md][n] = f32x4{0.f, 0.f, 0.f, 0.f};
  }
  const bf16x8 ones = bf16x8{(short)0x3F80, (short)0x3F80, (short)0x3F80, (short)0x3F80, (short)0x3F80, (short)0x3F80, (short)0x3F80, (short)0x3F80};
  const int nt = n1 + n2;
  __syncthreads();
  attn_stage(Kp, VTp, ldv, (0 < n1) ? 0 : tlo, lds, tid);
#pragma unroll 1
  for (int it = 0; it < nt; ++it) {
    wait_vm0();
    __syncthreads();
    const bool dma_next = it + 1 < nt;
    const int nx_tile = (it + 1 < n1) ? it + 1 : tlo + (it + 1 - n1);
    if (dma_next && w < 4) attn_stage(Kp, VTp, ldv, nx_tile, lds + ((it + 1) & 1) * 16384, tid);
    const char* sK = lds + (it & 1) * 16384;
    const char* sV = sK + 8192;
    f32x4 s[4][2];
#pragma unroll
    for (int m = 0; m < 4; ++m)
#pragma unroll
      for (int n = 0; n < 2; ++n) s[m][n] = f32x4{0.f, 0.f, 0.f, 0.f};
#pragma unroll
    for (int sd = 0; sd < 2; ++sd) {
#pragma unroll
      for (int m = 0; m < 4; ++m) {
        const int krow = (m >> 1) * 32 + (fr >> 2) * 8 + (m & 1) * 4 + (fr & 3);
        bf16x8 kf = *(const bf16x8*)(sK + sd * 4096 + krow * 64 + (fq ^ swz4(fr >> 2)) * 16);
#pragma unroll
        for (int n = 0; n < 2; ++n) s[m][n] = mfma16(kf, qf[n][sd], s[m][n]);
      }
    }
    if (dma_next && w >= 4) attn_stage(Kp, VTp, ldv, nx_tile, lds + ((it + 1) & 1) * 16384, tid);
    const int tile = (it < n1) ? it : tlo + (it - n1);
    const bool domask = WINDOW && (it >= n1);
    float mxs2[2];
#pragma unroll
    for (int n = 0; n < 2; ++n) {
      if (domask) {
        const int qpos = qpos0 + w * 32 + n * 16 + fr;
#pragma unroll
        for (int m = 0; m < 4; ++m)
#pragma unroll
          for (int j = 0; j < 4; ++j) {
            const int kpos = tile * 64 - CTX + (m >> 1) * 32 + fq * 8 + (m & 1) * 4 + j;
            const int d = qpos - kpos;
            if (d > 128 || d < -128) s[m][n][j] = -1e30f;
          }
      }
      float mx = -1e30f;
#pragma unroll
      for (int m = 0; m < 4; ++m) {
        mx = fmaxf(mx, fmaxf(s[m][n][0], s[m][n][1]));
        mx = fmaxf(mx, fmaxf(s[m][n][2], s[m][n][3]));
      }
      mxs2[n] = mx;
    }
    mxs2[0] *= scale_l2; mxs2[1] *= scale_l2;
    if (__any((mxs2[0] > m_run[0] + 8.f) || (mxs2[1] > m_run[1] + 8.f))) {
      {
        const float t0 = __shfl_xor(mxs2[0], 16), t1 = __shfl_xor(mxs2[1], 16);
        mxs2[0] = fmaxf(mxs2[0], t0); mxs2[1] = fmaxf(mxs2[1], t1);
        const float u0 = __shfl_xor(mxs2[0], 32), u1 = __shfl_xor(mxs2[1], 32);
        mxs2[0] = fmaxf(mxs2[0], u0); mxs2[1] = fmaxf(mxs2[1], u1);
      }
#pragma unroll
      for (int n = 0; n < 2; ++n) {
        const bool need = mxs2[n] > m_run[n] + 8.f;
        const float m_new = need ? mxs2[n] : m_run[n];
        const float alpha = __builtin_amdgcn_exp2f(m_run[n] - m_new);
        m_run[n] = m_new;
        ol[n][0] *= alpha; ol[n][1] *= alpha; ol[n][2] *= alpha; ol[n][3] *= alpha;
#pragma unroll
        for (int md = 0; md < 4; ++md) {
          o[md][n][0] *= alpha; o[md][n][1] *= alpha; o[md][n][2] *= alpha; o[md][n][3] *= alpha;
        }
      }
    }
#pragma unroll
    for (int n = 0; n < 2; ++n) {
      const float nm = -m_run[n];
#pragma unroll
      for (int m = 0; m < 4; ++m)
#pragma unroll
        for (int j = 0; j < 4; ++j) s[m][n][j] = __builtin_amdgcn_exp2f(__builtin_fmaf(s[m][n][j], scale_l2, nm));
    }
#pragma unroll
    for (int ks = 0; ks < 2; ++ks) {
      bf16x8 pf[2];
#pragma unroll
      for (int n = 0; n < 2; ++n) {
        const unsigned u0 = pack2(s[2 * ks][n][0], s[2 * ks][n][1]);
        const unsigned u1 = pack2(s[2 * ks][n][2], s[2 * ks][n][3]);
        const unsigned u2 = pack2(s[2 * ks + 1][n][0], s[2 * ks + 1][n][1]);
        const unsigned u3 = pack2(s[2 * ks + 1][n][2], s[2 * ks + 1][n][3]);
        const uint4 uu = make_uint4(u0, u1, u2, u3);
        pf[n] = __builtin_bit_cast(bf16x8, uu);
      }
#pragma unroll
      for (int md = 0; md < 4; ++md) {
        bf16x8 vf = *(const bf16x8*)(sV + ks * 4096 + (md * 16 + fr) * 64 + (fq ^ swz4(fr >> 2)) * 16);
#pragma unroll
        for (int n = 0; n < 2; ++n) o[md][n] = mfma16(vf, pf[n], o[md][n]);
      }
#pragma unroll
      for (int n = 0; n < 2; ++n) ol[n] = mfma16(ones, pf[n], ol[n]);
    }
  }
#pragma unroll
  for (int n = 0; n < 2; ++n) {
    const float inv = 1.f / ol[n][0];
    bfraw* orow = Op + (long)(w * 32 + n * 16 + fr) * ostride;
#pragma unroll
    for (int md = 0; md < 4; ++md) {
      uint2 st;
      st.x = pack2(o[md][n][0] * inv, o[md][n][1] * inv);
      st.y = pack2(o[md][n][2] * inv, o[md][n][3] * inv);
      *(uint2*)(orow + md * 16 + fq * 4) = st;
    }
  }
}

DI void xpose_tile(const float* src, long ld_src, bfraw* dst, long ld_dst, int mode, char* lds, int tid) {
  float(*t)[65] = (float(*)[65])lds;
  __syncthreads();
  {
    const int c = tid & 63, r0 = tid >> 6;
#pragma unroll 4
    for (int rr = r0; rr < 64; rr += NWAVE) t[rr][c] = src[(long)rr * ld_src + c];
  }
  __syncthreads();
  {
    const int k8 = (tid & 7) * 8, nn = tid >> 3;
    uint4 v;
    v.x = pack2(t[k8 + 0][nn], t[k8 + 1][nn]);
    v.y = pack2(t[k8 + 2][nn], t[k8 + 3][nn]);
    v.z = pack2(t[k8 + 4][nn], t[k8 + 5][nn]);
    v.w = pack2(t[k8 + 6][nn], t[k8 + 7][nn]);
    const int row = (mode == 0) ? nn : ((nn >> 4) * 32 + (mode == 2 ? 16 : 0) + (nn & 15));
    *(uint4*)(dst + (long)row * ld_dst + k8) = v;
  }
}

DI void xpose256x2(const float* s0, long ls0, bfraw* d0, long ld0, int m0,
                   const float* s1, long ls1, bfraw* d1, long ld1, int m1, bool two, char* lds, int tid) {
  const int w = tid >> 6, lane = tid & 63;
  float4 vA[8], vB[8];
#pragma unroll
  for (int i = 0; i < 8; ++i) {
    const int k = 2 * (w + 8 * (i >> 1)) + (i & 1);
    vA[i] = *(const float4*)(s0 + (long)k * ls0 + lane * 4);
  }
#pragma unroll
  for (int i = 0; i < 8; ++i) {
    const int k = 2 * (w + 8 * (i >> 1)) + (i & 1);
    vB[i] = *(const float4*)(s1 + (long)k * ls1 + lane * 4);
  }
#pragma unroll
  for (int half = 0; half < 2; ++half) {
    if (half == 1 && !two) break;
    __syncthreads();
#pragma unroll
    for (int i2 = 0; i2 < 4; ++i2) {
      const int k = 2 * (w + 8 * i2);
      char* base = lds + (lane * 4) * 136 + k * 2;
      const float4 e0 = half ? vB[2 * i2] : vA[2 * i2], e1 = half ? vB[2 * i2 + 1] : vA[2 * i2 + 1];
      *(unsigned*)(base + 0 * 136) = pack2(e0.x, e1.x);
      *(unsigned*)(base + 1 * 136) = pack2(e0.y, e1.y);
      *(unsigned*)(base + 2 * 136) = pack2(e0.z, e1.z);
      *(unsigned*)(base + 3 * 136) = pack2(e0.w, e1.w);
    }
    __syncthreads();
    bfraw* dst = half ? d1 : d0;
    const long ld_dst = half ? ld1 : ld0;
    const int mode = half ? m1 : m0;
#pragma unroll
    for (int q = 0; q < 4; ++q) {
      const int c = tid + NTHR * q;
      const int n = c >> 3, k8 = (c & 7) * 8;
      const uint2 lo = *(const uint2*)(lds + n * 136 + k8 * 2);
      const uint2 hi = *(const uint2*)(lds + n * 136 + k8 * 2 + 8);
      const int row = (mode == 0) ? n : ((n >> 4) * 32 + (mode == 2 ? 16 : 0) + (n & 15));
      *(uint4*)(dst + (long)row * ld_dst + k8) = make_uint4(lo.x, lo.y, hi.x, hi.y);
    }
  }
}

constexpr int N_EXPCONV = 4096 + 2048;
DI void expconv_decode(const Params& p, int layer, int item, const float*& src, long& ld_src, bfraw*& dst, long& ld_dst, int& mode) {
  bfraw* WGU = (bfraw*)(p.ws + O_WGU);
  bfraw* WD = (bfraw*)(p.ws + O_WD);
  if (item < 4096) {
    const int type = item & 1;
    int r = item >> 1;
    const int nt = r & 7; r >>= 3;
    const int kt = r & 15; const int e = r >> 4;
    src = (type ? p.w_up : p.w_gate) + ((long)(layer * NE + e) * DM + kt * 64) * FF + nt * 256;
    ld_src = FF;
    dst = WGU + ((long)e * 4096 + nt * 512) * DM + kt * 64;
    ld_dst = DM; mode = 1 + type;
  } else {
    int r = item - 4096;
    const int nt = r & 3; r >>= 2;
    const int kt = r & 31; const int e = r >> 5;
    src = p.w_down + ((long)(layer * NE + e) * FF + kt * 64) * DM + nt * 256;
    ld_src = DM;
    dst = WD + ((long)e * DM + nt * 256) * FF + kt * 64;
    ld_dst = FF; mode = 0;
  }
}
DI void expconv_pair(const Params& p, int layer, int i0, int i1, char* lds, int tid) {
  const float *s0, *s1; long ls0, ls1, ld0, ld1; bfraw *d0, *d1; int m0, m1;
  expconv_decode(p, layer, i0, s0, ls0, d0, ld0, m0);
  expconv_decode(p, layer, (i1 >= 0) ? i1 : i0, s1, ls1, d1, ld1, m1);
  xpose256x2(s0, ls0, d0, ld0, m0, s1, ls1, d1, ld1, m1, i1 >= 0, lds, tid);
}

DI void prep_mod_item(const Params& p, int item, char* lds, int tid) {
  const int layer = item / 96, chunk = item % 96;
  float* sc = (float*)lds;
  float* red = (float*)(lds + 36864);
  __syncthreads();
  for (int idx = tid; idx < 9 * 1024; idx += NTHR) {
    const int r = idx >> 10, k = idx & 1023;
    const float v = (r < 8) ? p.c[r * 1024 + k] : p.c_ctx[k];
    sc[idx] = v / (1.f + __expf(-v));
  }
  __syncthreads();
  const int w = tid >> 6, lane = tid & 63;
  const int col = chunk * 64 + lane;
  float acc[9];
#pragma unroll
  for (int r = 0; r < 9; ++r) acc[r] = 0.f;
  const float* wp = p.w_mod + ((long)layer * 1024 + w * 128) * 6144 + col;
#pragma unroll 4
  for (int k = 0; k < 128; ++k) {
    const float wv = wp[(long)k * 6144];
#pragma unroll
    for (int r = 0; r < 9; ++r) acc[r] += sc[r * 1024 + w * 128 + k] * wv;
  }
#pragma unroll
  for (int r = 0; r < 9; ++r) red[(w * 9 + r) * 64 + lane] = acc[r];
  __syncthreads();
  float* MOD = (float*)(p.ws + O_MOD);
  for (int idx = tid; idx < 9 * 64; idx += NTHR) {
    const int r = idx >> 6, l = idx & 63;
    float s = p.b_mod[layer * 6144 + chunk * 64 + l];
#pragma unroll
    for (int ww = 0; ww < NWAVE; ++ww) s += red[(ww * 9 + r) * 64 + l];
    MOD[(layer * 9 + r) * 6144 + chunk * 64 + l] = s;
  }
}

DI void prep_four_item(const Params& p, int item, char* lds, int tid) {
  const int layer = item >> 6, g = (item >> 4) & 3, kt = item & 15;
  float* G = (float*)lds;
  float(*Wt)[65] = (float(*)[65])(lds + 32768);
  float* ctab = (float*)(lds + 32768 + 64 * 65 * 4);
  __syncthreads();
  const float* wg = p.w_four + (long)(layer * 4 + g) * 4096;
  for (int idx = tid; idx < 4096; idx += NTHR) Wt[idx >> 6][idx & 63] = wg[idx];
  if (tid < 64) {
    float sn, cs;
    sincospif((float)tid / 32.f, &sn, &cs);
    ctab[tid] = cs;
    ctab[64 + tid] = sn;
  }
  __syncthreads();
  for (int o = tid; o < 4096; o += NTHR) {
    const int c = o >> 6, d = o & 63;
    float s1 = 0.f, s2 = 0.f;
#pragma unroll 4
    for (int c2 = 0; c2 < 64; ++c2) {
      const int a = (c * c2) & 63;
      const float wv = Wt[c2][d];
      s1 += ctab[a] * wv;
      s2 += ctab[64 + a] * wv;
    }
    G[o] = s1;
    G[4096 + o] = s2;
  }
  __syncthreads();
  const float* wi = p.w_in + ((long)layer * 1024 + kt * 64) * 1536 + 768 + g * 64;
  for (int idx = tid; idx < 4096; idx += NTHR) Wt[idx >> 6][idx & 63] = wi[(long)(idx >> 6) * 1536 + (idx & 63)];
  __syncthreads();
  bfraw* WINT = (bfraw*)(p.ws + O_WINT) + (long)layer * NPROJ * 1024;
  for (int o = tid; o < 64 * 128; o += NTHR) {
    const int kk = o & 63, dcol = o >> 6;
    const float* Gs = G + (dcol >> 6) * 4096 + (dcol & 63);
    float s = 0.f;
#pragma unroll 4
    for (int c = 0; c < 64; ++c) s += Wt[kk][c] * Gs[c * 64];
    const int row = (dcol < 64) ? (768 + g * 64 + dcol) : (1024 + g * 64 + (dcol - 64));
    WINT[(long)row * 1024 + kt * 64 + kk] = f2bf(s);
  }
}

constexpr int P0_MOD = 192, P0_FOUR = 128, P0_ROPE = 1, P0_DFTC = 256, P0_DFT = 4096, P0_WIN = 2 * 16 * 24, P0_WOUT = 2 * 16 * 16;
constexpr int P0_TOTAL = P0_MOD + P0_FOUR + P0_ROPE + P0_DFTC + P0_DFT + P0_WIN + P0_WOUT + N_EXPCONV;

DI void phase_prep(const Params& p, char* lds, int tid) {
  if (blockIdx.x == 0) { ((unsigned*)(p.ws + O_CTR))[tid] = 0u; ((unsigned*)(p.ws + O_CTR))[NTHR + tid] = 0u; }
  if (blockIdx.x == 0) { unsigned* bw = (unsigned*)(p.ws + O_BAR); for (int i = tid; i < XCD_BAR_WORDS; i += NTHR) bw[i] = 0u; }
  constexpr int P0_BASE = P0_TOTAL - N_EXPCONV;
  for (int item = blockIdx.x; item < P0_BASE; item += gridDim.x) {
    int it = item;
    if (it < P0_MOD) { prep_mod_item(p, it, lds, tid); continue; }
    it -= P0_MOD;
    if (it < P0_FOUR) { prep_four_item(p, it, lds, tid); continue; }
    it -= P0_FOUR;
    if (it < P0_ROPE) {
      float* rope = (float*)(p.ws + O_ROPE);
      for (int idx = tid; idx < 1024; idx += NTHR) {
        const int pos = idx >> 4, f = idx & 15;
        const float inv_freq = powf(10000.f, -(float)f / 16.f);
        const float ang = (float)pos * inv_freq;
        rope[idx] = cosf(ang);
        rope[1024 + idx] = sinf(ang);
      }
      continue;
    }
    it -= P0_ROPE;
    if (it < P0_DFTC) {
      bfraw* D = (bfraw*)(p.ws + O_DFTC) + (long)it * 512;
      for (int k = tid; k < 512; k += NTHR) {
        const int kk = k & 255;
        float sn, cs;
        sincospif((float)((it * kk) & 255) / 128.f, &sn, &cs);
        D[k] = f2bf(k < 256 ? cs : -sn);
      }
      continue;
    }
    it -= P0_DFTC;
    if (it < P0_DFT) {
      const int t = it & 2047;
      bfraw* D = (bfraw*)(p.ws + O_DFT) + (long)it * 4096;
      for (int ch = tid; ch < 2048; ch += NTHR) {
        const int k = ch * 2;
        float sn0, cs0, sn1, cs1;
        sincospif((float)((t * k) & 4095) / 2048.f, &sn0, &cs0);
        sincospif((float)((t * (k + 1)) & 4095) / 2048.f, &sn1, &cs1);
        *(unsigned*)(D + k) = (it < 2048) ? pack2(cs0, cs1) : pack2(sn0, sn1);
      }
      continue;
    }
    it -= P0_DFT;
    if (it < P0_WIN) {
      const int layer = it / 384, r = it % 384, kt = r / 24, nt = r % 24;
      if (nt >= 12 && nt < 16) continue;
      const int col = nt * 64;
      int drow;
      if (col < 768) drow = col;
      else if (col < 1152) drow = col + 256;
      else if (col < 1280) drow = col + 384;
      else if (col < 1408) drow = col + 128;
      else drow = col + 256;
      const float* src = p.w_in + ((long)layer * 1024 + kt * 64) * 1536 + col;
      bfraw* dst = (bfraw*)(p.ws + O_WINT) + ((long)layer * NPROJ + drow) * 1024 + kt * 64;
      xpose_tile(src, 1536, dst, 1024, 0, lds, tid);
      continue;
    }
    it -= P0_WIN;
    if (it < P0_WOUT) {
      const int layer = it >> 8, r = it & 255, kt = r >> 4, nt = r & 15;
      const float* src = p.w_out + ((long)layer * 1024 + kt * 64) * 1024 + nt * 64;
      bfraw* dst = (bfraw*)(p.ws + O_WOUTT) + ((long)layer * 1024 + nt * 64) * 1024 + kt * 64;
      xpose_tile(src, 1024, dst, 1024, 0, lds, tid);
      continue;
    }
  }
  for (int i0 = blockIdx.x; i0 < N_EXPCONV; i0 += 2 * gridDim.x) {
    const int i1 = i0 + gridDim.x;
    expconv_pair(p, 0, i0, (i1 < N_EXPCONV) ? i1 : -1, lds, tid);
  }
}

DI void ln_stats(const float v[16], float& mean, float& rstd) {
  float s = 0.f;
#pragma unroll
  for (int i = 0; i < 16; ++i) s += v[i];
  mean = wsum(s) * (1.f / 1024.f);
  float q = 0.f;
#pragma unroll
  for (int i = 0; i < 16; ++i) { const float d = v[i] - mean; q += d * d; }
  rstd = rsqrtf(wsum(q) * (1.f / 1024.f) + 1e-5f);
}
DI void load_row16(const float* src, int lane, float v[16]) {
#pragma unroll
  for (int i = 0; i < 4; ++i) {
    const float4 t = *(const float4*)(src + i * 256 + lane * 4);
    v[i * 4 + 0] = t.x; v[i * 4 + 1] = t.y; v[i * 4 + 2] = t.z; v[i * 4 + 3] = t.w;
  }
}
DI void store_row16(float* dst, int lane, const float v[16]) {
#pragma unroll
  for (int i = 0; i < 4; ++i) *(float4*)(dst + i * 256 + lane * 4) = make_float4(v[i * 4], v[i * 4 + 1], v[i * 4 + 2], v[i * 4 + 3]);
}
DI void store_row16_bf(bfraw* dst, int lane, const float v[16]) {
#pragma unroll
  for (int i = 0; i < 4; ++i) {
    uint2 st;
    st.x = pack2(v[i * 4], v[i * 4 + 1]);
    st.y = pack2(v[i * 4 + 2], v[i * 4 + 3]);
    *(uint2*)(dst + i * 256 + lane * 4) = st;
  }
}
DI void modulate16(float v[16], const float* sh, const float* sc, int lane) {
  float mean, rstd;
  ln_stats(v, mean, rstd);
  float a[16], b[16];
  load_row16(sh, lane, a);
  load_row16(sc, lane, b);
#pragma unroll
  for (int i = 0; i < 16; ++i) v[i] = (v[i] - mean) * rstd * (1.f + b[i]) + a[i];
}
DI void postnorm16(float v[16], const float* g, const float* bb, int lane) {
  float mean, rstd;
  ln_stats(v, mean, rstd);
  float a[16], b[16];
  load_row16(g, lane, a);
  load_row16(bb, lane, b);
#pragma unroll
  for (int i = 0; i < 16; ++i) v[i] = (v[i] - mean) * rstd * a[i] + b[i];
}

DI void phase_lnmod0(const Params& p, int tid) {
  const int w = tid >> 6, lane = tid & 63;
  const float* MOD = (const float*)(p.ws + O_MOD);
  const int stride = gridDim.x * NWAVE;
  int row = blockIdx.x * NWAVE + w;
  float nv[16];
  if (row < NT + NCT) load_row16((row < NT) ? p.x + (long)row * 1024 : p.ctx + (long)(row - NT) * 1024, lane, nv);
#pragma unroll 1
  for (; row < NT + NCT; row += stride) {
    float v[16];
#pragma unroll
    for (int i = 0; i < 16; ++i) v[i] = nv[i];
    const int nrow = row + stride;
    if (nrow < NT + NCT) load_row16((nrow < NT) ? p.x + (long)nrow * 1024 : p.ctx + (long)(nrow - NT) * 1024, lane, nv);
    if (row < NT) {
      const float* mr = MOD + (0 * 9 + row / SEQ) * 6144;
      modulate16(v, mr, mr + 1024, lane);
      store_row16_bf((bfraw*)(p.ws + O_H) + (long)row * 1024, lane, v);
    } else {
      const int rc = row - NT;
      const float* mr = MOD + (0 * 9 + 8) * 6144;
      modulate16(v, mr, mr + 1024, lane);
      store_row16_bf((bfraw*)(p.ws + O_HC) + (long)rc * 1024, lane, v);
    }
  }
}

DI void proj_item(const Params& p, int layer, bool is_ctx, int rt, int ct, char* lds, int tid) {
  const int T = is_ctx ? CTX : SEQ;
  const bfraw* Hs = (const bfraw*)(p.ws + (is_ctx ? O_HC : O_H));
  const bfraw* W = (const bfraw*)(p.ws + O_WINT) + (long)layer * NPROJ * 1024;
  const bfraw *ap[4], *bp[4];
  rows4(Hs, 1024, rt * 256, tid, ap);
  rows4(W, 1024, ct * 256, tid, bp);
  char* ws = p.ws;
  if (ct <= 2 || ct == 5) {
    const float* rope = (const float*)(ws + O_ROPE);
    gemm_tile<true>(ap, bp, 1024, lds, tid, [&](f32x4 (&acc)[8][4], int wr, int wc, int fr, int fq) {
      const int rowbase = rt * 256 + wr * 128;
      const int b = rowbase / T;
      const int tbase = rowbase - b * T;
      const bool donorm = (ct < 2) || (ct == 5 && wc < 2);
      const float* gn = ((ct < 2) ? p.q_norm : p.k_norm) + layer * 64;
      bfraw* dst;
      long rstride;
      if (ct < 2) { dst = (bfraw*)(ws + (is_ctx ? O_QAC : O_QA)) + ((long)rowbase * 8 + (ct * 4 + wc)) * 64; rstride = 512; }
      else if (ct == 2) { dst = (bfraw*)(ws + (is_ctx ? O_QCC : O_QC)) + ((long)rowbase * 4 + wc) * 64; rstride = 256; }
      else {
        const int slot0 = is_ctx ? tbase : CTX + tbase;
        dst = (bfraw*)(ws + (wc < 2 ? O_KA : O_KC)) + ((long)(b * 2 + (wc & 1)) * KS + slot0) * 64; rstride = 64;
      }
#pragma unroll
      for (int m = 0; m < 8; ++m) {
        const int rl = m * 16 + fr;
        float rs = 1.f;
        if (donorm) {
          float ss = 0.f;
#pragma unroll
          for (int n = 0; n < 4; ++n)
#pragma unroll
            for (int j = 0; j < 4; ++j) ss += acc[m][n][j] * acc[m][n][j];
          ss += __shfl_xor(ss, 16);
          ss += __shfl_xor(ss, 32);
          rs = rsqrtf(ss * (1.f / 64.f) + 1e-6f);
        }
        float xv[4][4];
        const float* gp = gn;
        asm volatile("" : "+s"(gp));
#pragma unroll
        for (int n = 0; n < 4; ++n) {
          if (donorm) {
            const float4 t = *(const float4*)(gp + n * 16 + fq * 4);
            xv[n][0] = acc[m][n][0] * rs * t.x; xv[n][1] = acc[m][n][1] * rs * t.y;
            xv[n][2] = acc[m][n][2] * rs * t.z; xv[n][3] = acc[m][n][3] * rs * t.w;
          } else {
            xv[n][0] = acc[m][n][0]; xv[n][1] = acc[m][n][1]; xv[n][2] = acc[m][n][2]; xv[n][3] = acc[m][n][3];
          }
        }
        if (!is_ctx) {
          const int t = tbase + rl;
          const int pr = t >> 6, pc = t & 63;
          const float4 c0 = *(const float4*)(rope + pr * 16 + fq * 4), s0 = *(const float4*)(rope + 1024 + pr * 16 + fq * 4);
          const float4 c1 = *(const float4*)(rope + pc * 16 + fq * 4), s1 = *(const float4*)(rope + 1024 + pc * 16 + fq * 4);
          const float c0a[4] = {c0.x, c0.y, c0.z, c0.w}, s0a[4] = {s0.x, s0.y, s0.z, s0.w};
          const float c1a[4] = {c1.x, c1.y, c1.z, c1.w}, s1a[4] = {s1.x, s1.y, s1.z, s1.w};
#pragma unroll
          for (int j = 0; j < 4; ++j) {
            const float y0 = xv[0][j] * c0a[j] - xv[1][j] * s0a[j], y1 = xv[1][j] * c0a[j] + xv[0][j] * s0a[j];
            const float y2 = xv[2][j] * c1a[j] - xv[3][j] * s1a[j], y3 = xv[3][j] * c1a[j] + xv[2][j] * s1a[j];
            xv[0][j] = y0; xv[1][j] = y1; xv[2][j] = y2; xv[3][j] = y3;
          }
        }
        bfraw* d = dst + (long)rl * rstride + fq * 4;
#pragma unroll
        for (int n = 0; n < 4; ++n) {
          uint2 st;
          st.x = pack2(xv[n][0], xv[n][1]);
          st.y = pack2(xv[n][2], xv[n][3]);
          *(uint2*)(d + n * 16) = st;
        }
      }
    });
  } else {
    gemm_tile<false>(ap, bp, 1024, lds, tid, [&](f32x4 (&acc)[8][4], int wr, int wc, int fr, int fq) {
      const int rowbase = rt * 256 + wr * 128;
      const int b = rowbase / T;
      const int tbase = rowbase - b * T;
      bfraw* dst;
      long cstride;
      if (ct == 6) {
        const int slot0 = is_ctx ? tbase : CTX + tbase;
        dst = (bfraw*)(ws + (wc < 2 ? O_VAT : O_VCT)) + (long)(b * 2 + (wc & 1)) * 64 * KS + slot0;
        cstride = KS;
      } else {
        const int ncol0 = wc * 64;
        const int koff = (ct == 4) ? T : 0;
        if (is_ctx) { dst = (bfraw*)(ws + O_VTFC) + ((long)b * 256 + ncol0) * 512 + koff + tbase; cstride = 512; }
        else { dst = (bfraw*)(ws + O_VTF) + ((long)b * 256 + ncol0) * 8192 + koff + tbase; cstride = 8192; }
      }
#pragma unroll
      for (int m = 0; m < 8; ++m)
#pragma unroll
        for (int n = 0; n < 4; ++n) {
          uint2 st;
          st.x = pack2(acc[m][n][0], acc[m][n][1]);
          st.y = pack2(acc[m][n][2], acc[m][n][3]);
          *(uint2*)(dst + (long)(n * 16 + fr) * cstride + m * 16 + fq * 4) = st;
        }
    });
  }
}

DI void phase_proj(const Params& p, int layer, unsigned* ctr, int* s_item, char* lds, int tid) {
  const int nct_ctx = (layer == 0) ? 7 : 2;
  const int n_per = 112 + nct_ctx;
  XQ q{0, 0, 0, -1};
  while (next_item_s(n_per, tid, q)) {
    const int x = q.list, i = q.idx;
    if (i < 112) proj_item(p, layer, false, 16 * x + i / 7, i % 7, lds, tid);
    else proj_item(p, layer, true, x, (layer == 0) ? (i - 112) : (5 + i - 112), lds, tid);
  }
}

DI void four_item(const Params& p, int layer, bool is_ctx, int b, int rt, char* lds, int tid) {
  const int T = is_ctx ? CTX : SEQ;
  const int K = 2 * T;
  const bfraw* A = (const bfraw*)(p.ws + (is_ctx ? O_DFTC : O_DFT));
  const bfraw* Bt = (const bfraw*)(p.ws + (is_ctx ? O_VTFC : O_VTF)) + (long)b * 256 * K;
  const bfraw *ap[4], *bp[4];
  rows4(A, K, rt * 256, tid, ap);
  rows4(Bt, K, 0, tid, bp);
  bfraw* MIX = (bfraw*)(p.ws + (is_ctx ? O_MIXC : O_MIX)) + (long)b * T * 1024;
  const float scale = is_ctx ? (1.f / 128.f) : (1.f / 512.f);
  const float* bias = p.b_four + layer * 256;
  gemm_tile<true>(ap, bp, K, lds, tid, [&](f32x4 (&acc)[8][4], int wr, int wc, int fr, int fq) {
#pragma unroll
    for (int n = 0; n < 4; ++n) {
      const int ncol = wc * 64 + n * 16 + fq * 4;
      const float4 bv = *(const float4*)(bias + ncol);
#pragma unroll
      for (int m = 0; m < 8; ++m) {
        const int t = rt * 256 + wr * 128 + m * 16 + fr;
        uint2 st;
        st.x = pack2(acc[m][n][0] * scale + bv.x, acc[m][n][1] * scale + bv.y);
        st.y = pack2(acc[m][n][2] * scale + bv.z, acc[m][n][3] * scale + bv.w);
        *(uint2*)(MIX + (long)t * 1024 + 512 + ncol) = st;
      }
    }
  });
}

DI void four_lat_item(const Params& p, int layer, int b, int rt, char* lds, int tid) {
  const bfraw* Cm = (const bfraw*)(p.ws + O_DFT);
  const bfraw* Sm = Cm + 2048l * 4096;
  const bfraw* Bt = (const bfraw*)(p.ws + O_VTF) + (long)b * 256 * 8192;
  float4* scr = (float4*)(p.ws + O_PSCR) + (long)(b * 8 + rt) * 16384;
  bfraw* MIX = (bfraw*)(p.ws + O_MIX) + (long)b * SEQ * 1024;
  const float scale = 1.f / 512.f;
  const float* bias = p.b_four + layer * 256;
  {
    const bfraw *ap[4], *bp[4];
    rows4(Cm, 4096, rt * 256, tid, ap);
    rows4(Bt, 8192, 0, tid, bp);
    gemm_tile<true>(ap, bp, 4096, lds, tid, [&](f32x4 (&acc)[8][4], int wr, int wc, int fr, int fq) {
      const int t_ = (wr * 4 + wc) * 64 + fq * 16 + fr;
#pragma unroll
      for (int m = 0; m < 8; ++m)
#pragma unroll
        for (int n = 0; n < 4; ++n)
          scr[(m * 4 + n) * NTHR + t_] = make_float4(acc[m][n][0], acc[m][n][1], acc[m][n][2], acc[m][n][3]);
    });
  }
  {
    const bfraw *ap[4], *bp[4];
    rows4(Sm, 4096, rt * 256, tid, ap);
    rows4(Bt + 4096, 8192, 0, tid, bp);
    gemm_tile<true>(ap, bp, 4096, lds, tid, [&](f32x4 (&acc)[8][4], int wr, int wc, int fr, int fq) {
      const int t_ = (wr * 4 + wc) * 64 + fq * 16 + fr;
#pragma unroll
      for (int n = 0; n < 4; ++n) {
        const int ncol = wc * 64 + n * 16 + fq * 4;
        const float4 bv = *(const float4*)(bias + ncol);
#pragma unroll
        for (int m = 0; m < 8; ++m) {
          const int t = rt * 256 + wr * 128 + m * 16 + fr;
          const float4 P = scr[(m * 4 + n) * NTHR + t_];
          uint2 st;
          st.x = pack2((P.x - acc[m][n][0]) * scale + bv.x, (P.y - acc[m][n][1]) * scale + bv.y);
          st.y = pack2((P.z - acc[m][n][2]) * scale + bv.z, (P.w - acc[m][n][3]) * scale + bv.w);
          *(uint2*)(MIX + (long)t * 1024 + 512 + ncol) = st;
          if (t > 0) {
            st.x = pack2((P.x + acc[m][n][0]) * scale + bv.x, (P.y + acc[m][n][1]) * scale + bv.y);
            st.y = pack2((P.z + acc[m][n][2]) * scale + bv.z, (P.w + acc[m][n][3]) * scale + bv.w);
            *(uint2*)(MIX + (long)(SEQ - t) * 1024 + 512 + ncol) = st;
          }
        }
      }
    });
  }
}

DI void four_mid_item(const Params& p, int layer, int b, int tid) {
  const int n = tid >> 1, half = tid & 1;
  const bfraw* v = (const bfraw*)(p.ws + O_VTF) + ((long)b * 256 + n) * 8192 + half * 2048;
  float s = 0.f;
#pragma unroll 4
  for (int k = 0; k < 2048; k += 8) {
    const uint4 u = *(const uint4*)(v + k);
    s += (bflo(u.x) - bfhi(u.x)) + (bflo(u.y) - bfhi(u.y)) + (bflo(u.z) - bfhi(u.z)) + (bflo(u.w) - bfhi(u.w));
  }
  s += __shfl_xor(s, 1);
  if (half == 0) {
    bfraw* MIX = (bfraw*)(p.ws + O_MIX) + ((long)b * SEQ + SEQ / 2) * 1024;
    MIX[512 + n] = f2bf(s * (1.f / 512.f) + p.b_four[layer * 256 + n]);
  }
}

DI void phase_mix(const Params& p, int layer, unsigned* ctr, int* s_item, char* lds, int tid) {
  char* ws = p.ws;
  const int nF = 9, nA = 128, nC = 64;
  const int nFc = (layer == 0) ? 1 : 0, nAc = (layer == 0) ? 8 : 0, nCc = (layer == 0) ? 4 : 0;
  const int n_per = nF + nA + nC + nFc + nAc + nCc;
  XQ q{0, 0, 0, -1};
  while (next_item_x(ctr, n_per, s_item, tid, q)) {
    const int b = q.list;
    int it = q.idx;
    if (it < 8) { four_lat_item(p, layer, b, it, lds, tid); continue; }
    if (it == 8) { four_mid_item(p, layer, b, tid); continue; }
    it -= nF;
    if (it >= nA + nC && it < nA + nC + nFc) { four_item(p, layer, true, b, 0, lds, tid); continue; }
    int kind, h, qb;
    if (it < nA) { kind = 0; h = it >> 4; qb = it & 15; }
    else if (it < nA + nC) { it -= nA; kind = 1; h = it >> 4; qb = it & 15; }
    else {
      it -= nA + nC + nFc;
      if (it < nAc) { kind = 2; h = it; qb = 0; }
      else { it -= nAc; kind = 3; h = it; qb = 0; }
    }
    const bool isA = (kind == 0 || kind == 2), isctx = (kind >= 2);
    const int nh = isA ? 8 : 4;
    const int kvh = isA ? (h >> 2) : (h >> 1);
    const int T = isctx ? CTX : SEQ;
    const long tok0 = (long)b * T + qb * 256;
    const bfraw* Qp = (const bfraw*)(ws + (isA ? (isctx ? O_QAC : O_QA) : (isctx ? O_QCC : O_QC))) + (tok0 * nh + h) * 64;
    const bfraw* Kp = (const bfraw*)(ws + (isA ? O_KA : O_KC)) + (long)(b * 2 + kvh) * KS * 64;
    const bfraw* Vp = (const bfraw*)(ws + (isA ? O_VAT : O_VCT)) + (long)(b * 2 + kvh) * 64 * KS;
    bfraw* Op = (bfraw*)(ws + (isctx ? O_MIXC : O_MIX)) + tok0 * 1024 + (isA ? 0 : 768) + h * 64;
    const float sk = isA ? 0.f : p.sink[layer * 4 + h] * LOG2E;
    if (kind == 1) {
      const int q0 = qb * 256;
      const int lo = (q0 - 128 < 0) ? 0 : q0 - 128;
      const int hi = (q0 + 384 > SEQ) ? SEQ : q0 + 384;
      attn_item<true>(Qp, 256, Kp, Vp, KS, CTX / 64, (CTX + lo) / 64, (hi - lo) / 64, q0, true, sk, Op, 1024, lds, tid);
    } else {
      attn_item<false>(Qp, nh * 64, Kp, Vp, KS, (kind == 0) ? KS / 64 : CTX / 64, 0, 0, 0, !isA, sk, Op, 1024, lds, tid);
    }
  }
}

DI void phase_outproj(const Params& p, int layer, unsigned* ctr, int* s_item, char* lds, int tid) {
  const int n_lat = 128 * 4, n_ctx = (layer == 0) ? 8 * 4 : 0;
  const bfraw* W = (const bfraw*)(p.ws + O_WOUTT) + (long)layer * 1024 * 1024;
  const float* MOD = (const float*)(p.ws + O_MOD);
  (void)n_lat; (void)n_ctx;
  const int n_per = 64 + ((layer == 0) ? 4 : 0);
  XQ q{0, 0, 0, -1};
  while (next_item_s(n_per, tid, q)) {
    const bool is_ctx = q.idx >= 64;
    const int rt = is_ctx ? q.list : (16 * q.list + (q.idx >> 2));
    const int ct = is_ctx ? (q.idx - 64) : (q.idx & 3);
    const int T = is_ctx ? CTX : SEQ;
    const bfraw* A = (const bfraw*)(p.ws + (is_ctx ? O_MIXC : O_MIX));
    const float* xin = is_ctx ? p.ctx : (layer == 0 ? p.x : p.out);
    float* X1 = (float*)(p.ws + (is_ctx ? O_X1C : O_X1));
    const bfraw *ap[4], *bp[4];
    rows4(A, 1024, rt * 256, tid, ap);
    rows4(W, 1024, ct * 256, tid, bp);
    gemm_tile<true>(ap, bp, 1024, lds, tid, [&](f32x4 (&acc)[8][4], int wr, int wc, int fr, int fq) {
      const int rowbase = rt * 256 + wr * 128;
      const int b = is_ctx ? 8 : rowbase / T;
      const float* g1 = MOD + (layer * 9 + b) * 6144 + 2048;
#pragma unroll
      for (int n = 0; n < 4; ++n) {
        const int col = ct * 256 + wc * 64 + n * 16 + fq * 4;
        const float4 gv = *(const float4*)(g1 + col);
#pragma unroll
        for (int m = 0; m < 8; ++m) {
          const long idx = (long)(rowbase + m * 16 + fr) * 1024 + col;
          const float4 xv = *(const float4*)(xin + idx);
          float4 o;
          o.x = ALPHA * xv.x + gv.x * acc[m][n][0];
          o.y = ALPHA * xv.y + gv.y * acc[m][n][1];
          o.z = ALPHA * xv.z + gv.z * acc[m][n][2];
          o.w = ALPHA * xv.w + gv.w * acc[m][n][3];
          *(float4*)(X1 + idx) = o;
        }
      }
    });
  }
}

DI void phase_row(const Params& p, int layer, char* lds, int tid) {
  const int w = tid >> 6, lane = tid & 63;
  float* wrl = (float*)lds;
  __syncthreads();
  {
    const float* wr = p.w_router + (long)layer * 1024 * 16;
    for (int idx = tid; idx < 16384; idx += NTHR) wrl[(idx & 15) * 1024 + (idx >> 4)] = wr[idx];
  }
  __syncthreads();
  const float* MOD = (const float*)(p.ws + O_MOD);
  const int nrows = NT + ((layer == 0) ? NCT : 0);
  const int stride = gridDim.x * NWAVE;
  int row = blockIdx.x * NWAVE + w;
  float nv[16];
  if (row < nrows) {
    const bool c = row >= NT;
    load_row16((const float*)(p.ws + (c ? O_X1C : O_X1)) + (long)(c ? row - NT : row) * 1024, lane, nv);
  }
#pragma unroll 1
  for (; row < nrows; row += stride) {
    const bool is_ctx = row >= NT;
    const int rr = is_ctx ? row - NT : row;
    float* X1 = (float*)(p.ws + (is_ctx ? O_X1C : O_X1)) + (long)rr * 1024;
    bfraw* Hd = (bfraw*)(p.ws + (is_ctx ? O_HC : O_H)) + (long)rr * 1024;
    const int T = is_ctx ? CTX : SEQ;
    const int b = rr / T, t = rr - b * T;
    const float* mr = MOD + (layer * 9 + (is_ctx ? 8 : b)) * 6144;
    float v[16];
#pragma unroll
    for (int i = 0; i < 16; ++i) v[i] = nv[i];
    if (row + stride < nrows) {
      const int nrow = row + stride;
      const bool c = nrow >= NT;
      load_row16((const float*)(p.ws + (c ? O_X1C : O_X1)) + (long)(c ? nrow - NT : nrow) * 1024, lane, nv);
    }
    postnorm16(v, p.ln1_g + layer * 1024, p.ln1_b + layer * 1024, lane);
    store_row16(X1, lane, v);
    modulate16(v, mr + 3072, mr + 4096, lane);
    store_row16_bf(Hd, lane, v);
    float pr[16];
#pragma unroll
    for (int e = 0; e < 16; ++e) {
      float s = 0.f;
#pragma unroll
      for (int i = 0; i < 4; ++i) {
        const float4 wv = *(const float4*)(wrl + e * 1024 + i * 256 + lane * 4);
        s += v[i * 4] * wv.x + v[i * 4 + 1] * wv.y + v[i * 4 + 2] * wv.z + v[i * 4 + 3] * wv.w;
      }
      pr[e] = s;
      asm volatile("" ::: "memory");
    }
    float r8[8], r4[4], r2[2];
    {
      const bool hi = (lane & 32) != 0;
#pragma unroll
      for (int i = 0; i < 8; ++i) { const float a = pr[i], c = pr[i + 8]; r8[i] = (hi ? c : a) + __shfl_xor(hi ? a : c, 32); }
    }
    {
      const bool hi = (lane & 16) != 0;
#pragma unroll
      for (int i = 0; i < 4; ++i) { const float a = r8[i], c = r8[i + 4]; r4[i] = (hi ? c : a) + __shfl_xor(hi ? a : c, 16); }
    }
    {
      const bool hi = (lane & 8) != 0;
#pragma unroll
      for (int i = 0; i < 2; ++i) { const float a = r4[i], c = r4[i + 2]; r2[i] = (hi ? c : a) + __shfl_xor(hi ? a : c, 8); }
    }
    float lg;
    {
      const bool hi = (lane & 4) != 0;
      lg = (hi ? r2[1] : r2[0]) + __shfl_xor(hi ? r2[0] : r2[1], 4);
    }
    lg += __shfl_xor(lg, 2);
    lg += __shfl_xor(lg, 1);
    const int elane = ((lane >> 5) & 1) * 8 + ((lane >> 4) & 1) * 4 + ((lane >> 3) & 1) * 2 + ((lane >> 2) & 1);
    float mx = lg;
    mx = fmaxf(mx, __shfl_xor(mx, 4)); mx = fmaxf(mx, __shfl_xor(mx, 8));
    mx = fmaxf(mx, __shfl_xor(mx, 16)); mx = fmaxf(mx, __shfl_xor(mx, 32));
    const float ex = __expf(lg - mx);
    float den = ex;
    den += __shfl_xor(den, 4); den += __shfl_xor(den, 8); den += __shfl_xor(den, 16); den += __shfl_xor(den, 32);
    const float mine = ex / den;
    if ((lane & 3) == 0) {
      float* AFF = (float*)(p.ws + (is_ctx ? O_AFFC : O_AFF));
      AFF[((long)b * 16 + elane) * T + t] = mine;
    }
  }
}

DI void topk_item(const Params& p, bool is_ctx, int b, int e, char* lds, int tid) {
  const int T = is_ctx ? CTX : SEQ, cap = is_ctx ? CAPC : CAP;
  unsigned* hist = (unsigned*)lds;
  unsigned* sel = hist + 256;
  unsigned* wtot = hist + 264;
  const unsigned* AFF = (const unsigned*)(p.ws + (is_ctx ? O_AFFC : O_AFF)) + ((long)b * 16 + e) * T;
  const int lane = tid & 63, w = tid >> 6;
  const bool have = tid * 8 < T;
  unsigned v[8];
  if (have) {
    const uint4 t0 = *(const uint4*)(AFF + tid * 8), t1 = *(const uint4*)(AFF + tid * 8 + 4);
    v[0] = t0.x; v[1] = t0.y; v[2] = t0.z; v[3] = t0.w; v[4] = t1.x; v[5] = t1.y; v[6] = t1.z; v[7] = t1.w;
  } else {
#pragma unroll
    for (int i = 0; i < 8; ++i) v[i] = 0u;
  }
  unsigned prefix = 0u, kk = (unsigned)cap;
#pragma unroll 1
  for (int pass = 3; pass >= 0; --pass) {
    __syncthreads();
    if (tid < 256) hist[tid] = 0u;
    __syncthreads();
    if (have) {
#pragma unroll
      for (int i = 0; i < 8; ++i) {
        const bool match = (pass == 3) ? true : ((v[i] >> (8 * (pass + 1))) == prefix);
        if (match) atomicAdd(&hist[(v[i] >> (8 * pass)) & 255u], 1u);
      }
    }
    __syncthreads();
    if (tid < 256) {
      unsigned sfx = 0u;
      for (int d = tid + 1; d < 256; ++d) sfx += hist[d];
      const unsigned me = hist[tid];
      if (sfx < kk && sfx + me >= kk) { sel[0] = (unsigned)tid; sel[1] = kk - sfx; }
    }
    __syncthreads();
    prefix = (prefix << 8) | sel[0];
    kk = sel[1];
  }
  const unsigned thr = prefix;
  unsigned cg = 0u, ce = 0u;
  if (have) {
#pragma unroll
    for (int i = 0; i < 8; ++i) { cg += (v[i] > thr); ce += (v[i] == thr); }
  }
  unsigned pk = cg | (ce << 16);
  unsigned inc = pk;
#pragma unroll
  for (int o = 1; o < 64; o <<= 1) {
    const unsigned t = __shfl_up(inc, o);
    if (lane >= o) inc += t;
  }
  __syncthreads();
  if (lane == 63) wtot[w] = inc;
  __syncthreads();
  unsigned base = 0u, total = 0u;
#pragma unroll
  for (int ww = 0; ww < NWAVE; ++ww) { const unsigned t = wtot[ww]; if (ww < w) base += t; total += t; }
  const unsigned excl = base + inc - pk;
  unsigned pos_g = excl & 0xffffu, pos_e = excl >> 16;
  const unsigned n_gt = total & 0xffffu;
  if (have) {
    short* SLOT = (short*)(p.ws + (is_ctx ? O_SLOTC : O_SLOT));
    int* IDX = (int*)(p.ws + (is_ctx ? O_IDXC : O_IDX));
    float* GATE = (float*)(p.ws + (is_ctx ? O_GATEC : O_GATE));
#pragma unroll
    for (int i = 0; i < 8; ++i) {
      const int idx = tid * 8 + i;
      int slot = -1;
      if (v[i] > thr) { slot = (int)pos_g; ++pos_g; }
      else if (v[i] == thr) { if (pos_e < kk) slot = (int)(n_gt + pos_e); ++pos_e; }
      if (slot >= 0) {
        const int prow = (e * 8 + b) * cap + slot;
        IDX[prow] = idx;
        GATE[prow] = __uint_as_float(v[i]);
      }
      SLOT[((long)b * T + idx) * 16 + e] = (short)slot;
    }
  }
}

DI void phase_topk(const Params& p, int layer, char* lds, int tid) {
  const int n_lat = 128, n_ctx = (layer == 0) ? 128 : 0;
  for (int item = blockIdx.x; item < n_lat + n_ctx; item += gridDim.x) {
    int it = item;
    if (it < n_lat) { topk_item(p, false, it >> 4, it & 15, lds, tid); continue; }
    it -= n_lat;
    topk_item(p, true, it >> 4, it & 15, lds, tid);
  }
  if (layer == 1) {
    const int g = gridDim.x;
    for (int i0 = ((int)blockIdx.x + g - 128 % g) % g; i0 < N_EXPCONV; i0 += 2 * g) {
      const int i1 = i0 + g;
      expconv_pair(p, 1, i0, (i1 < N_EXPCONV) ? i1 : -1, lds, tid);
    }
  }
}

template <int VAR = 0>
DI void phase_moe1(const Params& p, int layer, unsigned* ctr, int* s_item, char* lds, int tid) {
  const bfraw* WGU = (const bfraw*)(p.ws + O_WGU);
  const int n_per = 512 + ((layer == 0) ? 32 : 0);
  XQ q{0, 0, 0, -1};
  auto decode = [&](int x, int i, int& e, int& ct, int& rt, bool& is_ctx) {
    is_ctx = i >= 512;
    if (!is_ctx) { e = i >> 5; const int loc = i & 31; rt = 4 * (x & 3) + (loc & 3); ct = 8 * (x >> 2) + (loc >> 2); }
    else { const int g = x * 32 + (i - 512); e = g >> 4; ct = g & 15; rt = 0; }
  };
  auto load_tok = [&](int x, int i, int (&tok)[4]) {
    int e, ct, rt; bool c;
    decode(x, i, e, ct, rt, c);
    const int cap = c ? CAPC : CAP;
    const int* IDX = (const int*)(p.ws + (c ? O_IDXC : O_IDX));
    const int r0 = (tid & 255) >> 2;
#pragma unroll
    for (int k = 0; k < 4; ++k) tok[k] = IDX[e * 8 * cap + rt * 256 + k * 64 + r0];
  };
  int tokn[4] = {0, 0, 0, 0};
  bool have = next_item_s(n_per, tid, q);
  if (have) load_tok(q.list, q.idx, tokn);
  while (have) {
    const int x = q.list, ci = q.idx;
    int e, ct, rt; bool is_ctx;
    decode(x, ci, e, ct, rt, is_ctx);
    const int cap = is_ctx ? CAPC : CAP, T = is_ctx ? CTX : SEQ;
    const bfraw* Hs = (const bfraw*)(p.ws + (is_ctx ? O_HC : O_H));
    bfraw* ACT = (bfraw*)(p.ws + (is_ctx ? O_ACTC : O_ACT));
    const bfraw *ap[4], *bp[4];
    {
      const int r0 = (tid & 255) >> 2, c8 = ((tid & 3) ^ swz4(tid >> 4)) * 8;
#pragma unroll
      for (int i = 0; i < 4; ++i) {
        const int l = rt * 256 + i * 64 + r0;
        ap[i] = Hs + ((long)(l / cap) * T + tokn[i]) * 1024 + c8;
      }
    }
    have = next_item_s(n_per, tid, q);
    if (have) load_tok(q.list, q.idx, tokn);
    rows4(WGU, 1024, e * 4096 + ct * 256, tid, bp);
    const long prow0 = (long)e * 8 * cap + rt * 256;
    gemm_tile<true>(ap, bp, 1024, lds, tid, [&](f32x4 (&acc)[8][4], int wr, int wc, int fr, int fq) {
#pragma unroll
      for (int m = 0; m < 8; ++m)
#pragma unroll
        for (int q = 0; q < 2; ++q) {
          const int f = ct * 128 + wc * 32 + q * 16 + fq * 4;
          if (VAR != 0) {
            if (is_ctx || ct >= 8) continue;
            bfraw* Yd = (bfraw*)(p.ws + O_Y);
            uint2 st;
            st.x = pack2(acc[m][2 * q][0] + acc[m][2 * q + 1][0], acc[m][2 * q][1] + acc[m][2 * q + 1][1]);
            st.y = pack2(acc[m][2 * q][2] + acc[m][2 * q + 1][2], acc[m][2 * q][3] + acc[m][2 * q + 1][3]);
            *(uint2*)(Yd + (prow0 + wr * 128 + m * 16 + fr) * 1024 + f) = st;
            continue;
          }
          float sv[4];
#pragma unroll
          for (int j = 0; j < 4; ++j) {
            const float g = acc[m][2 * q][j], u = acc[m][2 * q + 1][j];
            sv[j] = g * u * __builtin_amdgcn_rcpf(1.f + __builtin_amdgcn_exp2f(-LOG2E * g));
          }
          uint2 st;
          st.x = pack2(sv[0], sv[1]);
          st.y = pack2(sv[2], sv[3]);
          *(uint2*)(ACT + (prow0 + wr * 128 + m * 16 + fr) * FF + f) = st;
        }
    });
  }
}

DI void phase_moe2(const Params& p, int layer, unsigned* ctr, int* s_item, char* lds, int tid) {
  const bfraw* WD = (const bfraw*)(p.ws + O_WD);
  const int n_per = 128 + ((layer == 0) ? 8 : 0);
  XQ q{0, 0, 0, -1};
  while (next_item_s(n_per, tid, q)) {
    const int x = q.list;
    const bool is_ctx = q.idx >= 128;
    const int cap = is_ctx ? CAPC : CAP;
    int e, ct, rt;
    if (!is_ctx) { e = (x >> 2) + 2 * (q.idx >> 4); const int loc = q.idx & 15; rt = 4 * (x & 3) + (loc & 3); ct = loc >> 2; }
    else { const int g = x * 8 + (q.idx - 128); e = g >> 2; ct = g & 3; rt = 0; }
    const bfraw* ACT = (const bfraw*)(p.ws + (is_ctx ? O_ACTC : O_ACT));
    bfraw* Y = (bfraw*)(p.ws + (is_ctx ? O_YC : O_Y));
    const long prow0 = (long)e * 8 * cap + rt * 256;
    const bfraw *ap[4], *bp[4];
    rows4(ACT + prow0 * FF, FF, 0, tid, ap);
    rows4(WD, FF, e * 1024 + ct * 256, tid, bp);
    gemm_tile<true>(ap, bp, FF, lds, tid, [&](f32x4 (&acc)[8][4], int wr, int wc, int fr, int fq) {
#pragma unroll
      for (int m = 0; m < 8; ++m)
#pragma unroll
        for (int n = 0; n < 4; ++n) {
          const int col = ct * 256 + wc * 64 + n * 16 + fq * 4;
          uint2 st;
          st.x = pack2(acc[m][n][0], acc[m][n][1]);
          st.y = pack2(acc[m][n][2], acc[m][n][3]);
          *(uint2*)(Y + (prow0 + wr * 128 + m * 16 + fr) * 1024 + col) = st;
        }
    });
  }
}

DI void phase_combine(const Params& p, int layer, int tid) {
  const int w = tid >> 6, lane = tid & 63;
  const float* MOD = (const float*)(p.ws + O_MOD);
  const int nrows = NT + ((layer == 0) ? NCT : 0);
  const int stride = gridDim.x * NWAVE;
  int row = blockIdx.x * NWAVE + w;
  if (row >= nrows) return;
  uint4 nsl0, nsl1;
  float nv[16];
  {
    const bool c = row >= NT;
    const int r = c ? row - NT : row;
    const short* SL = (const short*)(p.ws + (c ? O_SLOTC : O_SLOT)) + (long)r * 16;
    nsl0 = *(const uint4*)SL; nsl1 = *(const uint4*)(SL + 8);
    load_row16((const float*)(p.ws + (c ? O_X1C : O_X1)) + (long)r * 1024, lane, nv);
  }
#pragma unroll 1
  for (; row < nrows; row += stride) {
    const bool is_ctx = row >= NT;
    const int rr = is_ctx ? row - NT : row;
    const int T = is_ctx ? CTX : SEQ, cap = is_ctx ? CAPC : CAP;
    const int b = rr / T;
    const float* GATE = (const float*)(p.ws + (is_ctx ? O_GATEC : O_GATE));
    const bfraw* Y = (const bfraw*)(p.ws + (is_ctx ? O_YC : O_Y));
    const float* mr = MOD + (layer * 9 + (is_ctx ? 8 : b)) * 6144;
    const uint4 sl0 = nsl0, sl1 = nsl1;
    float v[16];
#pragma unroll
    for (int i = 0; i < 16; ++i) v[i] = nv[i];
    {
      const int nrow = row + stride;
      if (nrow < nrows) {
        const bool c = nrow >= NT;
        const int r = c ? nrow - NT : nrow;
        const short* SL = (const short*)(p.ws + (c ? O_SLOTC : O_SLOT)) + (long)r * 16;
        nsl0 = *(const uint4*)SL; nsl1 = *(const uint4*)(SL + 8);
        load_row16((const float*)(p.ws + (c ? O_X1C : O_X1)) + (long)r * 1024, lane, nv);
      }
    }
    const unsigned slw[8] = {sl0.x, sl0.y, sl0.z, sl0.w, sl1.x, sl1.y, sl1.z, sl1.w};
    float y[16];
#pragma unroll
    for (int i = 0; i < 16; ++i) y[i] = 0.f;
#pragma unroll
    for (int e = 0; e < 16; ++e) {
      const unsigned wd = slw[e >> 1];
      const int sv = (int)(short)((e & 1) ? (wd >> 16) : (wd & 0xffffu));
      if (sv >= 0) {
        const long prow = (long)(e * 8 + b) * cap + sv;
        const float g = GATE[prow];
        const bfraw* yr = Y + prow * 1024;
#pragma unroll
        for (int i = 0; i < 4; ++i) {
          const uint2 u = *(const uint2*)(yr + i * 256 + lane * 4);
          y[i * 4 + 0] += g * bflo(u.x); y[i * 4 + 1] += g * bfhi(u.x);
          y[i * 4 + 2] += g * bflo(u.y); y[i * 4 + 3] += g * bfhi(u.y);
        }
      }
    }
    float g2[16];
    load_row16(mr + 5120, lane, g2);
#pragma unroll
    for (int i = 0; i < 16; ++i) v[i] = ALPHA * v[i] + g2[i] * y[i];
    postnorm16(v, p.ln2_g + layer * 1024, p.ln2_b + layer * 1024, lane);
    if (!is_ctx) store_row16(p.out + (long)rr * 1024, lane, v);
    if (layer == 0) {
      const float* mn = MOD + (1 * 9 + (is_ctx ? 8 : b)) * 6144;
      modulate16(v, mn, mn + 1024, lane);
      store_row16_bf((bfraw*)(p.ws + (is_ctx ? O_HC : O_H)) + (long)rr * 1024, lane, v);
    }
  }
}

#ifndef DUP_MASK
#define DUP_MASK 0
#endif
DI void run_phase(const Params& p, int ph, unsigned* ctr, int* s_item, char* smem, int tid) {
  if (ph == 0) phase_prep(p, smem, tid);
  else if (ph == 1) phase_lnmod0(p, tid);
  else {
    const int layer = (ph - 2) >> 3, sub = (ph - 2) & 7;
    switch (sub) {
      case 0: phase_proj(p, layer, ctr, s_item, smem, tid); break;
      case 1: phase_mix(p, layer, ctr, s_item, smem, tid); break;
      case 2: phase_outproj(p, layer, ctr, s_item, smem, tid); break;
      case 3: phase_row(p, layer, smem, tid); break;
      case 4: phase_topk(p, layer, smem, tid); break;
      case 5: phase_moe1(p, layer, ctr, s_item, smem, tid); break;
      case 6: phase_moe2(p, layer, ctr, s_item, smem, tid); break;
      default: phase_combine(p, layer, tid); break;
    }
  }
}

__global__ void __launch_bounds__(NTHR) fwd_kernel(Params p) {
  extern __shared__ __attribute__((aligned(16))) char smem[];
  __shared__ int s_item;
  __shared__ uint4 xb_words;
  const int wave_id = __builtin_amdgcn_readfirstlane((int)(threadIdx.x >> 6));
  if (threadIdx.x == 0) xb_words = make_uint4(0u, 0u, 0u, 0u);
  __syncthreads();
  unsigned* barw = (unsigned*)(p.ws + O_BAR);
  for (int ph = p.ph_lo; ph < p.ph_hi; ++ph) {
    if (ph > p.ph_lo) {
      if (ph == 1) {
        cg::this_grid().sync();
        int t0;
        asm volatile("v_mbcnt_lo_u32_b32 %0, -1, 0\n\tv_mbcnt_hi_u32_b32 %0, -1, %0" : "=v"(t0));
        xcd_barrier_post(barw, t0 + wave_id * 64);
      } else {
        int t0;
        asm volatile("v_mbcnt_lo_u32_b32 %0, -1, 0\n\tv_mbcnt_hi_u32_b32 %0, -1, %0" : "=v"(t0));
        xcd_barrier(barw, (volatile unsigned*)&xb_words, t0 + wave_id * 64);
      }
    }
    int tid;
    asm volatile("v_mbcnt_lo_u32_b32 %0, -1, 0\n\tv_mbcnt_hi_u32_b32 %0, -1, %0" : "=v"(tid));
    tid += wave_id * 64;
    unsigned* ctr = (unsigned*)(p.ws + O_CTR) + ph * 8;
    run_phase(p, ph, ctr, &s_item, smem, tid);
#ifdef PROBE_VAR
    if (ph >= 2 && ((ph - 2) & 7) == 5) {
      cg::this_grid().sync();
      asm volatile("" : "+v"(tid));
      phase_moe1<PROBE_VAR>(p, (ph - 2) >> 3, ctr + 32 * 8, &s_item, smem, tid);
    }
#endif
#if DUP_MASK
    {
      const int bit = (ph == 0) ? 8 : (ph == 1) ? 9 : ((ph - 2) & 7);
      if ((DUP_MASK >> bit) & 1) {
        cg::this_grid().sync();
        asm volatile("" : "+v"(tid));
        run_phase(p, ph, ctr + 32 * 8, &s_item, smem, tid);
      }
    }
#endif
  }
}

extern "C" void kernel_launch(void* const* d_in, const int* in_sizes, int n_in, void* d_out, int out_size, void* d_ws,
                              size_t ws_size, hipStream_t stream) {
  (void)in_sizes; (void)n_in; (void)out_size;
  if (ws_size < O_END) { fprintf(stderr, "kernel_launch: workspace too small (%zu < %zu)\n", ws_size, (size_t)O_END); return; }
  Params p{};
  const float** pp = (const float**)&p;
  for (int i = 0; i < 21; ++i) pp[i] = (const float*)d_in[i];
  p.out = (float*)d_out;
  p.ws = (char*)d_ws;
  static int grid_blocks = 0;
  if (!grid_blocks) {
    int dev = 0, cus = 0, per_cu = 0;
    hipGetDevice(&dev);
    hipDeviceGetAttribute(&cus, hipDeviceAttributeMultiprocessorCount, dev);
    hipFuncSetAttribute((const void*)fwd_kernel, hipFuncAttributeMaxDynamicSharedMemorySize, LDS_BYTES);
    hipOccupancyMaxActiveBlocksPerMultiprocessor(&per_cu, fwd_kernel, NTHR, LDS_BYTES);
    if (per_cu < 1) per_cu = 1;
    if (per_cu > 1) per_cu = 1;
    grid_blocks = cus * per_cu;
  }
#if ONE_LAUNCH
  p.ph_lo = 0; p.ph_hi = NPHASE;
  void* args[] = {&p};
  hipError_t e = hipLaunchCooperativeKernel((void*)fwd_kernel, dim3(grid_blocks), dim3(NTHR), args, LDS_BYTES, stream);
  if (e != hipSuccess) fprintf(stderr, "cooperative launch failed: %s (grid %d)\n", hipGetErrorString(e), grid_blocks);
#else
  for (int ph = 0; ph < NPHASE; ++ph) {
    p.ph_lo = ph; p.ph_hi = ph + 1;
    hipLaunchKernelGGL(fwd_kernel, dim3(grid_blocks), dim3(NTHR), LDS_BYTES, stream, p);
  }
#endif
}
```

```cpp
#include <hip/hip_runtime.h>
#include <hip/hip_cooperative_groups.h>
#include <cstdio>
namespace cg = cooperative_groups;

#ifndef ONE_LAUNCH
#define ONE_LAUNCH 1
#endif

#define DI __device__ __forceinline__
typedef unsigned short bfraw;
using bf16x8 = __attribute__((ext_vector_type(8))) short;
using f32x4 = __attribute__((ext_vector_type(4))) float;

constexpr int NB = 8, SEQ = 4096, DM = 1024, CTX = 256;
constexpr int NT = NB * SEQ, NCT = NB * CTX;
constexpr int NPROJ = 1792;
constexpr int KS = CTX + SEQ;
constexpr int NE = 16, FF = 2048;
constexpr int CAP = 512, CAPC = 32;
constexpr float ALPHA = 1.41421356237f;
constexpr float LOG2E = 1.44269504089f;
constexpr int NPHASE = 18;
constexpr int NTHR = 512;
constexpr int NWAVE = NTHR / 64;
constexpr int LDS_BYTES = 131072;

constexpr size_t al(size_t x) { return (x + 255) & ~size_t(255); }
constexpr size_t O_MOD = 0;
constexpr size_t O_ROPE = al(O_MOD + 2 * 9 * 6144 * 4);
constexpr size_t O_CTR = al(O_ROPE + 2 * 1024 * 4);
constexpr size_t O_BAR = al(O_CTR + 1024 * 4);
constexpr size_t O_WINT = al(O_BAR + 3456 * 4);
constexpr size_t O_WOUTT = al(O_WINT + 2ull * NPROJ * 1024 * 2);
constexpr size_t O_DFT = al(O_WOUTT + 2ull * 1024 * 1024 * 2);
constexpr size_t O_PSCR = O_DFT + 2ull * 2048 * 4096 * 2;
constexpr size_t O_DFTC = al(O_DFT + 4096ull * 8192 * 2);
constexpr size_t O_WGU = al(O_DFTC + 256ull * 512 * 2);
constexpr size_t O_WD = al(O_WGU + 16ull * 4096 * 1024 * 2);
constexpr size_t O_X1 = al(O_WD + 16ull * 1024 * 2048 * 2);
constexpr size_t O_X1C = al(O_X1 + (size_t)NT * 1024 * 4);
constexpr size_t O_H = al(O_X1C + (size_t)NCT * 1024 * 4);
constexpr size_t O_HC = al(O_H + (size_t)NT * 1024 * 2);
constexpr size_t O_AFF = al(O_HC + (size_t)NCT * 1024 * 2);
constexpr size_t O_AFFC = al(O_AFF + 8ull * 16 * 4096 * 4);
constexpr size_t O_IDX = al(O_AFFC + 8ull * 16 * 256 * 4);
constexpr size_t O_GATE = al(O_IDX + 16ull * 8 * 512 * 4);
constexpr size_t O_SLOT = al(O_GATE + 16ull * 8 * 512 * 4);
constexpr size_t O_IDXC = al(O_SLOT + 8ull * 4096 * 16 * 2);
constexpr size_t O_GATEC = al(O_IDXC + 16ull * 8 * 32 * 4);
constexpr size_t O_SLOTC = al(O_GATEC + 16ull * 8 * 32 * 4);
constexpr size_t O_Y = al(O_SLOTC + 8ull * 256 * 16 * 2);
constexpr size_t O_YC = al(O_Y + 65536ull * 1024 * 2);
constexpr size_t O_ACTC = al(O_YC + 4096ull * 1024 * 2);
constexpr size_t O_R = al(O_ACTC + 4096ull * 2048 * 2);
constexpr size_t O_ACT = O_R;
constexpr size_t O_QA = O_R;
constexpr size_t O_QC = al(O_QA + (size_t)NT * 512 * 2);
constexpr size_t O_KA = al(O_QC + (size_t)NT * 256 * 2);
constexpr size_t O_VAT = al(O_KA + 8ull * 2 * KS * 64 * 2);
constexpr size_t O_KC = al(O_VAT + 8ull * 2 * KS * 64 * 2);
constexpr size_t O_VCT = al(O_KC + 8ull * 2 * KS * 64 * 2);
constexpr size_t O_VTF = al(O_VCT + 8ull * 2 * KS * 64 * 2);
constexpr size_t O_MIX = al(O_VTF + 8ull * 256 * 8192 * 2);
constexpr size_t O_QAC = al(O_MIX + (size_t)NT * 1024 * 2);
constexpr size_t O_QCC = al(O_QAC + (size_t)NCT * 512 * 2);
constexpr size_t O_VTFC = al(O_QCC + (size_t)NCT * 256 * 2);
constexpr size_t O_MIXC = al(O_VTFC + 8ull * 256 * 512 * 2);
constexpr size_t O_REND = al(O_MIXC + (size_t)NCT * 1024 * 2);
constexpr size_t O_END = O_R + 65536ull * 2048 * 2;
static_assert(O_REND <= O_END, "mixer buffers must fit in the ACT region");
static_assert(O_END <= 1073741824ull, "workspace too large");

struct Params {
  const float *x, *c, *ctx, *c_ctx, *w_mod, *b_mod, *w_in, *q_norm, *k_norm, *w_four, *b_four, *sink, *w_out,
      *ln1_g, *ln1_b, *w_router, *w_gate, *w_up, *w_down, *ln2_g, *ln2_b;
  float* out;
  char* ws;
  int ph_lo, ph_hi;
};

typedef __bf16 hwbf2 __attribute__((ext_vector_type(2)));
typedef float hwf2 __attribute__((ext_vector_type(2)));
DI unsigned pack2(float a, float b) {
  hwf2 f = {a, b};
  return __builtin_bit_cast(unsigned, __builtin_convertvector(f, hwbf2));
}
DI bfraw f2bf(float x) { return (bfraw)(pack2(x, 0.f) & 0xffffu); }
DI float bflo(unsigned u) { return __uint_as_float(u << 16); }
DI float bfhi(unsigned u) { return __uint_as_float(u & 0xffff0000u); }
DI float wsum(float v) {
#pragma unroll
  for (int o = 32; o; o >>= 1) v += __shfl_xor(v, o);
  return v;
}
DI void glds16(const void* g, char* l) {
  __builtin_amdgcn_global_load_lds((const unsigned*)g, (unsigned*)l, 16, 0, 0);
}
DI void wait_vm0() { asm volatile("s_waitcnt vmcnt(0)" ::: "memory"); }
DI f32x4 mfma16(bf16x8 a, bf16x8 b, f32x4 c) { return __builtin_amdgcn_mfma_f32_16x16x32_bf16(a, b, c, 0, 0, 0); }

DI int swz4(int q) { return (-q) & 3; }

struct XQ { int kk; int list; int idx; int wv; };
DI bool next_item_s(int n_per, int& tid, XQ& q) {
  if (q.wv < 0) { q.wv = __builtin_amdgcn_readfirstlane(tid >> 6); q.idx = (int)(blockIdx.x >> 3); q.list = (int)(blockIdx.x & 7); }
  else q.idx += (int)((gridDim.x + 7 - (blockIdx.x & 7)) >> 3);
  asm volatile("v_mbcnt_lo_u32_b32 %0, -1, 0\n\tv_mbcnt_hi_u32_b32 %0, -1, %0" : "=v"(tid));
  tid += q.wv * 64;
  return q.idx < n_per;
}
DI bool next_item_x(unsigned* ctr, int n_per, int* s_item, int& tid, XQ& q) {
  if (q.wv < 0) q.wv = __builtin_amdgcn_readfirstlane(tid >> 6);
  asm volatile("v_mbcnt_lo_u32_b32 %0, -1, 0\n\tv_mbcnt_hi_u32_b32 %0, -1, %0" : "=v"(tid));
  tid += q.wv * 64;
  for (;;) {
    if (q.kk >= 8) return false;
    q.list = ((int)(__builtin_amdgcn_s_getreg(20 | (3 << 11)) & 7) + q.kk) & 7;
    __syncthreads();
    if (tid == 0) *s_item = (int)atomicAdd(ctr + q.list, 1u);
    __syncthreads();
    q.idx = *s_item;
    if (q.idx < n_per) return true;
    ++q.kk;
  }
}

#define XB_TMO      128
#define XB_XCNT(j)  (256  + 64 * (j))
#define XB_XSUB(j)  (1280 + 64 * (j))
#define XB_XGEN(j)  (2304 + 64 * (j))
#define XB_TOP      3328
#define XB_TOPGEN   3392
#define XCD_BAR_WORDS 3456
#define XB_SPIN_CAP (1u << 18)
DI unsigned xb_ld(unsigned* p) { return __hip_atomic_load(p, __ATOMIC_RELAXED, __HIP_MEMORY_SCOPE_AGENT); }
DI unsigned xb_add(unsigned* p, unsigned v) { return __hip_atomic_fetch_add(p, v, __ATOMIC_RELAXED, __HIP_MEMORY_SCOPE_AGENT); }
DI unsigned xb_xcc_id() { return (unsigned)__builtin_amdgcn_s_getreg((3 << 11) | 20) & 0xFu; }
#define XB_SPIN(cond, bar) do { unsigned _sp = 0; while (cond) { __builtin_amdgcn_s_sleep(1); \
    if ((++_sp & 255u) == 0u) { if (xb_ld(&(bar)[XB_TMO])) break; if (_sp > XB_SPIN_CAP) { atomicAdd(&(bar)[XB_TMO], 1u); break; } } } } while (0)

DI void xcd_barrier_post(unsigned* bar, int tid) {
  if (tid == 0) (void)xb_add(&bar[XB_XCNT(xb_xcc_id())], 1u);
}
DI void xcd_barrier_complete(unsigned* bar, unsigned x, unsigned& nloc, unsigned& nx) {
  const unsigned G = gridDim.x;
  unsigned sum, cnt, mine, sp = 0u;
  for (;;) {
    sum = 0u; cnt = 0u; mine = 0u;
#pragma unroll
    for (unsigned j = 0; j < 16; ++j) { const unsigned c = xb_ld(&bar[XB_XCNT(j)]); sum += c; cnt += (c > 0u) ? 1u : 0u; mine = (j == x) ? c : mine; }
    if (sum == G) break;
    __builtin_amdgcn_s_sleep(1);
    if ((++sp & 255u) == 0u) { if (xb_ld(&bar[XB_TMO])) break; if (sp > XB_SPIN_CAP) { atomicAdd(&bar[XB_TMO], 1u); break; } }
  }
  nloc = mine > 0u ? mine : 1u; nx = cnt > 0u ? cnt : 1u;
}
DI void xcd_barrier(unsigned* bar, volatile unsigned* st, int tid) {
  asm volatile("s_waitcnt vmcnt(0)" ::: "memory");
  __syncthreads();
  if (tid == 0) {
    const unsigned x = xb_xcc_id();
    __builtin_amdgcn_s_waitcnt(0);
    unsigned nloc = st[0], nx = st[1];
    if (nloc == 0u) { xcd_barrier_complete(bar, x, nloc, nx); st[0] = nloc; st[1] = nx; }
    const unsigned old = xb_add(&bar[XB_XSUB(x)], 1u);
    const unsigned gen = old / nloc;
    if (old + 1u == (gen + 1u) * nloc) {
      __builtin_amdgcn_fence(__ATOMIC_RELEASE, "agent");
      asm volatile("s_waitcnt vmcnt(0)" ::: "memory");
      const unsigned og = xb_add(&bar[XB_TOP], 1u);
      const unsigned tg = og / nx;
      if (og + 1u == (tg + 1u) * nx) xb_add(&bar[XB_TOPGEN], 1u);
      else XB_SPIN(xb_ld(&bar[XB_TOPGEN]) == tg, bar);
      __builtin_amdgcn_fence(__ATOMIC_ACQUIRE, "agent");
      xb_add(&bar[XB_XGEN(x)], 1u);
      asm volatile("s_waitcnt vmcnt(0)" ::: "memory");
    } else {
      XB_SPIN(xb_ld(&bar[XB_XGEN(x)]) == gen, bar);
      __builtin_amdgcn_fence(__ATOMIC_ACQUIRE, "agent");
      asm volatile("s_waitcnt vmcnt(0)" ::: "memory");
    }
  }
  __syncthreads();
}

DI void rows4(const bfraw* base, long ld, int row0, int tid, const bfraw* (&out)[4]) {
  const int r0 = (tid & 255) >> 2, c8 = ((tid & 3) ^ swz4(tid >> 4)) * 8;
#pragma unroll
  for (int i = 0; i < 4; ++i) out[i] = base + (long)(row0 + i * 64 + r0) * ld + c8;
}
DI void gemm_stage(const bfraw* const (&ap)[4], const bfraw* const (&bp)[4], int k0, char* st, int tid) {
  const int t = tid & 255;
#pragma unroll
  for (int i = 0; i < 4; ++i) {
    glds16(ap[i] + k0, st + (i * 256 + t) * 16);
    glds16(bp[i] + k0, st + 16384 + (i * 256 + t) * 16);
  }
}

template <bool SWAP, int VAR = 0, class Epi>
DI void gemm_tile(const bfraw* const (&ap)[4], const bfraw* const (&bp)[4], int K, char* lds, int tid, Epi epi) {
  asm volatile("" : "+v"(tid));
  const int w = tid >> 6, lane = tid & 63, wr = w >> 2, wc = w & 3, fr = lane & 15, fq = lane >> 4;
  const bool loader = w < 4;
  f32x4 acc[8][4];
#pragma unroll
  for (int m = 0; m < 8; ++m)
#pragma unroll
    for (int n = 0; n < 4; ++n) acc[m][n] = f32x4{0.f, 0.f, 0.f, 0.f};
  const int ns = K >> 5;
  __syncthreads();
  if (loader) {
    gemm_stage(ap, bp, 0, lds, tid);
    gemm_stage(ap, bp, 32, lds + 32768, tid);
    gemm_stage(ap, bp, 64, lds + 65536, tid);
  }
  asm volatile("s_waitcnt vmcnt(16)" ::: "memory");
  __builtin_amdgcn_s_barrier();
  asm volatile("" ::: "memory");
  const int aoff = (wr * 128 + fr) * 64 + (fq ^ swz4(fr >> 2)) * 16;
  const int boff = 16384 + (wc * 64 + fr) * 64 + (fq ^ swz4(fr >> 2)) * 16;
  const int t = tid & 255;
#pragma unroll 1
  for (int j = 0; j < ns; ++j) {
    const char* st = lds + (j & 3) * 32768;
    bf16x8 bfr[4], af[8];
#pragma unroll
    for (int n = 0; n < 4; ++n) bfr[n] = *(const bf16x8*)(st + boff + n * 1024);
#pragma unroll
    for (int m = 0; m < 8; ++m) af[m] = *(const bf16x8*)(st + aoff + m * 1024);
    if (j + 1 < ns) {
      if (j + 2 < ns) asm volatile("s_waitcnt vmcnt(8)" ::: "memory");
      else asm volatile("s_waitcnt vmcnt(0)" ::: "memory");
      __builtin_amdgcn_s_barrier();
      asm volatile("" ::: "memory");
    }
    const bool issue = loader && (j + 3 < ns);
    char* nst = lds + ((j + 3) & 3) * 32768;
    const int nk0 = (j + 3) * 32;
#pragma unroll
    for (int c = 0; c < 4; ++c) {
#pragma unroll
      for (int m = 2 * c; m < 2 * c + 2; ++m)
#pragma unroll
        for (int n = 0; n < 4; ++n) acc[m][n] = SWAP ? mfma16(bfr[n], af[m], acc[m][n]) : mfma16(af[m], bfr[n], acc[m][n]);
      __builtin_amdgcn_sched_barrier(0);
      if (issue) {
        glds16(ap[c] + nk0, nst + (c * 256 + t) * 16);
        glds16(bp[c] + nk0, nst + 16384 + (c * 256 + t) * 16);
      }
      __builtin_amdgcn_sched_barrier(0);
    }
  }
  epi(acc, wr, wc, fr, fq);
}

DI void attn_stage(const bfraw* Kp, const bfraw* VTp, int ldv, int tile, char* st, int tid) {
  const int slot0 = tile * 64;
  const int h = tid >> 8, r = (tid & 255) >> 2;
  const int ck = ((tid & 3) ^ swz4(r >> 3)) * 8;
  const int cv = ((tid & 3) ^ swz4(r >> 2)) * 8;
  glds16(Kp + (long)(slot0 + r) * 64 + h * 32 + ck, st + tid * 16);
  glds16(VTp + (long)r * ldv + slot0 + h * 32 + cv, st + 8192 + tid * 16);
}

template <bool WINDOW>
DI void attn_item(const bfraw* Qp, int qstride, const bfraw* Kp, const bfraw* VTp, int ldv, int n1, int tlo, int n2,
                  int qpos0, bool has_sink, float sink_l2, bfraw* Op, int ostride, char* lds, int tid) {
  asm volatile("" : "+v"(tid));
  const int w = tid >> 6, lane = tid & 63, fr = lane & 15, fq = lane >> 4;
  const float scale_l2 = 0.125f * LOG2E;
  bf16x8 qf[2][2];
#pragma unroll
  for (int n = 0; n < 2; ++n)
#pragma unroll
    for (int sd = 0; sd < 2; ++sd)
      qf[n][sd] = *(const bf16x8*)(Qp + (long)(w * 32 + n * 16 + fr) * qstride + sd * 32 + fq * 8);
  float m_run[2];
  f32x4 o[4][2], ol[2];
#pragma unroll
  for (int n = 0; n < 2; ++n) {
    m_run[n] = has_sink ? sink_l2 : -1e30f;
    const float l0 = has_sink ? 1.f : 0.f;
    ol[n] = f32x4{l0, l0, l0, l0};
#pragma unroll
    for (int md = 0; md < 4; ++md) o[md][n] = f32x4{0.f, 0.f, 0.f, 0.f};
  }
  const bf16x8 ones = bf16x8{(short)0x3F80, (short)0x3F80, (short)0x3F80, (short)0x3F80, (short)0x3F80, (short)0x3F80, (short)0x3F80, (short)0x3F80};
  const int nt = n1 + n2;
  __syncthreads();
  attn_stage(Kp, VTp, ldv, (0 < n1) ? 0 : tlo, lds, tid);
#pragma unroll 1
  for (int it = 0; it < nt; ++it) {
    wait_vm0();
    __syncthreads();
    const bool dma_next = it + 1 < nt;
    const int nx_tile = (it + 1 < n1) ? it + 1 : tlo + (it + 1 - n1);
    if (dma_next && w < 4) attn_stage(Kp, VTp, ldv, nx_tile, lds + ((it + 1) & 1) * 16384, tid);
    const char* sK = lds + (it & 1) * 16384;
    const char* sV = sK + 8192;
    f32x4 s[4][2];
#pragma unroll
    for (int m = 0; m < 4; ++m)
#pragma unroll
      for (int n = 0; n < 2; ++n) s[m][n] = f32x4{0.f, 0.f, 0.f, 0.f};
#pragma unroll
    for (int sd = 0; sd < 2; ++sd) {
#pragma unroll
      for (int m = 0; m < 4; ++m) {
        const int krow = (m >> 1) * 32 + (fr >> 2) * 8 + (m & 1) * 4 + (fr & 3);
        bf16x8 kf = *(const bf16x8*)(sK + sd * 4096 + krow * 64 + (fq ^ swz4(fr >> 2)) * 16);
#pragma unroll
        for (int n = 0; n < 2; ++n) s[m][n] = mfma16(kf, qf[n][sd], s[m][n]);
      }
    }
    if (dma_next && w >= 4) attn_stage(Kp, VTp, ldv, nx_tile, lds + ((it + 1) & 1) * 16384, tid);
    const int tile = (it < n1) ? it : tlo + (it - n1);
    const bool domask = WINDOW && (it >= n1);
    float mxs2[2];
#pragma unroll
    for (int n = 0; n < 2; ++n) {
      if (domask) {
        const int qpos = qpos0 + w * 32 + n * 16 + fr;
#pragma unroll
        for (int m = 0; m < 4; ++m)
#pragma unroll
          for (int j = 0; j < 4; ++j) {
            const int kpos = tile * 64 - CTX + (m >> 1) * 32 + fq * 8 + (m & 1) * 4 + j;
            const int d = qpos - kpos;
            if (d > 128 || d < -128) s[m][n][j] = -1e30f;
          }
      }
      float mx = -1e30f;
#pragma unroll
      for (int m = 0; m < 4; ++m) {
        mx = fmaxf(mx, fmaxf(s[m][n][0], s[m][n][1]));
        mx = fmaxf(mx, fmaxf(s[m][n][2], s[m][n][3]));
      }
      mxs2[n] = mx;
    }
    mxs2[0] *= scale_l2; mxs2[1] *= scale_l2;
    if (__any((mxs2[0] > m_run[0] + 8.f) || (mxs2[1] > m_run[1] + 8.f))) {
      {
        const float t0 = __shfl_xor(mxs2[0], 16), t1 = __shfl_xor(mxs2[1], 16);
        mxs2[0] = fmaxf(mxs2[0], t0); mxs2[1] = fmaxf(mxs2[1], t1);
        const float u0 = __shfl_xor(mxs2[0], 32), u1 = __shfl_xor(mxs2[1], 32);
        mxs2[0] = fmaxf(mxs2[0], u0); mxs2[1] = fmaxf(mxs2[1], u1);
      }
#pragma unroll
      for (int n = 0; n < 2; ++n) {
        const bool need = mxs2[n] > m_run[n] + 8.f;
        const float m_new = need ? mxs2[n] : m_run[n];
        const float alpha = __builtin_amdgcn_exp2f(m_run[n] - m_new);
        m_run[n] = m_new;
        ol[n][0] *= alpha; ol[n][1] *= alpha; ol[n][2] *= alpha; ol[n][3] *= alpha;
#pragma unroll
        for (int md = 0; md < 4; ++md) {
          o[md][n][0] *= alpha; o[md][n][1] *= alpha; o[md][n][2] *= alpha; o[md][n][3] *= alpha;
        }
      }
    }
#pragma unroll
    for (int n = 0; n < 2; ++n) {
      const float nm = -m_run[n];
#pragma unroll
      for (int m = 0; m < 4; ++m)
#pragma unroll
        for (int j = 0; j < 4; ++j) s[m][n][j] = __builtin_amdgcn_exp2f(__builtin_fmaf(s[m][n][j], scale_l2, nm));
    }
#pragma unroll
    for (int ks = 0; ks < 2; ++ks) {
      bf16x8 pf[2];
#pragma unroll
      for (int n = 0; n < 2; ++n) {
        const unsigned u0 = pack2(s[2 * ks][n][0], s[2 * ks][n][1]);
        const unsigned u1 = pack2(s[2 * ks][n][2], s[2 * ks][n][3]);
        const unsigned u2 = pack2(s[2 * ks + 1][n][0], s[2 * ks + 1][n][1]);
        const unsigned u3 = pack2(s[2 * ks + 1][n][2], s[2 * ks + 1][n][3]);
        const uint4 uu = make_uint4(u0, u1, u2, u3);
        pf[n] = __builtin_bit_cast(bf16x8, uu);
      }
#pragma unroll
      for (int md = 0; md < 4; ++md) {
        bf16x8 vf = *(const bf16x8*)(sV + ks * 4096 + (md * 16 + fr) * 64 + (fq ^ swz4(fr >> 2)) * 16);
#pragma unroll
        for (int n = 0; n < 2; ++n) o[md][n] = mfma16(vf, pf[n], o[md][n]);
      }
#pragma unroll
      for (int n = 0; n < 2; ++n) ol[n] = mfma16(ones, pf[n], ol[n]);
    }
  }
#pragma unroll
  for (int n = 0; n < 2; ++n) {
    const float inv = 1.f / ol[n][0];
    bfraw* orow = Op + (long)(w * 32 + n * 16 + fr) * ostride;
#pragma unroll
    for (int md = 0; md < 4; ++md) {
      uint2 st;
      st.x = pack2(o[md][n][0] * inv, o[md][n][1] * inv);
      st.y = pack2(o[md][n][2] * inv, o[md][n][3] * inv);
      *(uint2*)(orow + md * 16 + fq * 4) = st;
    }
  }
}

DI void xpose_tile(const float* src, long ld_src, bfraw* dst, long ld_dst, int mode, char* lds, int tid) {
  float(*t)[65] = (float(*)[65])lds;
  __syncthreads();
  {
    const int c = tid & 63, r0 = tid >> 6;
#pragma unroll 4
    for (int rr = r0; rr < 64; rr += NWAVE) t[rr][c] = src[(long)rr * ld_src + c];
  }
  __syncthreads();
  {
    const int k8 = (tid & 7) * 8, nn = tid >> 3;
    uint4 v;
    v.x = pack2(t[k8 + 0][nn], t[k8 + 1][nn]);
    v.y = pack2(t[k8 + 2][nn], t[k8 + 3][nn]);
    v.z = pack2(t[k8 + 4][nn], t[k8 + 5][nn]);
    v.w = pack2(t[k8 + 6][nn], t[k8 + 7][nn]);
    const int row = (mode == 0) ? nn : ((nn >> 4) * 32 + (mode == 2 ? 16 : 0) + (nn & 15));
    *(uint4*)(dst + (long)row * ld_dst + k8) = v;
  }
}

DI void xpose256x2(const float* s0, long ls0, bfraw* d0, long ld0, int m0,
                   const float* s1, long ls1, bfraw* d1, long ld1, int m1, bool two, char* lds, int tid) {
  const int w = tid >> 6, lane = tid & 63;
  float4 vA[8], vB[8];
#pragma unroll
  for (int i = 0; i < 8; ++i) {
    const int k = 2 * (w + 8 * (i >> 1)) + (i & 1);
    vA[i] = *(const float4*)(s0 + (long)k * ls0 + lane * 4);
  }
#pragma unroll
  for (int i = 0; i < 8; ++i) {
    const int k = 2 * (w + 8 * (i >> 1)) + (i & 1);
    vB[i] = *(const float4*)(s1 + (long)k * ls1 + lane * 4);
  }
#pragma unroll
  for (int half = 0; half < 2; ++half) {
    if (half == 1 && !two) break;
    __syncthreads();
#pragma unroll
    for (int i2 = 0; i2 < 4; ++i2) {
      const int k = 2 * (w + 8 * i2);
      char* base = lds + (lane * 4) * 136 + k * 2;
      const float4 e0 = half ? vB[2 * i2] : vA[2 * i2], e1 = half ? vB[2 * i2 + 1] : vA[2 * i2 + 1];
      *(unsigned*)(base + 0 * 136) = pack2(e0.x, e1.x);
      *(unsigned*)(base + 1 * 136) = pack2(e0.y, e1.y);
      *(unsigned*)(base + 2 * 136) = pack2(e0.z, e1.z);
      *(unsigned*)(base + 3 * 136) = pack2(e0.w, e1.w);
    }
    __syncthreads();
    bfraw* dst = half ? d1 : d0;
    const long ld_dst = half ? ld1 : ld0;
    const int mode = half ? m1 : m0;
#pragma unroll
    for (int q = 0; q < 4; ++q) {
      const int c = tid + NTHR * q;
      const int n = c >> 3, k8 = (c & 7) * 8;
      const uint2 lo = *(const uint2*)(lds + n * 136 + k8 * 2);
      const uint2 hi = *(const uint2*)(lds + n * 136 + k8 * 2 + 8);
      const int row = (mode == 0) ? n : ((n >> 4) * 32 + (mode == 2 ? 16 : 0) + (n & 15));
      *(uint4*)(dst + (long)row * ld_dst + k8) = make_uint4(lo.x, lo.y, hi.x, hi.y);
    }
  }
}

constexpr int N_EXPCONV = 4096 + 2048;
DI void expconv_decode(const Params& p, int layer, int item, const float*& src, long& ld_src, bfraw*& dst, long& ld_dst, int& mode) {
  bfraw* WGU = (bfraw*)(p.ws + O_WGU);
  bfraw* WD = (bfraw*)(p.ws + O_WD);
  if (item < 4096) {
    const int type = item & 1;
    int r = item >> 1;
    const int nt = r & 7; r >>= 3;
    const int kt = r & 15; const int e = r >> 4;
    src = (type ? p.w_up : p.w_gate) + ((long)(layer * NE + e) * DM + kt * 64) * FF + nt * 256;
    ld_src = FF;
    dst = WGU + ((long)e * 4096 + nt * 512) * DM + kt * 64;
    ld_dst = DM; mode = 1 + type;
  } else {
    int r = item - 4096;
    const int nt = r & 3; r >>= 2;
    const int kt = r & 31; const int e = r >> 5;
    src = p.w_down + ((long)(layer * NE + e) * FF + kt * 64) * DM + nt * 256;
    ld_src = DM;
    dst = WD + ((long)e * DM + nt * 256) * FF + kt * 64;
    ld_dst = FF; mode = 0;
  }
}
DI void expconv_pair(const Params& p, int layer, int i0, int i1, char* lds, int tid) {
  const float *s0, *s1; long ls0, ls1, ld0, ld1; bfraw *d0, *d1; int m0, m1;
  expconv_decode(p, layer, i0, s0, ls0, d0, ld0, m0);
  expconv_decode(p, layer, (i1 >= 0) ? i1 : i0, s1, ls1, d1, ld1, m1);
  xpose256x2(s0, ls0, d0, ld0, m0, s1, ls1, d1, ld1, m1, i1 >= 0, lds, tid);
}

DI void prep_mod_item(const Params& p, int item, char* lds, int tid) {
  const int layer = item / 96, chunk = item % 96;
  float* sc = (float*)lds;
  float* red = (float*)(lds + 36864);
  __syncthreads();
  for (int idx = tid; idx < 9 * 1024; idx += NTHR) {
    const int r = idx >> 10, k = idx & 1023;
    const float v = (r < 8) ? p.c[r * 1024 + k] : p.c_ctx[k];
    sc[idx] = v / (1.f + __expf(-v));
  }
  __syncthreads();
  const int w = tid >> 6, lane = tid & 63;
  const int col = chunk * 64 + lane;
  float acc[9];
#pragma unroll
  for (int r = 0; r < 9; ++r) acc[r] = 0.f;
  const float* wp = p.w_mod + ((long)layer * 1024 + w * 128) * 6144 + col;
#pragma unroll 4
  for (int k = 0; k < 128; ++k) {
    const float wv = wp[(long)k * 6144];
#pragma unroll
    for (int r = 0; r < 9; ++r) acc[r] += sc[r * 1024 + w * 128 + k] * wv;
  }
#pragma unroll
  for (int r = 0; r < 9; ++r) red[(w * 9 + r) * 64 + lane] = acc[r];
  __syncthreads();
  float* MOD = (float*)(p.ws + O_MOD);
  for (int idx = tid; idx < 9 * 64; idx += NTHR) {
    const int r = idx >> 6, l = idx & 63;
    float s = p.b_mod[layer * 6144 + chunk * 64 + l];
#pragma unroll
    for (int ww = 0; ww < NWAVE; ++ww) s += red[(ww * 9 + r) * 64 + l];
    MOD[(layer * 9 + r) * 6144 + chunk * 64 + l] = s;
  }
}

DI void prep_four_item(const Params& p, int item, char* lds, int tid) {
  const int layer = item >> 6, g = (item >> 4) & 3, kt = item & 15;
  float* G = (float*)lds;
  float(*Wt)[65] = (float(*)[65])(lds + 32768);
  float* ctab = (float*)(lds + 32768 + 64 * 65 * 4);
  __syncthreads();
  const float* wg = p.w_four + (long)(layer * 4 + g) * 4096;
  for (int idx = tid; idx < 4096; idx += NTHR) Wt[idx >> 6][idx & 63] = wg[idx];
  if (tid < 64) {
    float sn, cs;
    sincospif((float)tid / 32.f, &sn, &cs);
    ctab[tid] = cs;
    ctab[64 + tid] = sn;
  }
  __syncthreads();
  for (int o = tid; o < 4096; o += NTHR) {
    const int c = o >> 6, d = o & 63;
    float s1 = 0.f, s2 = 0.f;
#pragma unroll 4
    for (int c2 = 0; c2 < 64; ++c2) {
      const int a = (c * c2) & 63;
      const float wv = Wt[c2][d];
      s1 += ctab[a] * wv;
      s2 += ctab[64 + a] * wv;
    }
    G[o] = s1;
    G[4096 + o] = s2;
  }
  __syncthreads();
  const float* wi = p.w_in + ((long)layer * 1024 + kt * 64) * 1536 + 768 + g * 64;
  for (int idx = tid; idx < 4096; idx += NTHR) Wt[idx >> 6][idx & 63] = wi[(long)(idx >> 6) * 1536 + (idx & 63)];
  __syncthreads();
  bfraw* WINT = (bfraw*)(p.ws + O_WINT) + (long)layer * NPROJ * 1024;
  for (int o = tid; o < 64 * 128; o += NTHR) {
    const int kk = o & 63, dcol = o >> 6;
    const float* Gs = G + (dcol >> 6) * 4096 + (dcol & 63);
    float s = 0.f;
#pragma unroll 4
    for (int c = 0; c < 64; ++c) s += Wt[kk][c] * Gs[c * 64];
    const int row = (dcol < 64) ? (768 + g * 64 + dcol) : (1024 + g * 64 + (dcol - 64));
    WINT[(long)row * 1024 + kt * 64 + kk] = f2bf(s);
  }
}

constexpr int P0_MOD = 192, P0_FOUR = 128, P0_ROPE = 1, P0_DFTC = 256, P0_DFT = 4096, P0_WIN = 2 * 16 * 24, P0_WOUT = 2 * 16 * 16;
constexpr int P0_TOTAL = P0_MOD + P0_FOUR + P0_ROPE + P0_DFTC + P0_DFT + P0_WIN + P0_WOUT + N_EXPCONV;

DI void phase_prep(const Params& p, char* lds, int tid) {
  if (blockIdx.x == 0) { ((unsigned*)(p.ws + O_CTR))[tid] = 0u; ((unsigned*)(p.ws + O_CTR))[NTHR + tid] = 0u; }
  if (blockIdx.x == 0) { unsigned* bw = (unsigned*)(p.ws + O_BAR); for (int i = tid; i < XCD_BAR_WORDS; i += NTHR) bw[i] = 0u; }
  constexpr int P0_BASE = P0_TOTAL - N_EXPCONV;
  for (int item = blockIdx.x; item < P0_BASE; item += gridDim.x) {
    int it = item;
    if (it < P0_MOD) { prep_mod_item(p, it, lds, tid); continue; }
    it -= P0_MOD;
    if (it < P0_FOUR) { prep_four_item(p, it, lds, tid); continue; }
    it -= P0_FOUR;
    if (it < P0_ROPE) {
      float* rope = (float*)(p.ws + O_ROPE);
      for (int idx = tid; idx < 1024; idx += NTHR) {
        const int pos = idx >> 4, f = idx & 15;
        const float inv_freq = powf(10000.f, -(float)f / 16.f);
        const float ang = (float)pos * inv_freq;
        rope[idx] = cosf(ang);
        rope[1024 + idx] = sinf(ang);
      }
      continue;
    }
    it -= P0_ROPE;
    if (it < P0_DFTC) {
      bfraw* D = (bfraw*)(p.ws + O_DFTC) + (long)it * 512;
      for (int k = tid; k < 512; k += NTHR) {
        const int kk = k & 255;
        float sn, cs;
        sincospif((float)((it * kk) & 255) / 128.f, &sn, &cs);
        D[k] = f2bf(k < 256 ? cs : -sn);
      }
      continue;
    }
    it -= P0_DFTC;
    if (it < P0_DFT) {
      const int t = it & 2047;
      bfraw* D = (bfraw*)(p.ws + O_DFT) + (long)it * 4096;
      for (int ch = tid; ch < 2048; ch += NTHR) {
        const int k = ch * 2;
        float sn0, cs0, sn1, cs1;
        sincospif((float)((t * k) & 4095) / 2048.f, &sn0, &cs0);
        sincospif((float)((t * (k + 1)) & 4095) / 2048.f, &sn1, &cs1);
        *(unsigned*)(D + k) = (it < 2048) ? pack2(cs0, cs1) : pack2(sn0, sn1);
      }
      continue;
    }
    it -= P0_DFT;
    if (it < P0_WIN) {
      const int layer = it / 384, r = it % 384, kt = r / 24, nt = r % 24;
      if (nt >= 12 && nt < 16) continue;
      const int col = nt * 64;
      int drow;
      if (col < 768) drow = col;
      else if (col < 1152) drow = col + 256;
      else if (col < 1280) drow = col + 384;
      else if (col < 1408) drow = col + 128;
      else drow = col + 256;
      const float* src = p.w_in + ((long)layer * 1024 + kt * 64) * 1536 + col;
      bfraw* dst = (bfraw*)(p.ws + O_WINT) + ((long)layer * NPROJ + drow) * 1024 + kt * 64;
      xpose_tile(src, 1536, dst, 1024, 0, lds, tid);
      continue;
    }
    it -= P0_WIN;
    if (it < P0_WOUT) {
      const int layer = it >> 8, r = it & 255, kt = r >> 4, nt = r & 15;
      const float* src = p.w_out + ((long)layer * 1024 + kt * 64) * 1024 + nt * 64;
      bfraw* dst = (bfraw*)(p.ws + O_WOUTT) + ((long)layer * 1024 + nt * 64) * 1024 + kt * 64;
      xpose_tile(src, 1024, dst, 1024, 0, lds, tid);
      continue;
    }
  }
  for (int i0 = blockIdx.x; i0 < N_EXPCONV; i0 += 2 * gridDim.x) {
    const int i1 = i0 + gridDim.x;
    expconv_pair(p, 0, i0, (i1 < N_EXPCONV) ? i1 : -1, lds, tid);
  }
}

DI void ln_stats(const float v[16], float& mean, float& rstd) {
  float s = 0.f;
#pragma unroll
  for (int i = 0; i < 16; ++i) s += v[i];
  mean = wsum(s) * (1.f / 1024.f);
  float q = 0.f;
#pragma unroll
  for (int i = 0; i < 16; ++i) { const float d = v[i] - mean; q += d * d; }
  rstd = rsqrtf(wsum(q) * (1.f / 1024.f) + 1e-5f);
}
DI void load_row16(const float* src, int lane, float v[16]) {
#pragma unroll
  for (int i = 0; i < 4; ++i) {
    const float4 t = *(const float4*)(src + i * 256 + lane * 4);
    v[i * 4 + 0] = t.x; v[i * 4 + 1] = t.y; v[i * 4 + 2] = t.z; v[i * 4 + 3] = t.w;
  }
}
DI void store_row16(float* dst, int lane, const float v[16]) {
#pragma unroll
  for (int i = 0; i < 4; ++i) *(float4*)(dst + i * 256 + lane * 4) = make_float4(v[i * 4], v[i * 4 + 1], v[i * 4 + 2], v[i * 4 + 3]);
}
DI void store_row16_bf(bfraw* dst, int lane, const float v[16]) {
#pragma unroll
  for (int i = 0; i < 4; ++i) {
    uint2 st;
    st.x = pack2(v[i * 4], v[i * 4 + 1]);
    st.y = pack2(v[i * 4 + 2], v[i * 4 + 3]);
    *(uint2*)(dst + i * 256 + lane * 4) = st;
  }
}
DI void modulate16(float v[16], const float* sh, const float* sc, int lane) {
  float mean, rstd;
  ln_stats(v, mean, rstd);
  float a[16], b[16];
  load_row16(sh, lane, a);
  load_row16(sc, lane, b);
#pragma unroll
  for (int i = 0; i < 16; ++i) v[i] = (v[i] - mean) * rstd * (1.f + b[i]) + a[i];
}
DI void postnorm16(float v[16], const float* g, const float* bb, int lane) {
  float mean, rstd;
  ln_stats(v, mean, rstd);
  float a[16], b[16];
  load_row16(g, lane, a);
  load_row16(bb, lane, b);
#pragma unroll
  for (int i = 0; i < 16; ++i) v[i] = (v[i] - mean) * rstd * a[i] + b[i];
}

DI void phase_lnmod0(const Params& p, int tid) {
  const int w = tid >> 6, lane = tid & 63;
  const float* MOD = (const float*)(p.ws + O_MOD);
  const int stride = gridDim.x * NWAVE;
  int row = blockIdx.x * NWAVE + w;
  float nv[16];
  if (row < NT + NCT) load_row16((row < NT) ? p.x + (long)row * 1024 : p.ctx + (long)(row - NT) * 1024, lane, nv);
#pragma unroll 1
  for (; row < NT + NCT; row += stride) {
    float v[16];
#pragma unroll
    for (int i = 0; i < 16; ++i) v[i] = nv[i];
    const int nrow = row + stride;
    if (nrow < NT + NCT) load_row16((nrow < NT) ? p.x + (long)nrow * 1024 : p.ctx + (long)(nrow - NT) * 1024, lane, nv);
    if (row < NT) {
      const float* mr = MOD + (0 * 9 + row / SEQ) * 6144;
      modulate16(v, mr, mr + 1024, lane);
      store_row16_bf((bfraw*)(p.ws + O_H) + (long)row * 1024, lane, v);
    } else {
      const int rc = row - NT;
      const float* mr = MOD + (0 * 9 + 8) * 6144;
      modulate16(v, mr, mr + 1024, lane);
      store_row16_bf((bfraw*)(p.ws + O_HC) + (long)rc * 1024, lane, v);
    }
  }
}

DI void proj_item(const Params& p, int layer, bool is_ctx, int rt, int ct, char* lds, int tid) {
  const int T = is_ctx ? CTX : SEQ;
  const bfraw* Hs = (const bfraw*)(p.ws + (is_ctx ? O_HC : O_H));
  const bfraw* W = (const bfraw*)(p.ws + O_WINT) + (long)layer * NPROJ * 1024;
  const bfraw *ap[4], *bp[4];
  rows4(Hs, 1024, rt * 256, tid, ap);
  rows4(W, 1024, ct * 256, tid, bp);
  char* ws = p.ws;
  if (ct <= 2 || ct == 5) {
    const float* rope = (const float*)(ws + O_ROPE);
    gemm_tile<true>(ap, bp, 1024, lds, tid, [&](f32x4 (&acc)[8][4], int wr, int wc, int fr, int fq) {
      const int rowbase = rt * 256 + wr * 128;
      const int b = rowbase / T;
      const int tbase = rowbase - b * T;
      const bool donorm = (ct < 2) || (ct == 5 && wc < 2);
      const float* gn = ((ct < 2) ? p.q_norm : p.k_norm) + layer * 64;
      bfraw* dst;
      long rstride;
      if (ct < 2) { dst = (bfraw*)(ws + (is_ctx ? O_QAC : O_QA)) + ((long)rowbase * 8 + (ct * 4 + wc)) * 64; rstride = 512; }
      else if (ct == 2) { dst = (bfraw*)(ws + (is_ctx ? O_QCC : O_QC)) + ((long)rowbase * 4 + wc) * 64; rstride = 256; }
      else {
        const int slot0 = is_ctx ? tbase : CTX + tbase;
        dst = (bfraw*)(ws + (wc < 2 ? O_KA : O_KC)) + ((long)(b * 2 + (wc & 1)) * KS + slot0) * 64; rstride = 64;
      }
#pragma unroll
      for (int m = 0; m < 8; ++m) {
        const int rl = m * 16 + fr;
        float rs = 1.f;
        if (donorm) {
          float ss = 0.f;
#pragma unroll
          for (int n = 0; n < 4; ++n)
#pragma unroll
            for (int j = 0; j < 4; ++j) ss += acc[m][n][j] * acc[m][n][j];
          ss += __shfl_xor(ss, 16);
          ss += __shfl_xor(ss, 32);
          rs = rsqrtf(ss * (1.f / 64.f) + 1e-6f);
        }
        float xv[4][4];
        const float* gp = gn;
        asm volatile("" : "+s"(gp));
#pragma unroll
        for (int n = 0; n < 4; ++n) {
          if (donorm) {
            const float4 t = *(const float4*)(gp + n * 16 + fq * 4);
            xv[n][0] = acc[m][n][0] * rs * t.x; xv[n][1] = acc[m][n][1] * rs * t.y;
            xv[n][2] = acc[m][n][2] * rs * t.z; xv[n][3] = acc[m][n][3] * rs * t.w;
          } else {
            xv[n][0] = acc[m][n][0]; xv[n][1] = acc[m][n][1]; xv[n][2] = acc[m][n][2]; xv[n][3] = acc[m][n][3];
          }
        }
        if (!is_ctx) {
          const int t = tbase + rl;
          const int pr = t >> 6, pc = t & 63;
          const float4 c0 = *(const float4*)(rope + pr * 16 + fq * 4), s0 = *(const float4*)(rope + 1024 + pr * 16 + fq * 4);
          const float4 c1 = *(const float4*)(rope + pc * 16 + fq * 4), s1 = *(const float4*)(rope + 1024 + pc * 16 + fq * 4);
          const float c0a[4] = {c0.x, c0.y, c0.z, c0.w}, s0a[4] = {s0.x, s0.y, s0.z, s0.w};
          const float c1a[4] = {c1.x, c1.y, c1.z, c1.w}, s1a[4] = {s1.x, s1.y, s1.z, s1.w};
#pragma unroll
          for (int j = 0; j < 4; ++j) {
            const float y0 = xv[0][j] * c0a[j] - xv[1][j] * s0a[j], y1 = xv[1][j] * c0a[j] + xv[0][j] * s0a[j];
            const float y2 = xv[2][j] * c1a[j] - xv[3][j] * s1a[j], y3 = xv[3][j] * c1a[j] + xv[2][j] * s1a[j];
            xv[0][j] = y0; xv[1][j] = y1; xv[2][j] = y2; xv[3][j] = y3;
          }
        }
        bfraw* d = dst + (long)rl * rstride + fq * 4;
#pragma unroll
        for (int n = 0; n < 4; ++n) {
          uint2 st;
          st.x = pack2(xv[n][0], xv[n][1]);
          st.y = pack2(xv[n][2], xv[n][3]);
          *(uint2*)(d + n * 16) = st;
        }
      }
    });
  } else {
    gemm_tile<false>(ap, bp, 1024, lds, tid, [&](f32x4 (&acc)[8][4], int wr, int wc, int fr, int fq) {
      const int rowbase = rt * 256 + wr * 128;
      const int b = rowbase / T;
      const int tbase = rowbase - b * T;
      bfraw* dst;
      long cstride;
      if (ct == 6) {
        const int slot0 = is_ctx ? tbase : CTX + tbase;
        dst = (bfraw*)(ws + (wc < 2 ? O_VAT : O_VCT)) + (long)(b * 2 + (wc & 1)) * 64 * KS + slot0;
        cstride = KS;
      } else {
        const int ncol0 = wc * 64;
        const int koff = (ct == 4) ? T : 0;
        if (is_ctx) { dst = (bfraw*)(ws + O_VTFC) + ((long)b * 256 + ncol0) * 512 + koff + tbase; cstride = 512; }
        else { dst = (bfraw*)(ws + O_VTF) + ((long)b * 256 + ncol0) * 8192 + koff + tbase; cstride = 8192; }
      }
#pragma unroll
      for (int m = 0; m < 8; ++m)
#pragma unroll
        for (int n = 0; n < 4; ++n) {
          uint2 st;
          st.x = pack2(acc[m][n][0], acc[m][n][1]);
          st.y = pack2(acc[m][n][2], acc[m][n][3]);
          *(uint2*)(dst + (long)(n * 16 + fr) * cstride + m * 16 + fq * 4) = st;
        }
    });
  }
}

DI void phase_proj(const Params& p, int layer, unsigned* ctr, int* s_item, char* lds, int tid) {
  const int nct_ctx = (layer == 0) ? 7 : 2;
  const int n_per = 112 + nct_ctx;
  XQ q{0, 0, 0, -1};
  while (next_item_s(n_per, tid, q)) {
    const int x = q.list, i = q.idx;
    if (i < 112) proj_item(p, layer, false, 16 * x + i / 7, i % 7, lds, tid);
    else proj_item(p, layer, true, x, (layer == 0) ? (i - 112) : (5 + i - 112), lds, tid);
  }
}

DI void four_item(const Params& p, int layer, bool is_ctx, int b, int rt, char* lds, int tid) {
  const int T = is_ctx ? CTX : SEQ;
  const int K = 2 * T;
  const bfraw* A = (const bfraw*)(p.ws + (is_ctx ? O_DFTC : O_DFT));
  const bfraw* Bt = (const bfraw*)(p.ws + (is_ctx ? O_VTFC : O_VTF)) + (long)b * 256 * K;
  const bfraw *ap[4], *bp[4];
  rows4(A, K, rt * 256, tid, ap);
  rows4(Bt, K, 0, tid, bp);
  bfraw* MIX = (bfraw*)(p.ws + (is_ctx ? O_MIXC : O_MIX)) + (long)b * T * 1024;
  const float scale = is_ctx ? (1.f / 128.f) : (1.f / 512.f);
  const float* bias = p.b_four + layer * 256;
  gemm_tile<true>(ap, bp, K, lds, tid, [&](f32x4 (&acc)[8][4], int wr, int wc, int fr, int fq) {
#pragma unroll
    for (int n = 0; n < 4; ++n) {
      const int ncol = wc * 64 + n * 16 + fq * 4;
      const float4 bv = *(const float4*)(bias + ncol);
#pragma unroll
      for (int m = 0; m < 8; ++m) {
        const int t = rt * 256 + wr * 128 + m * 16 + fr;
        uint2 st;
        st.x = pack2(acc[m][n][0] * scale + bv.x, acc[m][n][1] * scale + bv.y);
        st.y = pack2(acc[m][n][2] * scale + bv.z, acc[m][n][3] * scale + bv.w);
        *(uint2*)(MIX + (long)t * 1024 + 512 + ncol) = st;
      }
    }
  });
}

DI void four_lat_item(const Params& p, int layer, int b, int rt, char* lds, int tid) {
  const bfraw* Cm = (const bfraw*)(p.ws + O_DFT);
  const bfraw* Sm = Cm + 2048l * 4096;
  const bfraw* Bt = (const bfraw*)(p.ws + O_VTF) + (long)b * 256 * 8192;
  float4* scr = (float4*)(p.ws + O_PSCR) + (long)(b * 8 + rt) * 16384;
  bfraw* MIX = (bfraw*)(p.ws + O_MIX) + (long)b * SEQ * 1024;
  const float scale = 1.f / 512.f;
  const float* bias = p.b_four + layer * 256;
  {
    const bfraw *ap[4], *bp[4];
    rows4(Cm, 4096, rt * 256, tid, ap);
    rows4(Bt, 8192, 0, tid, bp);
    gemm_tile<true>(ap, bp, 4096, lds, tid, [&](f32x4 (&acc)[8][4], int wr, int wc, int fr, int fq) {
      const int t_ = (wr * 4 + wc) * 64 + fq * 16 + fr;
#pragma unroll
      for (int m = 0; m < 8; ++m)
#pragma unroll
        for (int n = 0; n < 4; ++n)
          scr[(m * 4 + n) * NTHR + t_] = make_float4(acc[m][n][0], acc[m][n][1], acc[m][n][2], acc[m][n][3]);
    });
  }
  {
    const bfraw *ap[4], *bp[4];
    rows4(Sm, 4096, rt * 256, tid, ap);
    rows4(Bt + 4096, 8192, 0, tid, bp);
    gemm_tile<true>(ap, bp, 4096, lds, tid, [&](f32x4 (&acc)[8][4], int wr, int wc, int fr, int fq) {
      const int t_ = (wr * 4 + wc) * 64 + fq * 16 + fr;
#pragma unroll
      for (int n = 0; n < 4; ++n) {
        const int ncol = wc * 64 + n * 16 + fq * 4;
        const float4 bv = *(const float4*)(bias + ncol);
#pragma unroll
        for (int m = 0; m < 8; ++m) {
          const int t = rt * 256 + wr * 128 + m * 16 + fr;
          const float4 P = scr[(m * 4 + n) * NTHR + t_];
          uint2 st;
          st.x = pack2((P.x - acc[m][n][0]) * scale + bv.x, (P.y - acc[m][n][1]) * scale + bv.y);
          st.y = pack2((P.z - acc[m][n][2]) * scale + bv.z, (P.w - acc[m][n][3]) * scale + bv.w);
          *(uint2*)(MIX + (long)t * 1024 + 512 + ncol) = st;
          if (t > 0) {
            st.x = pack2((P.x + acc[m][n][0]) * scale + bv.x, (P.y + acc[m][n][1]) * scale + bv.y);
            st.y = pack2((P.z + acc[m][n][2]) * scale + bv.z, (P.w + acc[m][n][3]) * scale + bv.w);
            *(uint2*)(MIX + (long)(SEQ - t) * 1024 + 512 + ncol) = st;
          }
        }
      }
    });
  }
}

DI void four_mid_item(const Params& p, int layer, int b, int tid) {
  const int n = tid >> 1, half = tid & 1;
  const bfraw* v = (const bfraw*)(p.ws + O_VTF) + ((long)b * 256 + n) * 8192 + half * 2048;
  float s = 0.f;
#pragma unroll 4
  for (int k = 0; k < 2048; k += 8) {
    const uint4 u = *(const uint4*)(v + k);
    s += (bflo(u.x) - bfhi(u.x)) + (bflo(u.y) - bfhi(u.y)) + (bflo(u.z) - bfhi(u.z)) + (bflo(u.w) - bfhi(u.w));
  }
  s += __shfl_xor(s, 1);
  if (half == 0) {
    bfraw* MIX = (bfraw*)(p.ws + O_MIX) + ((long)b * SEQ + SEQ / 2) * 1024;
    MIX[512 + n] = f2bf(s * (1.f / 512.f) + p.b_four[layer * 256 + n]);
  }
}

DI void phase_mix(const Params& p, int layer, unsigned* ctr, int* s_item, char* lds, int tid) {
  char* ws = p.ws;
  const int nF = 9, nA = 128, nC = 64;
  const int nFc = (layer == 0) ? 1 : 0, nAc = (layer == 0) ? 8 : 0, nCc = (layer == 0) ? 4 : 0;
  const int n_per = nF + nA + nC + nFc + nAc + nCc;
  XQ q{0, 0, 0, -1};
  while (next_item_x(ctr, n_per, s_item, tid, q)) {
    const int b = q.list;
    int it = q.idx;
    if (it < 8) { four_lat_item(p, layer, b, it, lds, tid); continue; }
    if (it == 8) { four_mid_item(p, layer, b, tid); continue; }
    it -= nF;
    if (it >= nA + nC && it < nA + nC + nFc) { four_item(p, layer, true, b, 0, lds, tid); continue; }
    int kind, h, qb;
    if (it < nA) { kind = 0; h = it >> 4; qb = it & 15; }
    else if (it < nA + nC) { it -= nA; kind = 1; h = it >> 4; qb = it & 15; }
    else {
      it -= nA + nC + nFc;
      if (it < nAc) { kind = 2; h = it; qb = 0; }
      else { it -= nAc; kind = 3; h = it; qb = 0; }
    }
    const bool isA = (kind == 0 || kind == 2), isctx = (kind >= 2);
    const int nh = isA ? 8 : 4;
    const int kvh = isA ? (h >> 2) : (h >> 1);
    const int T = isctx ? CTX : SEQ;
    const long tok0 = (long)b * T + qb * 256;
    const bfraw* Qp = (const bfraw*)(ws + (isA ? (isctx ? O_QAC : O_QA) : (isctx ? O_QCC : O_QC))) + (tok0 * nh + h) * 64;
    const bfraw* Kp = (const bfraw*)(ws + (isA ? O_KA : O_KC)) + (long)(b * 2 + kvh) * KS * 64;
    const bfraw* Vp = (const bfraw*)(ws + (isA ? O_VAT : O_VCT)) + (long)(b * 2 + kvh) * 64 * KS;
    bfraw* Op = (bfraw*)(ws + (isctx ? O_MIXC : O_MIX)) + tok0 * 1024 + (isA ? 0 : 768) + h * 64;
    const float sk = isA ? 0.f : p.sink[layer * 4 + h] * LOG2E;
    if (kind == 1) {
      const int q0 = qb * 256;
      const int lo = (q0 - 128 < 0) ? 0 : q0 - 128;
      const int hi = (q0 + 384 > SEQ) ? SEQ : q0 + 384;
      attn_item<true>(Qp, 256, Kp, Vp, KS, CTX / 64, (CTX + lo) / 64, (hi - lo) / 64, q0, true, sk, Op, 1024, lds, tid);
    } else {
      attn_item<false>(Qp, nh * 64, Kp, Vp, KS, (kind == 0) ? KS / 64 : CTX / 64, 0, 0, 0, !isA, sk, Op, 1024, lds, tid);
    }
  }
}

DI void phase_outproj(const Params& p, int layer, unsigned* ctr, int* s_item, char* lds, int tid) {
  const int n_lat = 128 * 4, n_ctx = (layer == 0) ? 8 * 4 : 0;
  const bfraw* W = (const bfraw*)(p.ws + O_WOUTT) + (long)layer * 1024 * 1024;
  const float* MOD = (const float*)(p.ws + O_MOD);
  (void)n_lat; (void)n_ctx;
  const int n_per = 64 + ((layer == 0) ? 4 : 0);
  XQ q{0, 0, 0, -1};
  while (next_item_s(n_per, tid, q)) {
    const bool is_ctx = q.idx >= 64;
    const int rt = is_ctx ? q.list : (16 * q.list + (q.idx >> 2));
    const int ct = is_ctx ? (q.idx - 64) : (q.idx & 3);
    const int T = is_ctx ? CTX : SEQ;
    const bfraw* A = (const bfraw*)(p.ws + (is_ctx ? O_MIXC : O_MIX));
    const float* xin = is_ctx ? p.ctx : (layer == 0 ? p.x : p.out);
    float* X1 = (float*)(p.ws + (is_ctx ? O_X1C : O_X1));
    const bfraw *ap[4], *bp[4];
    rows4(A, 1024, rt * 256, tid, ap);
    rows4(W, 1024, ct * 256, tid, bp);
    gemm_tile<true>(ap, bp, 1024, lds, tid, [&](f32x4 (&acc)[8][4], int wr, int wc, int fr, int fq) {
      const int rowbase = rt * 256 + wr * 128;
      const int b = is_ctx ? 8 : rowbase / T;
      const float* g1 = MOD + (layer * 9 + b) * 6144 + 2048;
#pragma unroll
      for (int n = 0; n < 4; ++n) {
        const int col = ct * 256 + wc * 64 + n * 16 + fq * 4;
        const float4 gv = *(const float4*)(g1 + col);
#pragma unroll
        for (int m = 0; m < 8; ++m) {
          const long idx = (long)(rowbase + m * 16 + fr) * 1024 + col;
          const float4 xv = *(const float4*)(xin + idx);
          float4 o;
          o.x = ALPHA * xv.x + gv.x * acc[m][n][0];
          o.y = ALPHA * xv.y + gv.y * acc[m][n][1];
          o.z = ALPHA * xv.z + gv.z * acc[m][n][2];
          o.w = ALPHA * xv.w + gv.w * acc[m][n][3];
          *(float4*)(X1 + idx) = o;
        }
      }
    });
  }
}

DI void phase_row(const Params& p, int layer, char* lds, int tid) {
  const int w = tid >> 6, lane = tid & 63;
  float* wrl = (float*)lds;
  __syncthreads();
  {
    const float* wr = p.w_router + (long)layer * 1024 * 16;
    for (int idx = tid; idx < 16384; idx += NTHR) wrl[(idx & 15) * 1028 + (idx >> 4)] = wr[idx];
  }
  __syncthreads();
  const float* MOD = (const float*)(p.ws + O_MOD);
  const int nrows = NT + ((layer == 0) ? NCT : 0);
  const int stride = gridDim.x * NWAVE;
  int row = blockIdx.x * NWAVE + w;
  float nv[16];
  if (row < nrows) {
    const bool c = row >= NT;
    load_row16((const float*)(p.ws + (c ? O_X1C : O_X1)) + (long)(c ? row - NT : row) * 1024, lane, nv);
  }
#pragma unroll 1
  for (; row < nrows; row += stride) {
    const bool is_ctx = row >= NT;
    const int rr = is_ctx ? row - NT : row;
    float* X1 = (float*)(p.ws + (is_ctx ? O_X1C : O_X1)) + (long)rr * 1024;
    bfraw* Hd = (bfraw*)(p.ws + (is_ctx ? O_HC : O_H)) + (long)rr * 1024;
    const int T = is_ctx ? CTX : SEQ;
    const int b = rr / T, t = rr - b * T;
    const float* mr = MOD + (layer * 9 + (is_ctx ? 8 : b)) * 6144;
    float v[16];
#pragma unroll
    for (int i = 0; i < 16; ++i) v[i] = nv[i];
    if (row + stride < nrows) {
      const int nrow = row + stride;
      const bool c = nrow >= NT;
      load_row16((const float*)(p.ws + (c ? O_X1C : O_X1)) + (long)(c ? nrow - NT : nrow) * 1024, lane, nv);
    }
    postnorm16(v, p.ln1_g + layer * 1024, p.ln1_b + layer * 1024, lane);
    store_row16(X1, lane, v);
    modulate16(v, mr + 3072, mr + 4096, lane);
    store_row16_bf(Hd, lane, v);
    float pr[16];
#pragma unroll
    for (int e = 0; e < 16; ++e) {
      float s = 0.f;
#pragma unroll
      for (int i = 0; i < 4; ++i) {
        const float4 wv = *(const float4*)(wrl + e * 1028 + i * 256 + lane * 4);
        s += v[i * 4] * wv.x + v[i * 4 + 1] * wv.y + v[i * 4 + 2] * wv.z + v[i * 4 + 3] * wv.w;
      }
      pr[e] = s;
      asm volatile("" ::: "memory");
    }
    float r8[8], r4[4], r2[2];
    {
      const bool hi = (lane & 32) != 0;
#pragma unroll
      for (int i = 0; i < 8; ++i) { const float a = pr[i], c = pr[i + 8]; r8[i] = (hi ? c : a) + __shfl_xor(hi ? a : c, 32); }
    }
    {
      const bool hi = (lane & 16) != 0;
#pragma unroll
      for (int i = 0; i < 4; ++i) { const float a = r8[i], c = r8[i + 4]; r4[i] = (hi ? c : a) + __shfl_xor(hi ? a : c, 16); }
    }
    {
      const bool hi = (lane & 8) != 0;
#pragma unroll
      for (int i = 0; i < 2; ++i) { const float a = r4[i], c = r4[i + 2]; r2[i] = (hi ? c : a) + __shfl_xor(hi ? a : c, 8); }
    }
    float lg;
    {
      const bool hi = (lane & 4) != 0;
      lg = (hi ? r2[1] : r2[0]) + __shfl_xor(hi ? r2[0] : r2[1], 4);
    }
    lg += __shfl_xor(lg, 2);
    lg += __shfl_xor(lg, 1);
    const int elane = ((lane >> 5) & 1) * 8 + ((lane >> 4) & 1) * 4 + ((lane >> 3) & 1) * 2 + ((lane >> 2) & 1);
    float mx = lg;
    mx = fmaxf(mx, __shfl_xor(mx, 4)); mx = fmaxf(mx, __shfl_xor(mx, 8));
    mx = fmaxf(mx, __shfl_xor(mx, 16)); mx = fmaxf(mx, __shfl_xor(mx, 32));
    const float ex = __expf(lg - mx);
    float den = ex;
    den += __shfl_xor(den, 4); den += __shfl_xor(den, 8); den += __shfl_xor(den, 16); den += __shfl_xor(den, 32);
    const float mine = ex / den;
    if ((lane & 3) == 0) {
      float* AFF = (float*)(p.ws + (is_ctx ? O_AFFC : O_AFF));
      AFF[((long)b * 16 + elane) * T + t] = mine;
    }
  }
}

DI void topk_item(const Params& p, bool is_ctx, int b, int e, char* lds, int tid) {
  const int T = is_ctx ? CTX : SEQ, cap = is_ctx ? CAPC : CAP;
  unsigned* hist = (unsigned*)lds;
  unsigned* sel = hist + 256;
  unsigned* wtot = hist + 264;
  const unsigned* AFF = (const unsigned*)(p.ws + (is_ctx ? O_AFFC : O_AFF)) + ((long)b * 16 + e) * T;
  const int lane = tid & 63, w = tid >> 6;
  const bool have = tid * 8 < T;
  unsigned v[8];
  if (have) {
    const uint4 t0 = *(const uint4*)(AFF + tid * 8), t1 = *(const uint4*)(AFF + tid * 8 + 4);
    v[0] = t0.x; v[1] = t0.y; v[2] = t0.z; v[3] = t0.w; v[4] = t1.x; v[5] = t1.y; v[6] = t1.z; v[7] = t1.w;
  } else {
#pragma unroll
    for (int i = 0; i < 8; ++i) v[i] = 0u;
  }
  unsigned prefix = 0u, kk = (unsigned)cap;
#pragma unroll 1
  for (int pass = 3; pass >= 0; --pass) {
    __syncthreads();
    if (tid < 256) hist[tid] = 0u;
    __syncthreads();
    if (have) {
#pragma unroll
      for (int i = 0; i < 8; ++i) {
        const bool match = (pass == 3) ? true : ((v[i] >> (8 * (pass + 1))) == prefix);
        if (match) atomicAdd(&hist[(v[i] >> (8 * pass)) & 255u], 1u);
      }
    }
    __syncthreads();
    if (tid < 256) {
      unsigned sfx = 0u;
      for (int d = tid + 1; d < 256; ++d) sfx += hist[d];
      const unsigned me = hist[tid];
      if (sfx < kk && sfx + me >= kk) { sel[0] = (unsigned)tid; sel[1] = kk - sfx; }
    }
    __syncthreads();
    prefix = (prefix << 8) | sel[0];
    kk = sel[1];
  }
  const unsigned thr = prefix;
  unsigned cg = 0u, ce = 0u;
  if (have) {
#pragma unroll
    for (int i = 0; i < 8; ++i) { cg += (v[i] > thr); ce += (v[i] == thr); }
  }
  unsigned pk = cg | (ce << 16);
  unsigned inc = pk;
#pragma unroll
  for (int o = 1; o < 64; o <<= 1) {
    const unsigned t = __shfl_up(inc, o);
    if (lane >= o) inc += t;
  }
  __syncthreads();
  if (lane == 63) wtot[w] = inc;
  __syncthreads();
  unsigned base = 0u, total = 0u;
#pragma unroll
  for (int ww = 0; ww < NWAVE; ++ww) { const unsigned t = wtot[ww]; if (ww < w) base += t; total += t; }
  const unsigned excl = base + inc - pk;
  unsigned pos_g = excl & 0xffffu, pos_e = excl >> 16;
  const unsigned n_gt = total & 0xffffu;
  if (have) {
    short* SLOT = (short*)(p.ws + (is_ctx ? O_SLOTC : O_SLOT));
    int* IDX = (int*)(p.ws + (is_ctx ? O_IDXC : O_IDX));
    float* GATE = (float*)(p.ws + (is_ctx ? O_GATEC : O_GATE));
#pragma unroll
    for (int i = 0; i < 8; ++i) {
      const int idx = tid * 8 + i;
      int slot = -1;
      if (v[i] > thr) { slot = (int)pos_g; ++pos_g; }
      else if (v[i] == thr) { if (pos_e < kk) slot = (int)(n_gt + pos_e); ++pos_e; }
      if (slot >= 0) {
        const int prow = (e * 8 + b) * cap + slot;
        IDX[prow] = idx;
        GATE[prow] = __uint_as_float(v[i]);
      }
      SLOT[((long)b * T + idx) * 16 + e] = (short)slot;
    }
  }
}

DI void phase_topk(const Params& p, int layer, char* lds, int tid) {
  const int n_lat = 128, n_ctx = (layer == 0) ? 128 : 0;
  for (int item = blockIdx.x; item < n_lat + n_ctx; item += gridDim.x) {
    int it = item;
    if (it < n_lat) { topk_item(p, false, it >> 4, it & 15, lds, tid); continue; }
    it -= n_lat;
    topk_item(p, true, it >> 4, it & 15, lds, tid);
  }
  if (layer == 1) {
    const int g = gridDim.x;
    for (int i0 = ((int)blockIdx.x + g - 128 % g) % g; i0 < N_EXPCONV; i0 += 2 * g) {
      const int i1 = i0 + g;
      expconv_pair(p, 1, i0, (i1 < N_EXPCONV) ? i1 : -1, lds, tid);
    }
  }
}

template <int VAR = 0>
DI void phase_moe1(const Params& p, int layer, unsigned* ctr, int* s_item, char* lds, int tid) {
  const bfraw* WGU = (const bfraw*)(p.ws + O_WGU);
  const int n_per = 512 + ((layer == 0) ? 32 : 0);
  XQ q{0, 0, 0, -1};
  auto decode = [&](int x, int i, int& e, int& ct, int& rt, bool& is_ctx) {
    is_ctx = i >= 512;
    if (!is_ctx) { e = i >> 5; const int loc = i & 31; rt = 4 * (x & 3) + (loc & 3); ct = 8 * (x >> 2) + (loc >> 2); }
    else { const int g = x * 32 + (i - 512); e = g >> 4; ct = g & 15; rt = 0; }
  };
  auto load_tok = [&](int x, int i, int (&tok)[4]) {
    int e, ct, rt; bool c;
    decode(x, i, e, ct, rt, c);
    const int cap = c ? CAPC : CAP;
    const int* IDX = (const int*)(p.ws + (c ? O_IDXC : O_IDX));
    const int r0 = (tid & 255) >> 2;
#pragma unroll
    for (int k = 0; k < 4; ++k) tok[k] = IDX[e * 8 * cap + rt * 256 + k * 64 + r0];
  };
  int tokn[4] = {0, 0, 0, 0};
  bool have = next_item_s(n_per, tid, q);
  if (have) load_tok(q.list, q.idx, tokn);
  while (have) {
    const int x = q.list, ci = q.idx;
    int e, ct, rt; bool is_ctx;
    decode(x, ci, e, ct, rt, is_ctx);
    const int cap = is_ctx ? CAPC : CAP, T = is_ctx ? CTX : SEQ;
    const bfraw* Hs = (const bfraw*)(p.ws + (is_ctx ? O_HC : O_H));
    bfraw* ACT = (bfraw*)(p.ws + (is_ctx ? O_ACTC : O_ACT));
    const bfraw *ap[4], *bp[4];
    {
      const int r0 = (tid & 255) >> 2, c8 = ((tid & 3) ^ swz4(tid >> 4)) * 8;
#pragma unroll
      for (int i = 0; i < 4; ++i) {
        const int l = rt * 256 + i * 64 + r0;
        ap[i] = Hs + ((long)(l / cap) * T + tokn[i]) * 1024 + c8;
      }
    }
    have = next_item_s(n_per, tid, q);
    if (have) load_tok(q.list, q.idx, tokn);
    rows4(WGU, 1024, e * 4096 + ct * 256, tid, bp);
    const long prow0 = (long)e * 8 * cap + rt * 256;
    gemm_tile<true>(ap, bp, 1024, lds, tid, [&](f32x4 (&acc)[8][4], int wr, int wc, int fr, int fq) {
#pragma unroll
      for (int m = 0; m < 8; ++m)
#pragma unroll
        for (int q = 0; q < 2; ++q) {
          const int f = ct * 128 + wc * 32 + q * 16 + fq * 4;
          if (VAR != 0) {
            if (is_ctx || ct >= 8) continue;
            bfraw* Yd = (bfraw*)(p.ws + O_Y);
            uint2 st;
            st.x = pack2(acc[m][2 * q][0] + acc[m][2 * q + 1][0], acc[m][2 * q][1] + acc[m][2 * q + 1][1]);
            st.y = pack2(acc[m][2 * q][2] + acc[m][2 * q + 1][2], acc[m][2 * q][3] + acc[m][2 * q + 1][3]);
            *(uint2*)(Yd + (prow0 + wr * 128 + m * 16 + fr) * 1024 + f) = st;
            continue;
          }
          float sv[4];
#pragma unroll
          for (int j = 0; j < 4; ++j) {
            const float g = acc[m][2 * q][j], u = acc[m][2 * q + 1][j];
            sv[j] = g * u * __builtin_amdgcn_rcpf(1.f + __builtin_amdgcn_exp2f(-LOG2E * g));
          }
          uint2 st;
          st.x = pack2(sv[0], sv[1]);
          st.y = pack2(sv[2], sv[3]);
          *(uint2*)(ACT + (prow0 + wr * 128 + m * 16 + fr) * FF + f) = st;
        }
    });
  }
}

DI void phase_moe2(const Params& p, int layer, unsigned* ctr, int* s_item, char* lds, int tid) {
  const bfraw* WD = (const bfraw*)(p.ws + O_WD);
  const int n_per = 128 + ((layer == 0) ? 8 : 0);
  XQ q{0, 0, 0, -1};
  while (next_item_s(n_per, tid, q)) {
    const int x = q.list;
    const bool is_ctx = q.idx >= 128;
    const int cap = is_ctx ? CAPC : CAP;
    int e, ct, rt;
    if (!is_ctx) { e = (x >> 2) + 2 * (q.idx >> 4); const int loc = q.idx & 15; rt = 4 * (x & 3) + (loc & 3); ct = loc >> 2; }
    else { const int g = x * 8 + (q.idx - 128); e = g >> 2; ct = g & 3; rt = 0; }
    const bfraw* ACT = (const bfraw*)(p.ws + (is_ctx ? O_ACTC : O_ACT));
    bfraw* Y = (bfraw*)(p.ws + (is_ctx ? O_YC : O_Y));
    const long prow0 = (long)e * 8 * cap + rt * 256;
    const bfraw *ap[4], *bp[4];
    rows4(ACT + prow0 * FF, FF, 0, tid, ap);
    rows4(WD, FF, e * 1024 + ct * 256, tid, bp);
    gemm_tile<true>(ap, bp, FF, lds, tid, [&](f32x4 (&acc)[8][4], int wr, int wc, int fr, int fq) {
#pragma unroll
      for (int m = 0; m < 8; ++m)
#pragma unroll
        for (int n = 0; n < 4; ++n) {
          const int col = ct * 256 + wc * 64 + n * 16 + fq * 4;
          uint2 st;
          st.x = pack2(acc[m][n][0], acc[m][n][1]);
          st.y = pack2(acc[m][n][2], acc[m][n][3]);
          *(uint2*)(Y + (prow0 + wr * 128 + m * 16 + fr) * 1024 + col) = st;
        }
    });
  }
}

DI void phase_combine(const Params& p, int layer, int tid) {
  const int w = tid >> 6, lane = tid & 63;
  const float* MOD = (const float*)(p.ws + O_MOD);
  const int nrows = NT + ((layer == 0) ? NCT : 0);
  const int stride = gridDim.x * NWAVE;
  int row = blockIdx.x * NWAVE + w;
  if (row >= nrows) return;
  uint4 nsl0, nsl1;
  float nv[16];
  {
    const bool c = row >= NT;
    const int r = c ? row - NT : row;
    const short* SL = (const short*)(p.ws + (c ? O_SLOTC : O_SLOT)) + (long)r * 16;
    nsl0 = *(const uint4*)SL; nsl1 = *(const uint4*)(SL + 8);
    load_row16((const float*)(p.ws + (c ? O_X1C : O_X1)) + (long)r * 1024, lane, nv);
  }
#pragma unroll 1
  for (; row < nrows; row += stride) {
    const bool is_ctx = row >= NT;
    const int rr = is_ctx ? row - NT : row;
    const int T = is_ctx ? CTX : SEQ, cap = is_ctx ? CAPC : CAP;
    const int b = rr / T;
    const float* GATE = (const float*)(p.ws + (is_ctx ? O_GATEC : O_GATE));
    const bfraw* Y = (const bfraw*)(p.ws + (is_ctx ? O_YC : O_Y));
    const float* mr = MOD + (layer * 9 + (is_ctx ? 8 : b)) * 6144;
    const uint4 sl0 = nsl0, sl1 = nsl1;
    float v[16];
#pragma unroll
    for (int i = 0; i < 16; ++i) v[i] = nv[i];
    {
      const int nrow = row + stride;
      if (nrow < nrows) {
        const bool c = nrow >= NT;
        const int r = c ? nrow - NT : nrow;
        const short* SL = (const short*)(p.ws + (c ? O_SLOTC : O_SLOT)) + (long)r * 16;
        nsl0 = *(const uint4*)SL; nsl1 = *(const uint4*)(SL + 8);
        load_row16((const float*)(p.ws + (c ? O_X1C : O_X1)) + (long)r * 1024, lane, nv);
      }
    }
    const unsigned slw[8] = {sl0.x, sl0.y, sl0.z, sl0.w, sl1.x, sl1.y, sl1.z, sl1.w};
    float y[16];
#pragma unroll
    for (int i = 0; i < 16; ++i) y[i] = 0.f;
#pragma unroll
    for (int e = 0; e < 16; ++e) {
      const unsigned wd = slw[e >> 1];
      const int sv = (int)(short)((e & 1) ? (wd >> 16) : (wd & 0xffffu));
      if (sv >= 0) {
        const long prow = (long)(e * 8 + b) * cap + sv;
        const float g = GATE[prow];
        const bfraw* yr = Y + prow * 1024;
#pragma unroll
        for (int i = 0; i < 4; ++i) {
          const uint2 u = *(const uint2*)(yr + i * 256 + lane * 4);
          y[i * 4 + 0] += g * bflo(u.x); y[i * 4 + 1] += g * bfhi(u.x);
          y[i * 4 + 2] += g * bflo(u.y); y[i * 4 + 3] += g * bfhi(u.y);
        }
      }
    }
    float g2[16];
    load_row16(mr + 5120, lane, g2);
#pragma unroll
    for (int i = 0; i < 16; ++i) v[i] = ALPHA * v[i] + g2[i] * y[i];
    postnorm16(v, p.ln2_g + layer * 1024, p.ln2_b + layer * 1024, lane);
    if (!is_ctx) store_row16(p.out + (long)rr * 1024, lane, v);
    if (layer == 0) {
      const float* mn = MOD + (1 * 9 + (is_ctx ? 8 : b)) * 6144;
      modulate16(v, mn, mn + 1024, lane);
      store_row16_bf((bfraw*)(p.ws + (is_ctx ? O_HC : O_H)) + (long)rr * 1024, lane, v);
    }
  }
}

#ifndef DUP_MASK
#define DUP_MASK 0
#endif
DI void run_phase(const Params& p, int ph, unsigned* ctr, int* s_item, char* smem, int tid) {
  if (ph == 0) phase_prep(p, smem, tid);
  else if (ph == 1) phase_lnmod0(p, tid);
  else {
    const int layer = (ph - 2) >> 3, sub = (ph - 2) & 7;
    switch (sub) {
      case 0: phase_proj(p, layer, ctr, s_item, smem, tid); break;
      case 1: phase_mix(p, layer, ctr, s_item, smem, tid); break;
      case 2: phase_outproj(p, layer, ctr, s_item, smem, tid); break;
      case 3: phase_row(p, layer, smem, tid); break;
      case 4: phase_topk(p, layer, smem, tid); break;
      case 5: phase_moe1(p, layer, ctr, s_item, smem, tid); break;
      case 6: phase_moe2(p, layer, ctr, s_item, smem, tid); break;
      default: phase_combine(p, layer, tid); break;
    }
  }
}

__global__ void __launch_bounds__(NTHR) fwd_kernel(Params p) {
  extern __shared__ __attribute__((aligned(16))) char smem[];
  __shared__ int s_item;
  __shared__ uint4 xb_words;
  const int wave_id = __builtin_amdgcn_readfirstlane((int)(threadIdx.x >> 6));
  if (threadIdx.x == 0) xb_words = make_uint4(0u, 0u, 0u, 0u);
  __syncthreads();
  unsigned* barw = (unsigned*)(p.ws + O_BAR);
  for (int ph = p.ph_lo; ph < p.ph_hi; ++ph) {
    if (ph > p.ph_lo) {
      if (ph == 1) {
        cg::this_grid().sync();
        int t0;
        asm volatile("v_mbcnt_lo_u32_b32 %0, -1, 0\n\tv_mbcnt_hi_u32_b32 %0, -1, %0" : "=v"(t0));
        xcd_barrier_post(barw, t0 + wave_id * 64);
      } else {
        int t0;
        asm volatile("v_mbcnt_lo_u32_b32 %0, -1, 0\n\tv_mbcnt_hi_u32_b32 %0, -1, %0" : "=v"(t0));
        xcd_barrier(barw, (volatile unsigned*)&xb_words, t0 + wave_id * 64);
      }
    }
    int tid;
    asm volatile("v_mbcnt_lo_u32_b32 %0, -1, 0\n\tv_mbcnt_hi_u32_b32 %0, -1, %0" : "=v"(tid));
    tid += wave_id * 64;
    unsigned* ctr = (unsigned*)(p.ws + O_CTR) + ph * 8;
    run_phase(p, ph, ctr, &s_item, smem, tid);
#ifdef PROBE_VAR
    if (ph >= 2 && ((ph - 2) & 7) == 5) {
      cg::this_grid().sync();
      asm volatile("" : "+v"(tid));
      phase_moe1<PROBE_VAR>(p, (ph - 2) >> 3, ctr + 32 * 8, &s_item, smem, tid);
    }
#endif
#if DUP_MASK
    {
      const int bit = (ph == 0) ? 8 : (ph == 1) ? 9 : ((ph - 2) & 7);
      if ((DUP_MASK >> bit) & 1) {
        cg::this_grid().sync();
        asm volatile("" : "+v"(tid));
        run_phase(p, ph, ctr + 32 * 8, &s_item, smem, tid);
      }
    }
#endif
  }
}

extern "C" void kernel_launch(void* const* d_in, const int* in_sizes, int n_in, void* d_out, int out_size, void* d_ws,
                              size_t ws_size, hipStream_t stream) {
  (void)in_sizes; (void)n_in; (void)out_size;
  if (ws_size < O_END) { fprintf(stderr, "kernel_launch: workspace too small (%zu < %zu)\n", ws_size, (size_t)O_END); return; }
  Params p{};
  const float** pp = (const float**)&p;
  for (int i = 0; i < 21; ++i) pp[i] = (const float*)d_in[i];
  p.out = (float*)d_out;
  p.ws = (char*)d_ws;
  static int grid_blocks = 0;
  if (!grid_blocks) {
    int dev = 0, cus = 0, per_cu = 0;
    hipGetDevice(&dev);
    hipDeviceGetAttribute(&cus, hipDeviceAttributeMultiprocessorCount, dev);
    hipFuncSetAttribute((const void*)fwd_kernel, hipFuncAttributeMaxDynamicSharedMemorySize, LDS_BYTES);
    hipOccupancyMaxActiveBlocksPerMultiprocessor(&per_cu, fwd_kernel, NTHR, LDS_BYTES);
    if (per_cu < 1) per_cu = 1;
    if (per_cu > 1) per_cu = 1;
    grid_blocks = cus * per_cu;
  }
#if ONE_LAUNCH
  p.ph_lo = 0; p.ph_hi = NPHASE;
  void* args[] = {&p};
  hipError_t e = hipLaunchCooperativeKernel((void*)fwd_kernel, dim3(grid_blocks), dim3(NTHR), args, LDS_BYTES, stream);
  if (e != hipSuccess) fprintf(stderr, "cooperative launch failed: %s (grid %d)\n", hipGetErrorString(e), grid_blocks);
#else
  for (int ph = 0; ph < NPHASE; ++ph) {
    p.ph_lo = ph; p.ph_hi = ph + 1;
    hipLaunchKernelGGL(fwd_kernel, dim3(grid_blocks), dim3(NTHR), LDS_BYTES, stream, p);
  }
#endif
}
```
